# Optimizing an MI355X kernel written in HIP

```python
import jax, jax.numpy as jnp
from jax import lax
import numpy as np

D_MODEL = 1024
BATCH = 8
SEQ = 2048
DEPTH = 4

HEAD_DIM = 64
Q_BLOCK = 128
ROPE_THETA = 10000.0
NORM_EPS = 1e-6
FOX_HEADS = 6
FOX_WIDTH = FOX_HEADS * HEAD_DIM
FORGET_BIAS_LO = 1.0
FORGET_BIAS_HI = 4.0
DIL_HEADS = 6
DIL_WIDTH = DIL_HEADS * HEAD_DIM
DIL_PAIRS = ((128, 1), (512, 4), (2048, 16))
DIL_BLOCK = 128
MLA_HEADS = 4
MLA_Q_RANK = 256
MLA_KV_RANK = 256
MLA_NOPE_DIM = 64
MLA_ROPE_DIM = 32
MLA_V_DIM = 64
MLA_WIDTH = MLA_HEADS * MLA_V_DIM
N_BRANCHES = 3
IN_SIZES = (FOX_WIDTH, FOX_WIDTH, FOX_WIDTH, FOX_HEADS,
            DIL_WIDTH, DIL_WIDTH, DIL_WIDTH,
            MLA_Q_RANK, MLA_KV_RANK, MLA_ROPE_DIM,
            N_BRANCHES * D_MODEL)
IN_WIDTH = sum(IN_SIZES)
D_FF = 2816
N_EXPERTS = 8
TOP_K = 2
D_FF_EXPERT = 1408
N_DENSE = (DEPTH + 1) // 2
N_MOE = DEPTH // 2
PLE_DIM = 256
MAX_POS_OFFSET = 1024

kernel_name = "hybrid_fox_dilated_mla_moe_trunk"


def rmsnorm(x, gain):
    xf = x.astype(jnp.float32)
    y = xf * lax.rsqrt(jnp.mean(xf * xf, axis=-1, keepdims=True) + NORM_EPS)
    return (y * gain.astype(jnp.float32)).astype(x.dtype)


def rope(x, positions):
    half = x.shape[-1] // 2
    inv_freq = ROPE_THETA ** (-jnp.arange(half, dtype=jnp.float32) / half)
    ang = positions.astype(jnp.float32)[:, None, :, None] * inv_freq
    cos, sin = jnp.cos(ang), jnp.sin(ang)
    xf = x.astype(jnp.float32)
    x1, x2 = xf[..., :half], xf[..., half:]
    return jnp.concatenate([x1 * cos - x2 * sin, x2 * cos + x1 * sin], axis=-1).astype(x.dtype)


def to_heads(a, n_heads):
    b, t, _ = a.shape
    return a.reshape(b, t, n_heads, -1).transpose(0, 2, 1, 3)


def from_heads(a):
    b, h, t, d = a.shape
    return a.transpose(0, 2, 1, 3).reshape(b, t, h * d)


def causal_block_attention(q, k, v, scale, decay=None):
    b, h, t, dk = q.shape
    nb = t // Q_BLOCK
    qb = q.reshape(b, h, nb, Q_BLOCK, dk).transpose(2, 0, 1, 3, 4)
    starts = jnp.arange(nb, dtype=jnp.int32) * Q_BLOCK
    k_pos = jnp.arange(t, dtype=jnp.int32)
    if decay is None:
        xs = (qb, starts)
    else:
        xs = (qb, starts, decay.reshape(b, h, nb, Q_BLOCK).transpose(2, 0, 1, 3))

    def one_block(xs_i):
        qi, start = xs_i[0], xs_i[1]
        s = jnp.einsum('bhqd,bhkd->bhqk', qi, k).astype(jnp.float32) * scale
        if decay is not None:
            s = s + (xs_i[2][..., :, None] - decay[:, :, None, :])
        q_pos = start + jnp.arange(Q_BLOCK, dtype=jnp.int32)
        s = jnp.where(k_pos[None, :] <= q_pos[:, None], s, -jnp.inf)
        pr = jax.nn.softmax(s, axis=-1)
        return jnp.einsum('bhqk,bhkd->bhqd', pr.astype(v.dtype), v)

    out = lax.map(one_block, xs)
    return out.transpose(1, 2, 0, 3, 4).reshape(b, h, t, v.shape[-1])


def dilated_branch(q, k, v, window, rate, scale):
    b, h, t, d = q.shape
    span = window // rate
    chunk = rate * DIL_BLOCK
    t_pad = -(-t // chunk) * chunk
    length = t_pad // rate
    nb = length // DIL_BLOCK

    def blocks(a):
        a = jnp.pad(a, ((0, 0), (0, 0), (0, t_pad - t), (0, 0)))
        a = a.reshape(b, h, length, rate, d).transpose(0, 1, 3, 2, 4)
        return a.reshape(b, h, rate, nb, DIL_BLOCK, d)

    def with_prev(a):
        prev = jnp.concatenate([jnp.zeros_like(a[:, :, :, :1]), a[:, :, :, :-1]], axis=3)
        return jnp.concatenate([prev, a], axis=4)

    qb = blocks(q)
    kb = with_prev(blocks(k))
    vb = with_prev(blocks(v))
    s = jnp.einsum('bhrnqd,bhrnkd->bhrnqk', qb, kb).astype(jnp.float32) * scale
    qi = jnp.arange(DIL_BLOCK)[:, None]
    ki = jnp.arange(2 * DIL_BLOCK)[None, :]
    dist = qi + DIL_BLOCK - ki
    band = (dist >= 0) & (dist <= span)
    has_prev = (jnp.arange(nb) > 0)[:, None, None] | (ki >= DIL_BLOCK)[None]
    valid = band[None] & has_prev
    s = jnp.where(valid, s, -jnp.inf)
    lse = jax.nn.logsumexp(s, axis=-1)
    pr = jnp.exp(s - lse[..., None])
    o = jnp.einsum('bhrnqk,bhrnkd->bhrnqd', pr.astype(v.dtype), vb)
    o = o.reshape(b, h, rate, length, d).transpose(0, 1, 3, 2, 4).reshape(b, h, t_pad, d)[:, :, :t]
    lse = lse.reshape(b, h, rate, length).transpose(0, 1, 3, 2).reshape(b, h, t_pad)[:, :, :t]
    return o, lse


def dilated_attention(q, k, v, scale):
    results = [dilated_branch(q, k, v, w, r, scale) for (w, r) in DIL_PAIRS]
    outs = jnp.stack([o for o, _ in results], axis=0)
    lses = jnp.stack([l for _, l in results], axis=0)
    alpha = jax.nn.softmax(lses, axis=0)
    return jnp.einsum('gbht,gbhtd->bhtd', alpha.astype(v.dtype), outs)


def swiglu(h, w_gate, w_up, w_down):
    return (jax.nn.silu(h @ w_gate) * (h @ w_up)) @ w_down


def moe_swiglu(h, w_router, w_gate, w_up, w_down):
    logits = (h @ w_router).astype(jnp.float32)
    top_val, top_idx = lax.top_k(logits, TOP_K)
    top_w = jax.nn.softmax(top_val, axis=-1)
    combine = jnp.sum(jax.nn.one_hot(top_idx, N_EXPERTS, dtype=jnp.float32) * top_w[..., None], axis=-2)
    combine = combine.astype(h.dtype)
    y = jnp.zeros_like(h)
    for e in range(N_EXPERTS):
        y = y + combine[..., e:e + 1] * swiglu(h, w_gate[e], w_up[e], w_down[e])
    return y


def setup_inputs(seed: int = 0) -> dict:
    key = jax.random.key(seed)
    ks = iter(jax.random.split(key, 32))
    f32 = jnp.float32

    def normal(shape, fan_in):
        return jax.random.normal(next(ks), shape, f32) * (fan_in ** -0.5)

    def gain(shape):
        return 1.0 + 0.05 * jax.random.normal(next(ks), shape, f32)

    x = jax.random.normal(next(ks), (BATCH, SEQ, D_MODEL), f32)
    p = jax.random.normal(next(ks), (DEPTH, BATCH, SEQ, PLE_DIM), f32)
    offsets = jax.random.randint(next(ks), (BATCH, 1), 0, MAX_POS_OFFSET, dtype=jnp.int32)
    positions = offsets + jnp.arange(SEQ, dtype=jnp.int32)[None, :]
    return {
        'x': x,
        'p': p,
        'positions': positions,
        'mix_norm': gain((DEPTH, D_MODEL)),
        'w_in': normal((DEPTH, D_MODEL, IN_WIDTH), D_MODEL),
        'b_forget': jax.random.uniform(next(ks), (DEPTH, FOX_HEADS), f32, FORGET_BIAS_LO, FORGET_BIAS_HI),
        'mla_q_norm': gain((DEPTH, MLA_Q_RANK)),
        'mla_kv_norm': gain((DEPTH, MLA_KV_RANK)),
        'w_uq': normal((DEPTH, MLA_Q_RANK, MLA_HEADS * (MLA_NOPE_DIM + MLA_ROPE_DIM)), MLA_Q_RANK),
        'w_ukv': normal((DEPTH, MLA_KV_RANK, MLA_HEADS * (MLA_NOPE_DIM + MLA_V_DIM)), MLA_KV_RANK),
        'w_br_fox': normal((DEPTH, FOX_WIDTH, D_MODEL), FOX_WIDTH),
        'w_br_dil': normal((DEPTH, DIL_WIDTH, D_MODEL), DIL_WIDTH),
        'w_br_mla': normal((DEPTH, MLA_WIDTH, D_MODEL), MLA_WIDTH),
        'w_out': normal((DEPTH, D_MODEL, D_MODEL), D_MODEL),
        'ffn_norm': gain((DEPTH, D_MODEL)),
        'w_ffn_gate': normal((N_DENSE, D_MODEL, D_FF), D_MODEL),
        'w_ffn_up': normal((N_DENSE, D_MODEL, D_FF), D_MODEL),
        'w_ffn_down': normal((N_DENSE, D_FF, D_MODEL), D_FF),
        'w_router': normal((N_MOE, D_MODEL, N_EXPERTS), D_MODEL),
        'w_exp_gate': normal((N_MOE, N_EXPERTS, D_MODEL, D_FF_EXPERT), D_MODEL),
        'w_exp_up': normal((N_MOE, N_EXPERTS, D_MODEL, D_FF_EXPERT), D_MODEL),
        'w_exp_down': normal((N_MOE, N_EXPERTS, D_FF_EXPERT, D_MODEL), D_FF_EXPERT),
        'ple_norm': gain((DEPTH, D_MODEL)),
        'w_ple_gate': normal((DEPTH, D_MODEL, D_MODEL), D_MODEL),
        'w_ple_proj': normal((DEPTH, PLE_DIM, D_MODEL), PLE_DIM),
        'final_norm': gain((D_MODEL,)),
    }


def reference(x, p, positions, mix_norm, w_in, b_forget, mla_q_norm, mla_kv_norm, w_uq, w_ukv,
              w_br_fox, w_br_dil, w_br_mla, w_out, ffn_norm, w_ffn_gate, w_ffn_up, w_ffn_down,
              w_router, w_exp_gate, w_exp_up, w_exp_down, ple_norm, w_ple_gate, w_ple_proj,
              final_norm):
    b, t, _ = x.shape
    split_at = np.cumsum(IN_SIZES)[:-1].tolist()
    head_scale = HEAD_DIM ** -0.5
    mla_scale = (MLA_NOPE_DIM + MLA_ROPE_DIM) ** -0.5
    for i in range(DEPTH):
        h = rmsnorm(x, mix_norm[i])
        proj = h @ w_in[i]
        (fq, fk, fv, fz, dq, dk, dv, cq, ckv, kr, gates) = jnp.split(proj, split_at, axis=-1)

        log_f = jax.nn.log_sigmoid(fz.astype(jnp.float32) + b_forget[i].astype(jnp.float32))
        decay = jnp.cumsum(log_f, axis=1).transpose(0, 2, 1)
        o_fox = causal_block_attention(to_heads(fq, FOX_HEADS), to_heads(fk, FOX_HEADS),
                                       to_heads(fv, FOX_HEADS), head_scale, decay)

        o_dil = dilated_attention(rope(to_heads(dq, DIL_HEADS), positions),
                                  rope(to_heads(dk, DIL_HEADS), positions),
                                  to_heads(dv, DIL_HEADS), head_scale)

        q_c = to_heads(rmsnorm(cq, mla_q_norm[i]) @ w_uq[i], MLA_HEADS)
        q_c = jnp.concatenate([q_c[..., :MLA_NOPE_DIM], rope(q_c[..., MLA_NOPE_DIM:], positions)], axis=-1)
        kv_c = to_heads(rmsnorm(ckv, mla_kv_norm[i]) @ w_ukv[i], MLA_HEADS)
        k_pe = rope(kr[:, None], positions)
        k_c = jnp.concatenate([kv_c[..., :MLA_NOPE_DIM],
                               jnp.broadcast_to(k_pe, (b, MLA_HEADS, t, MLA_ROPE_DIM))], axis=-1)
        o_mla = causal_block_attention(q_c, k_c, kv_c[..., MLA_NOPE_DIM:], mla_scale)

        g_fox, g_dil, g_mla = jnp.split(jax.nn.sigmoid(gates), N_BRANCHES, axis=-1)
        merged = (g_fox * (from_heads(o_fox) @ w_br_fox[i])
                  + g_dil * (from_heads(o_dil) @ w_br_dil[i])
                  + g_mla * (from_heads(o_mla) @ w_br_mla[i]))
        x = x + merged @ w_out[i]

        h = rmsnorm(x, ffn_norm[i])
        j = i // 2
        if i % 2 == 0:
            x = x + swiglu(h, w_ffn_gate[j], w_ffn_up[j], w_ffn_down[j])
        else:
            x = x + moe_swiglu(h, w_router[j], w_exp_gate[j], w_exp_up[j], w_exp_down[j])

        g = jax.nn.sigmoid(rmsnorm(x, ple_norm[i]) @ w_ple_gate[i])
        x = x + g * (p[i] @ w_ple_proj[i])
    return rmsnorm(x, final_norm)
```

```cpp
#include <hip/hip_runtime.h>
#include <cstdio>
#include <cstdint>
#include <cmath>

#define GAS __attribute__((address_space(1)))
#define LAS __attribute__((address_space(3)))
typedef unsigned short bf16;
typedef unsigned u32x4 __attribute__((ext_vector_type(4)));
typedef unsigned u32x2 __attribute__((ext_vector_type(2)));
typedef float f32x4 __attribute__((ext_vector_type(4)));
typedef float f32x2 __attribute__((ext_vector_type(2)));
typedef short bf16x8 __attribute__((ext_vector_type(8)));

constexpr int BATCH = 8, T = 2048, D = 1024, DEPTH = 4, M = BATCH * T;
constexpr int NPROJ = 6144;
constexpr int C_FQ = 0, C_FK = 384, C_FV = 768, C_DQ = 1152, C_DK = 1536, C_DV = 1920, C_CQ = 2304, C_CKV = 2560, C_G = 2816, C_MISC = 5888;
constexpr int S_FQ = 0, S_FK = 384, S_FV = 768, S_FZ = 1152, S_DQ = 1158, S_DK = 1542, S_DV = 1926, S_CQ = 2310, S_CKV = 2566, S_KR = 2822, S_G = 2854, IN_W = 5926;
constexpr int DFF = 2816, DFE = 1408, NEXP = 8;
constexpr float LOG2E = 1.4426950408889634f;
constexpr float QS = 0.125f * LOG2E;
constexpr float MS = 0.10206207261596577f * LOG2E;
constexpr float EPS = 1e-6f;
constexpr int MOE_ROWS = 2 * M + NEXP * 256;

constexpr size_t MiB = 1u << 20;
constexpr size_t WS_CTL = 0, CTL_BYTES = 1 * MiB;
constexpr size_t WS_WIN = 1 * MiB;
constexpr size_t WS_WUQ = WS_WIN + 48 * MiB;
constexpr size_t WS_WUKV = WS_WUQ + 1 * MiB;
constexpr size_t WS_WBR = WS_WUKV + 1 * MiB;
constexpr size_t WS_WOUT = WS_WBR + 8 * MiB;
constexpr size_t WS_WGU = WS_WOUT + 8 * MiB;
constexpr size_t WS_WDN = WS_WGU + 22 * MiB;
constexpr size_t WS_WEGU = WS_WDN + 11 * MiB;
constexpr size_t WS_WEDN = WS_WEGU + 88 * MiB;
constexpr size_t WS_WPG = WS_WEDN + 44 * MiB;
constexpr size_t WS_WPP = WS_WPG + 8 * MiB;
constexpr size_t WS_HB = WS_WPP + 2 * MiB;
constexpr size_t WS_PROJ = WS_HB + 32 * MiB;
constexpr size_t WS_HID = WS_PROJ;
constexpr size_t WS_XG = WS_PROJ + 96 * MiB;
constexpr size_t WS_PB = WS_PROJ + 164 * MiB;
constexpr size_t WS_PP = WS_PROJ;
constexpr size_t WS_MISCF = WS_PROJ + 192 * MiB;
constexpr size_t WS_QC = WS_MISCF + 4 * MiB;
constexpr size_t WS_KVC = WS_QC + 16 * MiB;
constexpr size_t WS_KR = WS_KVC + 16 * MiB;
constexpr size_t WS_DL = WS_KR + 1 * MiB;
constexpr size_t WS_RSTD = WS_DL + 1 * MiB;
constexpr size_t WS_OALL = WS_RSTD + 1 * MiB;
constexpr size_t WS_MERGED = WS_OALL + 32 * MiB;
constexpr size_t WS_CS64 = WS_MERGED + 32 * MiB;
constexpr size_t WS_CS32 = WS_CS64 + 4 * MiB;
constexpr size_t WS_ROUTE = WS_CS32 + 2 * MiB;
constexpr size_t WS_TOKS = WS_ROUTE + 1 * MiB;
constexpr size_t WS_END = WS_TOKS + 1 * MiB;
constexpr int CW_BAR = 4096;
constexpr int CW_CNT = 1024;

__device__ __forceinline__ float bf2f(unsigned b) { return __uint_as_float(b << 16); }
__device__ __forceinline__ unsigned cvt_pk_bf16(float lo, float hi) { unsigned r; asm volatile("v_cvt_pk_bf16_f32 %0, %1, %2" : "=v"(r) : "v"(lo), "v"(hi)); return r; }
__device__ __forceinline__ float fast_sigmoid(float x) { return __builtin_amdgcn_rcpf(1.0f + __builtin_amdgcn_exp2f(-LOG2E * x)); }
__device__ __forceinline__ float wave_sum(float v) {
#pragma unroll
    for (int o = 1; o < 64; o <<= 1) v += __shfl_xor(v, o);
    return v;
}
__device__ __forceinline__ float wave_max(float v) {
#pragma unroll
    for (int o = 1; o < 64; o <<= 1) v = fmaxf(v, __shfl_xor(v, o));
    return v;
}

namespace pg8 {
constexpr int BM = 256, BK = 64, HALF = 128, HTB = HALF * BK * 2, STAGE_BYTES = 8 * HTB, NXCD = 8, WGM = 8;
__host__ __device__ __forceinline__ int lds_byte(int r, int c) { const int st = (r >> 4) * 2 + (c >> 5), rr = r & 15, cc = c & 31, ob = rr * 64 + cc * 2; return st * 1024 + (ob ^ (((ob >> 9) & 1) << 5)); }
__host__ __device__ __forceinline__ void stage_rc(int b, int& R, int& C) { const int st = b / 1024, sb = b % 1024, swz = sb ^ (((sb >> 9) & 1) << 5); R = (st >> 1) * 16 + swz / 64; C = (st & 1) * 32 + (swz % 64) / 2; }
__host__ __device__ __forceinline__ int perm32(int rho) { const int n = rho >> 4, i = rho & 15; return 8 * (i >> 2) + 4 * n + (i & 3); }

struct Unit { int pm, pn; long aoff, boff; };
struct Gemm { const bf16* A; const bf16* Bt; int lda, ldb, K; };

struct StaticOrder {
    int nM, nN, nwg, G, c; long ta, tb;
    __device__ void init(int Mr, int N, int G_, int c_, int lda, int ldb) { nM = Mr / BM; nN = N / BM; nwg = nM * nN; G = G_; c = c_; ta = 256L * lda * 2; tb = 256L * ldb * 2; }
    __device__ bool next(int i, Unit& u) const {
        const long L = (long)i * G + c; if (L >= nwg) return false;
        int wgid = (int)L; { const int q = nwg / NXCD, r = nwg % NXCD, xcd = wgid % NXCD, off = wgid / NXCD; wgid = (xcd < r ? xcd * (q + 1) : r * (q + 1) + (xcd - r) * q) + off; }
        const int nig = WGM * nN, gid = wgid / nig, fm = gid * WGM, gsz = (nM - fm) < WGM ? (nM - fm) : WGM;
        u.pm = fm + ((wgid % nig) % gsz); u.pn = (wgid % nig) / gsz; u.aoff = u.pm * ta; u.boff = u.pn * tb; return true;
    }
};
struct MoeOrder {
    int cum[9]; int npn, G, c; long ta, tb, eb;
    __device__ bool next(int i, Unit& u) const {
        const long L = (long)i * G + c; if (L >= (long)cum[8] * npn) return false;
        const int tile = (int)(L / npn), pn = (int)(L % npn); int e = 0;
#pragma unroll
        for (int k = 1; k < 8; ++k) e += (tile >= cum[k]) ? 1 : 0;
        u.pm = tile; u.pn = pn; u.aoff = tile * ta; u.boff = e * eb + pn * tb; return true;
    }
};

template <class Epi, class Sched>
__device__ __forceinline__ void gemm_phase(LAS unsigned char* lds, const Gemm g, const Sched& S, const Epi& E) {
    int tid = threadIdx.x; asm volatile("" : "+v"(tid));
    const int wid = __builtin_amdgcn_readfirstlane(tid >> 6), lane = tid & 63, wr = wid >> 2, wc = wid & 3, fr = lane & 15, fq = lane >> 4;
    int K = g.K; asm volatile("" : "+s"(K));
    const int nt = K / BK;
    unsigned voffA[2], voffB[2];
#pragma unroll
    for (int i = 0; i < 2; ++i) { int R, C; stage_rc(tid * 16 + i * 8192, R, C); const int Rb = (R & ~31) + perm32(R & 31);
        voffA[i] = (unsigned)(R * g.lda + C) * 2u; voffB[i] = (unsigned)(Rb * g.ldb + C) * 2u; }
    const size_t kstep = (size_t)(BK * 2);
    const size_t hstepA = (size_t)HALF * g.lda * 2, hstepB = (size_t)HALF * g.ldb * 2;
    const unsigned ldsw = (unsigned)wid * 1024u;
    const int aoff = lds_byte(wr * 64 + fr, fq * 8), boff = lds_byte(wc * 32 + fr, fq * 8);
#define PG8_SA(b, h) (((b) * 2 + (h)) * HTB)
#define PG8_SB(b, h) ((4 + (b) * 2 + (h)) * HTB)
#define PG8_STAGE(bufoff, gbase, voff) do { _Pragma("unroll") for (int _i = 0; _i < 2; ++_i) \
        __builtin_amdgcn_global_load_lds((const unsigned*)((const char*)(gbase) + (voff)[_i]), (LAS unsigned*)(lds + (bufoff) + ldsw + _i * 8192), 16, 0, 0); } while (0)
#define PG8_LDA(dst, b, h) do { _Pragma("unroll") for (int m = 0; m < 4; ++m) _Pragma("unroll") for (int k = 0; k < 2; ++k) dst[m][k] = *(const LAS bf16x8*)(lds + PG8_SA(b, h) + aoff + m * 2048 + k * 1024); } while (0)
#define PG8_LDB(dst, b, h) do { _Pragma("unroll") for (int n = 0; n < 2; ++n) _Pragma("unroll") for (int k = 0; k < 2; ++k) dst[n][k] = *(const LAS bf16x8*)(lds + PG8_SB(b, h) + boff + n * 2048 + k * 1024); } while (0)
#define PG8_MMA(ai, bj, At, Bt) do { __builtin_amdgcn_s_setprio(1); _Pragma("unroll") for (int m = 0; m < 4; ++m) _Pragma("unroll") for (int n = 0; n < 2; ++n) _Pragma("unroll") for (int k = 0; k < 2; ++k) \
        acc[ai][bj][m][n] = __builtin_amdgcn_mfma_f32_16x16x32_bf16(Bt[n][k], At[m][k], acc[ai][bj][m][n], 0, 0, 0); __builtin_amdgcn_s_setprio(0); } while (0)
#define PG8_WAIT_V(n) asm volatile("s_waitcnt vmcnt(" #n ")" ::: "memory")
#define PG8_WAIT_L(n) asm volatile("s_waitcnt lgkmcnt(" #n ")" ::: "memory")
#define PG8_BAR __builtin_amdgcn_s_barrier()
#define PG8_SCHED __builtin_amdgcn_sched_barrier(0)
    Unit cur, nxt; int ui = 0;
    if (!S.next(0, cur)) return;
    f32x4 acc[2][2][4][2];
#pragma unroll
    for (int a = 0; a < 2; ++a)
#pragma unroll
        for (int b = 0; b < 2; ++b)
#pragma unroll
            for (int m = 0; m < 4; ++m)
#pragma unroll
                for (int n = 0; n < 2; ++n) acc[a][b][m][n] = (f32x4){0.f, 0.f, 0.f, 0.f};
    bf16x8 At[4][2], B0[2][2], B1[2][2];
    const char* cA = (const char*)g.A + cur.aoff; const char* cB = (const char*)g.Bt + cur.boff;
    PG8_STAGE(PG8_SB(0, 0), cB, voffB); PG8_STAGE(PG8_SB(0, 1), cB + hstepB, voffB); PG8_STAGE(PG8_SA(0, 0), cA, voffA); PG8_STAGE(PG8_SA(0, 1), cA + hstepA, voffA);
    if (wr == 1) PG8_BAR;
    PG8_WAIT_V(2); PG8_BAR;
    PG8_STAGE(PG8_SB(1, 0), cB + kstep, voffB); PG8_STAGE(PG8_SA(1, 0), cA + kstep, voffA); PG8_STAGE(PG8_SB(1, 1), cB + hstepB + kstep, voffB);
    PG8_WAIT_V(6); PG8_BAR;
    for (;;) {
        const bool has_next = S.next(ui + 1, nxt);
        const char* nA = has_next ? (const char*)g.A + nxt.aoff : cA; const char* nB = has_next ? (const char*)g.Bt + nxt.boff : cB;
        for (int t = 0; t < nt; t += 2) {
            const bool last = (t == nt - 2);
            const char* a1 = cA + (size_t)(t + 1) * kstep;
            const char* a2 = last ? nA : cA + (size_t)(t + 2) * kstep; const char* b2 = last ? nB : cB + (size_t)(t + 2) * kstep;
            const char* a3 = a2 + kstep; const char* b3 = b2 + kstep;
            PG8_LDB(B0, 0, 0); PG8_LDB(B1, 0, 1); PG8_SCHED; PG8_LDA(At, 0, 0); PG8_STAGE(PG8_SA(1, 1), a1 + hstepA, voffA);
            PG8_WAIT_V(8); PG8_WAIT_L(0); PG8_BAR; PG8_MMA(0, 0, At, B0); PG8_MMA(0, 1, At, B1); PG8_BAR; PG8_SCHED;
            PG8_LDA(At, 0, 1); PG8_STAGE(PG8_SB(0, 0), b2, voffB); PG8_STAGE(PG8_SB(0, 1), b2 + hstepB, voffB); PG8_STAGE(PG8_SA(0, 0), a2, voffA);
            PG8_WAIT_V(8); PG8_WAIT_L(0); PG8_BAR; PG8_MMA(1, 0, At, B0); PG8_MMA(1, 1, At, B1); PG8_BAR; PG8_SCHED;
            PG8_LDB(B0, 1, 0); PG8_LDB(B1, 1, 1); PG8_SCHED; PG8_LDA(At, 1, 0); PG8_STAGE(PG8_SA(0, 1), a2 + hstepA, voffA);
            PG8_WAIT_V(8); PG8_WAIT_L(0); PG8_BAR; PG8_MMA(0, 0, At, B0); PG8_MMA(0, 1, At, B1); PG8_BAR; PG8_SCHED;
            PG8_LDA(At, 1, 1); PG8_STAGE(PG8_SB(1, 0), b3, voffB); PG8_STAGE(PG8_SB(1, 1), b3 + hstepB, voffB); PG8_STAGE(PG8_SA(1, 0), a3, voffA);
            PG8_WAIT_V(8); PG8_WAIT_L(0); PG8_BAR; PG8_MMA(1, 0, At, B0); PG8_MMA(1, 1, At, B1); PG8_BAR; PG8_SCHED;
        }
        if (wr == 0) PG8_BAR;
        E(acc, cur, wr, wc, fr, fq);
        if (!has_next) break;
#pragma unroll
        for (int a = 0; a < 2; ++a)
#pragma unroll
            for (int b = 0; b < 2; ++b)
#pragma unroll
                for (int m = 0; m < 4; ++m)
#pragma unroll
                    for (int n = 0; n < 2; ++n) acc[a][b][m][n] = (f32x4){0.f, 0.f, 0.f, 0.f};
        cur = nxt; cA = nA; cB = nB; ++ui;
        if (wr == 1) PG8_BAR;
    }
    PG8_WAIT_V(0);
    PG8_BAR;
#undef PG8_SA
#undef PG8_SB
#undef PG8_STAGE
#undef PG8_LDA
#undef PG8_LDB
#undef PG8_MMA
#undef PG8_WAIT_V
#undef PG8_WAIT_L
#undef PG8_BAR
#undef PG8_SCHED
}

#define EPI_ROWS(...) \
    _Pragma("unroll") for (int ai = 0; ai < 2; ++ai) _Pragma("unroll") for (int m = 0; m < 4; ++m) { const int row = row0 + ai * HALF + m * 16; \
        _Pragma("unroll") for (int bj = 0; bj < 2; ++bj) { const int col = col0 + bj * HALF; f32x4 v0 = acc[ai][bj][m][0], v1 = acc[ai][bj][m][1]; __VA_ARGS__ } }
__device__ __forceinline__ u32x4 pack8(f32x4 v0, f32x4 v1) { u32x4 w; w.x = cvt_pk_bf16(v0[0], v0[1]); w.y = cvt_pk_bf16(v0[2], v0[3]); w.z = cvt_pk_bf16(v1[0], v1[1]); w.w = cvt_pk_bf16(v1[2], v1[3]); return w; }
__device__ __forceinline__ void unpack8(u32x4 w, f32x4& a, f32x4& b) {
    a = (f32x4){bf2f(w.x & 0xffffu), bf2f(w.x >> 16), bf2f(w.y & 0xffffu), bf2f(w.y >> 16)};
    b = (f32x4){bf2f(w.z & 0xffffu), bf2f(w.z >> 16), bf2f(w.w & 0xffffu), bf2f(w.w >> 16)}; }

struct EpiProj {
    bf16* P; float* miscf;
    __device__ __forceinline__ void operator()(const f32x4 (&acc)[2][2][4][2], const Unit& u, int wr, int wc, int fr, int fq) const {
        const int row0 = u.pm * BM + wr * 64 + fr, col0 = u.pn * BM + wc * 32 + 8 * fq;
        const bool sig = (u.pn >= 11 && u.pn < 23), misc = (u.pn == 23);
        EPI_ROWS(
            if (sig) { _Pragma("unroll") for (int e = 0; e < 4; ++e) { v0[e] = fast_sigmoid(v0[e]); v1[e] = fast_sigmoid(v1[e]); } }
            *(u32x4*)(P + (size_t)row * NPROJ + col) = pack8(v0, v1);
            if (misc && bj == 0 && wc < 2) { float* mp = miscf + (size_t)row * 64 + wc * 32 + 8 * fq; *(f32x4*)mp = v0; *(f32x4*)(mp + 4) = v1; }
        )
    }
};
struct EpiStore {
    bf16* O; int ldc; const float* rs;
    __device__ __forceinline__ void operator()(const f32x4 (&acc)[2][2][4][2], const Unit& u, int wr, int wc, int fr, int fq) const {
        const int row0 = u.pm * BM + wr * 64 + fr, col0 = u.pn * BM + wc * 32 + 8 * fq;
        EPI_ROWS(
            if (rs) { const float s = rs[row]; v0 = v0 * s; v1 = v1 * s; }
            *(u32x4*)(O + (size_t)row * ldc + col) = pack8(v0, v1);
        )
    }
};
template <bool FIRST> struct EpiGated {
    bf16* O; const bf16* gate;
    __device__ __forceinline__ void operator()(const f32x4 (&acc)[2][2][4][2], const Unit& u, int wr, int wc, int fr, int fq) const {
        const int row0 = u.pm * BM + wr * 64 + fr, col0 = u.pn * BM + wc * 32 + 8 * fq;
        EPI_ROWS(
            f32x4 g0, g1; unpack8(*(const u32x4*)(gate + (size_t)row * NPROJ + col), g0, g1);
            v0 = v0 * g0; v1 = v1 * g1;
            bf16* op = O + (size_t)row * D + col;
            if (!FIRST) { f32x4 o0, o1; unpack8(*(const u32x4*)op, o0, o1); v0 = v0 + o0; v1 = v1 + o1; }
            *(u32x4*)op = pack8(v0, v1);
        )
    }
};
struct EpiResid {
    float* X;
    __device__ __forceinline__ void operator()(const f32x4 (&acc)[2][2][4][2], const Unit& u, int wr, int wc, int fr, int fq) const {
        const int row0 = u.pm * BM + wr * 64 + fr, col0 = u.pn * BM + wc * 32 + 8 * fq;
        EPI_ROWS(
            float* xp = X + (size_t)row * D + col;
            const f32x4 x0 = *(const f32x4*)xp, x1 = *(const f32x4*)(xp + 4);
            *(f32x4*)xp = x0 + v0; *(f32x4*)(xp + 4) = x1 + v1;
        )
    }
};
struct EpiSwiGLU {
    bf16* Hd; int ldh;
    __device__ __forceinline__ void operator()(const f32x4 (&acc)[2][2][4][2], const Unit& u, int wr, int wc, int fr, int fq) const {
        const int row0 = u.pm * BM + wr * 64 + fr, col0 = u.pn * BM + wc * 32 + 8 * fq;
        EPI_ROWS(
            f32x4 h;
            _Pragma("unroll") for (int e = 0; e < 4; ++e) h[e] = v0[e] * fast_sigmoid(v0[e]) * v1[e];
            u32x2 w; w.x = cvt_pk_bf16(h[0], h[1]); w.y = cvt_pk_bf16(h[2], h[3]);
            *(u32x2*)(Hd + (size_t)row * ldh + (col >> 1)) = w;
        )
    }
};
struct EpiPle {
    float* X; const bf16* PP;
    __device__ __forceinline__ void operator()(const f32x4 (&acc)[2][2][4][2], const Unit& u, int wr, int wc, int fr, int fq) const {
        const int row0 = u.pm * BM + wr * 64 + fr, col0 = u.pn * BM + wc * 32 + 8 * fq;
        EPI_ROWS(
            f32x4 p0, p1; unpack8(*(const u32x4*)(PP + (size_t)row * D + col), p0, p1);
            float* xp = X + (size_t)row * D + col;
            const f32x4 x0 = *(const f32x4*)xp, x1 = *(const f32x4*)(xp + 4);
            _Pragma("unroll") for (int e = 0; e < 4; ++e) { v0[e] = fast_sigmoid(v0[e]) * p0[e]; v1[e] = fast_sigmoid(v1[e]) * p1[e]; }
            *(f32x4*)xp = x0 + v0; *(f32x4*)(xp + 4) = x1 + v1;
        )
    }
};
}

#define XB_TMO      128
#define XB_XCNT(j)  (256  + 64 * (j))
#define XB_XSUB(j)  (1280 + 64 * (j))
#define XB_XGEN(j)  (2304 + 64 * (j))
#define XB_TOP      3328
#define XB_TOPGEN   3392
#define XCD_BAR_WORDS 3456
#define XB_SPIN_CAP (1u << 18)
__device__ __forceinline__ unsigned xb_ld(unsigned* p)              { return __hip_atomic_load(p, __ATOMIC_RELAXED, __HIP_MEMORY_SCOPE_AGENT); }
__device__ __forceinline__ unsigned xb_add(unsigned* p, unsigned v) { return __hip_atomic_fetch_add(p, v, __ATOMIC_RELAXED, __HIP_MEMORY_SCOPE_AGENT); }
__device__ __forceinline__ unsigned xb_xcc_id() { return (unsigned)__builtin_amdgcn_s_getreg((3 << 11) | 20) & 0xFu; }
#define XB_SPIN(cond, bar) do { unsigned _sp = 0; while (cond) { __builtin_amdgcn_s_sleep(1); \
    if ((++_sp & 255u) == 0u) { if (xb_ld(&(bar)[XB_TMO])) break; if (_sp > XB_SPIN_CAP) { atomicAdd(&(bar)[XB_TMO], 1u); break; } } } } while (0)
struct XcdBarrier { unsigned* bar; unsigned x; volatile LAS unsigned* st; };
__device__ __forceinline__ XcdBarrier xcd_barrier_post(unsigned* bar, volatile LAS unsigned* st) {
    XcdBarrier b; b.bar = bar; b.x = xb_xcc_id(); b.st = st;
    if (threadIdx.x == 0) (void)xb_add(&bar[XB_XCNT(b.x)], 1u);
    return b;
}
__device__ __forceinline__ void xcd_barrier_complete(unsigned* bar, unsigned x, unsigned& nloc, unsigned& nx) {
    const unsigned G = gridDim.x * gridDim.y * gridDim.z;
    unsigned sum, cnt, mine, sp = 0u;
    for (;;) {
        sum = 0u; cnt = 0u; mine = 0u;
#pragma unroll
        for (unsigned j = 0; j < 16; ++j) { const unsigned c = xb_ld(&bar[XB_XCNT(j)]); sum += c; cnt += (c > 0u) ? 1u : 0u; mine = (j == x) ? c : mine; }
        if (sum == G) break;
        __builtin_amdgcn_s_sleep(1);
        if ((++sp & 255u) == 0u) { if (xb_ld(&bar[XB_TMO])) break; if (sp > XB_SPIN_CAP) { atomicAdd(&bar[XB_TMO], 1u); break; } }
    }
    nloc = mine > 0u ? mine : 1u; nx = cnt > 0u ? cnt : 1u;
}
__device__ __forceinline__ void xcd_barrier(const XcdBarrier& b) {
    asm volatile("s_waitcnt vmcnt(0)" ::: "memory");
    __syncthreads();
    if (threadIdx.x == 0) {
        unsigned* bar = b.bar;
        __builtin_amdgcn_s_waitcnt(0);
        unsigned nloc = b.st[0], nx = b.st[1];
        if (nloc == 0u) { xcd_barrier_complete(bar, b.x, nloc, nx); b.st[0] = nloc; b.st[1] = nx; }
        const unsigned old = xb_add(&bar[XB_XSUB(b.x)], 1u);
        const unsigned gen = old / nloc;
        if (old + 1u == (gen + 1u) * nloc) {
            __builtin_amdgcn_fence(__ATOMIC_RELEASE, "agent");
            asm volatile("s_waitcnt vmcnt(0)" ::: "memory");
            const unsigned og = xb_add(&bar[XB_TOP], 1u);
            const unsigned tg = og / nx;
            if (og + 1u == (tg + 1u) * nx) xb_add(&bar[XB_TOPGEN], 1u);
            else XB_SPIN(xb_ld(&bar[XB_TOPGEN]) == tg, bar);
            __builtin_amdgcn_fence(__ATOMIC_ACQUIRE, "agent");
            xb_add(&bar[XB_XGEN(b.x)], 1u);
            asm volatile("s_waitcnt vmcnt(0)" ::: "memory");
        } else {
            XB_SPIN(xb_ld(&bar[XB_XGEN(b.x)]) == gen, bar);
            __builtin_amdgcn_fence(__ATOMIC_ACQUIRE, "agent");
            asm volatile("s_waitcnt vmcnt(0)" ::: "memory");
        }
    }
    __syncthreads();
}

constexpr int RING_BYTES = 131072;
constexpr int MISC_OFF = RING_BYTES;
constexpr int LDS_BYTES = 147456;
constexpr int NWAVES = 8, NTHR = 512;

struct Args { const float* in[26]; float* out; unsigned char* ws; int l_lo, l_hi, ph_lo, ph_hi, fused, pad; };
enum { I_X = 0, I_P, I_POS, I_MIXN, I_WIN, I_BF, I_QN, I_KVN, I_WUQ, I_WUKV, I_BRF, I_BRD, I_BRM, I_WOUT, I_FFNN, I_FG, I_FU, I_FD, I_WR, I_EG, I_EU, I_ED, I_PLEN, I_WPG, I_WPP, I_FINN };
constexpr int PH_FINAL = 16;

__device__ __forceinline__ void conv_job(LAS float* scr, const float* src, int lds_, int K, int col0, int ncols, bf16* dst, int ldd, int row0, int mode, int sub,
                                         const float* gain, float scale, int wg, int nwg) {
    const int tid = threadIdx.x;
    const int nct = (ncols + 63) >> 6, nkt = K >> 6, ntiles = nct * nkt;
    for (int t = wg; t < ntiles; t += nwg) {
        const int kt = t / nct, ct = t - kt * nct, k0 = kt * 64, c0 = ct * 64;
#pragma unroll
        for (int j = 0; j < 8; ++j) { const int kk = (tid >> 6) + 8 * j, cc = tid & 63; float v = 0.f;
            if (c0 + cc < ncols) v = src[(size_t)(k0 + kk) * lds_ + col0 + c0 + cc];
            if (gain) v *= gain[k0 + kk];
            scr[kk * 65 + cc] = v * scale; }
        __syncthreads();
        { const int cc = tid >> 3, kc = (tid & 7) * 8;
          if (c0 + cc < ncols) { const int c = c0 + cc; const int dr = row0 + (mode ? ((c >> 2) * 8 + sub + (c & 3)) : c);
              u32x4 o; o.x = cvt_pk_bf16(scr[(kc + 0) * 65 + cc], scr[(kc + 1) * 65 + cc]); o.y = cvt_pk_bf16(scr[(kc + 2) * 65 + cc], scr[(kc + 3) * 65 + cc]);
              o.z = cvt_pk_bf16(scr[(kc + 4) * 65 + cc], scr[(kc + 5) * 65 + cc]); o.w = cvt_pk_bf16(scr[(kc + 6) * 65 + cc], scr[(kc + 7) * 65 + cc]);
              *(u32x4*)(dst + (size_t)dr * ldd + k0 + kc) = o; } }
        __syncthreads();
    }
}
__device__ __forceinline__ void zero_rows(bf16* dst, int ldd, int row0, int nrows, int K, int gtid, int ngt) {
    const int per = K >> 3, n = nrows * per;
    for (int i = gtid; i < n; i += ngt) { const int r = i / per, k = (i - r * per) * 8; *(u32x4*)(dst + (size_t)(row0 + r) * ldd + k) = (u32x4){0u, 0u, 0u, 0u}; }
}

__device__ __forceinline__ float row_rstd(const f32x4 (&v)[4]) {
    float s = 0.f;
#pragma unroll
    for (int j = 0; j < 4; ++j) s += (v[j].x * v[j].x + v[j].y * v[j].y) + (v[j].z * v[j].z + v[j].w * v[j].w);
    return 1.0f / sqrtf(wave_sum(s) * (1.0f / D) + EPS);
}
__device__ __forceinline__ void store_row_bf16(bf16* orow, const f32x4 (&v)[4], float s, int lane) {
    u32x2* o8 = (u32x2*)orow + lane;
#pragma unroll
    for (int j = 0; j < 4; ++j) { u32x2 w; w.x = cvt_pk_bf16(v[j].x * s, v[j].y * s); w.y = cvt_pk_bf16(v[j].z * s, v[j].w * s); o8[64 * j] = w; }
}

__device__ __forceinline__ float dot8(u32x4 kv, const LAS float* q) {
    const f32x4 q0 = *(const LAS f32x4*)q, q1 = *(const LAS f32x4*)(q + 4);
    float s = __uint_as_float(kv.x << 16) * q0.x;
    s += __uint_as_float(kv.x & 0xffff0000u) * q0.y;
    s += __uint_as_float(kv.y << 16) * q0.z; s += __uint_as_float(kv.y & 0xffff0000u) * q0.w;
    s += __uint_as_float(kv.z << 16) * q1.x; s += __uint_as_float(kv.z & 0xffff0000u) * q1.y;
    s += __uint_as_float(kv.w << 16) * q1.z; s += __uint_as_float(kv.w & 0xffff0000u) * q1.w;
    return s;
}
struct AttnPtrs { const bf16* PROJ; const bf16* QC; const bf16* KVC; const bf16* KR; const float* DL; bf16* OALL; };
template <int TYPE> __device__ __forceinline__ void naive_attn_item(const AttnPtrs& P, int b, int h, int t, LAS float* qs, int lane) {
    const int row = b * T + t;
    constexpr int DQ = (TYPE == 2) ? 96 : 64;
    for (int d = lane; d < DQ; d += 64) {
        unsigned v;
        if (TYPE == 0) v = P.PROJ[(size_t)row * NPROJ + C_FQ + h * 64 + d];
        else if (TYPE == 1) v = P.PROJ[(size_t)row * NPROJ + C_DQ + h * 64 + d];
        else v = (d < 64) ? P.QC[(size_t)row * 512 + h * 64 + d] : P.QC[(size_t)row * 512 + 256 + h * 32 + (d - 64)];
        qs[d] = bf2f(v);
    }
    asm volatile("s_waitcnt lgkmcnt(0)" ::: "memory");
    constexpr int NBR = (TYPE == 1) ? 3 : 1;
    float mm[3], ll[3], oo[3];
#pragma unroll
    for (int g = 0; g < NBR; ++g) {
        const int r = (TYPE == 1) ? (g == 0 ? 1 : (g == 1 ? 4 : 16)) : 1;
        int nkeys = t + 1;
        if (TYPE == 1) { nkeys = t / r; if (nkeys > 128) nkeys = 128; nkeys += 1; }
        float m = -INFINITY, l = 0.f, o = 0.f;
        for (int c0 = 0; c0 < nkeys; c0 += 64) {
            const int d = c0 + lane; const bool valid = d < nkeys;
            const int stok = valid ? ((TYPE == 1) ? (t - r * d) : d) : 0;
            const size_t srow = (size_t)b * T + stok;
            const bf16* kp = (TYPE == 0) ? P.PROJ + srow * NPROJ + C_FK + h * 64 : (TYPE == 1) ? P.PROJ + srow * NPROJ + C_DK + h * 64 : P.KVC + srow * 512 + h * 64;
            float s = 0.f;
#pragma unroll
            for (int j = 0; j < 8; ++j) s += dot8(((const u32x4*)kp)[j], qs + 8 * j);
            if (TYPE == 2) { const bf16* kr = P.KR + srow * 32;
#pragma unroll
                for (int j = 0; j < 4; ++j) s += dot8(((const u32x4*)kr)[j], qs + 64 + 8 * j); }
            if (TYPE == 0) s += P.DL[(size_t)(b * 6 + h) * T + stok];
            s = valid ? s : -INFINITY;
            const float mn = fmaxf(m, wave_max(s));
            const float alpha = exp2f(m - mn);
            const float p = exp2f(s - mn);
            l = l * alpha + wave_sum(p); o *= alpha;
            const int nv = (nkeys - c0) < 64 ? (nkeys - c0) : 64;
            for (int kk = 0; kk < nv; ++kk) {
                const float pk = __uint_as_float(__builtin_amdgcn_readlane(__float_as_uint(p), kk));
                const int st = (TYPE == 1) ? (t - r * (c0 + kk)) : (c0 + kk);
                const size_t vr = (size_t)b * T + st;
                const unsigned vv = (TYPE == 0) ? P.PROJ[vr * NPROJ + C_FV + h * 64 + lane] : (TYPE == 1) ? P.PROJ[vr * NPROJ + C_DV + h * 64 + lane] : P.KVC[vr * 512 + 256 + h * 64 + lane];
                o += pk * bf2f(vv);
            }
            m = mn;
        }
        mm[g] = m; ll[g] = l; oo[g] = o;
    }
    float outv;
    if (TYPE == 1) {
        const float l0 = mm[0] + log2f(ll[0]), l1 = mm[1] + log2f(ll[1]), l2 = mm[2] + log2f(ll[2]);
        const float mx = fmaxf(l0, fmaxf(l1, l2));
        const float w0 = exp2f(l0 - mx), w1 = exp2f(l1 - mx), w2 = exp2f(l2 - mx);
        outv = (w0 * (oo[0] / ll[0]) + w1 * (oo[1] / ll[1]) + w2 * (oo[2] / ll[2])) / (w0 + w1 + w2);
    } else outv = oo[0] / ll[0];
    const int ocol = (TYPE == 0) ? h * 64 : (TYPE == 1) ? 384 + h * 64 : 768 + h * 64;
    P.OALL[(size_t)row * D + ocol + lane] = (bf16)(cvt_pk_bf16(outv, 0.f) & 0xffffu);
}

template <unsigned MASK> __global__ void __launch_bounds__(NTHR, 2) mk_fwd(Args args) {
    extern __shared__ __attribute__((aligned(16))) unsigned char lds_raw[];
    LAS unsigned char* lds = (LAS unsigned char*)lds_raw;
    volatile LAS unsigned* MISC = (volatile LAS unsigned*)(lds + MISC_OFF);
    const int tid = threadIdx.x, lane = tid & 63, wave = __builtin_amdgcn_readfirstlane(tid >> 6);
    const int G = gridDim.x, bx = blockIdx.x;
    const int gw = bx * NWAVES + wave, NGW = G * NWAVES;
    const int gtid = bx * NTHR + tid, NGT = G * NTHR;
    unsigned char* ws = args.ws;
    unsigned* ctl = (unsigned*)(ws + WS_CTL);
    for (int u = tid; u < (LDS_BYTES - MISC_OFF) / 4; u += NTHR) ((LAS unsigned*)(lds + MISC_OFF))[u] = 0u;
    __syncthreads();
    XcdBarrier bar; bar.bar = ctl + CW_BAR; bar.x = 0; bar.st = nullptr;
    if (args.fused) bar = xcd_barrier_post(ctl + CW_BAR, MISC + 8);
#define SEAM() do { if (args.fused) xcd_barrier(bar); } while (0)
    const int lo = args.ph_lo, hi = args.ph_hi;
#define IN(k) (((MASK >> (k)) & 1u) && lo <= (k) && (k) < hi)

    float* X = args.out;
    bf16* HB = (bf16*)(ws + WS_HB); bf16* PROJ = (bf16*)(ws + WS_PROJ); float* MISCF = (float*)(ws + WS_MISCF);
    bf16* QC = (bf16*)(ws + WS_QC); bf16* KVC = (bf16*)(ws + WS_KVC); bf16* KR = (bf16*)(ws + WS_KR); float* DL = (float*)(ws + WS_DL);
    float* RSTD = (float*)(ws + WS_RSTD); bf16* OALL = (bf16*)(ws + WS_OALL); bf16* MERGED = (bf16*)(ws + WS_MERGED);
    f32x2* CS64 = (f32x2*)(ws + WS_CS64); f32x2* CS32 = (f32x2*)(ws + WS_CS32);
    bf16* HID = (bf16*)(ws + WS_HID); bf16* XG = (bf16*)(ws + WS_XG); bf16* PB = (bf16*)(ws + WS_PB); bf16* PP = (bf16*)(ws + WS_PP);
    unsigned* ROUTE = (unsigned*)(ws + WS_ROUTE); int* TOKS = (int*)(ws + WS_TOKS);
    const int* POS = (const int*)args.in[I_POS];

    if (IN(0) && args.l_lo == 0) {
        LAS float* scr = (LAS float*)lds;
        int jid = 0;
#define CONV(src, lds_, K, col0, ncols, dst, ldd, row0, mode, sub, gain, scale) do { conv_job(scr, src, lds_, K, col0, ncols, dst, ldd, row0, mode, sub, gain, scale, (bx + jid * 61) % G, G); ++jid; } while (0)
        for (int L = 0; L < DEPTH; ++L) {
            const float* win = args.in[I_WIN] + (size_t)L * D * IN_W; const float* gm = args.in[I_MIXN] + L * D;
            bf16* wt = (bf16*)(ws + WS_WIN) + (size_t)L * NPROJ * D;
            CONV(win, IN_W, D, S_FQ, 384, wt, D, C_FQ, 0, 0, gm, QS);
            CONV(win, IN_W, D, S_FK, 768, wt, D, C_FK, 0, 0, gm, 1.f);
            CONV(win, IN_W, D, S_DQ, 384, wt, D, C_DQ, 0, 0, gm, QS);
            CONV(win, IN_W, D, S_DK, 768, wt, D, C_DK, 0, 0, gm, 1.f);
            CONV(win, IN_W, D, S_CQ, 512, wt, D, C_CQ, 0, 0, gm, 1.f);
            CONV(win, IN_W, D, S_G, 3072, wt, D, C_G, 0, 0, gm, 1.f);
            CONV(win, IN_W, D, S_KR, 32, wt, D, C_MISC, 0, 0, gm, 1.f);
            CONV(win, IN_W, D, S_FZ, 6, wt, D, C_MISC + 32, 0, 0, gm, 1.f);
            zero_rows(wt, D, C_MISC + 38, NPROJ - (C_MISC + 38), D, gtid, NGT);
            const float* wuq = args.in[I_WUQ] + (size_t)L * 256 * 384; const float* gq = args.in[I_QN] + L * 256;
            bf16* wuqt = (bf16*)(ws + WS_WUQ) + (size_t)L * 512 * 256;
            const float* wukv = args.in[I_WUKV] + (size_t)L * 256 * 512; const float* gkv = args.in[I_KVN] + L * 256;
            bf16* wukvt = (bf16*)(ws + WS_WUKV) + (size_t)L * 512 * 256;
            for (int h = 0; h < 4; ++h) {
                CONV(wuq, 384, 256, h * 96, 64, wuqt, 256, h * 64, 0, 0, gq, MS);
                CONV(wuq, 384, 256, h * 96 + 64, 32, wuqt, 256, 256 + h * 32, 0, 0, gq, MS);
                CONV(wukv, 512, 256, h * 128, 64, wukvt, 256, h * 64, 0, 0, gkv, 1.f);
                CONV(wukv, 512, 256, h * 128 + 64, 64, wukvt, 256, 256 + h * 64, 0, 0, gkv, 1.f);
            }
            zero_rows(wuqt, 256, 384, 128, 256, gtid, NGT);
            bf16* wbr = (bf16*)(ws + WS_WBR) + (size_t)L * D * D;
            CONV(args.in[I_BRF] + (size_t)L * 384 * D, D, 384, 0, D, wbr, D, 0, 0, 0, nullptr, 1.f);
            CONV(args.in[I_BRD] + (size_t)L * 384 * D, D, 384, 0, D, wbr + 384, D, 0, 0, 0, nullptr, 1.f);
            CONV(args.in[I_BRM] + (size_t)L * 256 * D, D, 256, 0, D, wbr + 768, D, 0, 0, 0, nullptr, 1.f);
            CONV(args.in[I_WOUT] + (size_t)L * D * D, D, D, 0, D, (bf16*)(ws + WS_WOUT) + (size_t)L * D * D, D, 0, 0, 0, nullptr, 1.f);
            const float* gf = args.in[I_FFNN] + L * D; const int j = L >> 1;
            if ((L & 1) == 0) {
                bf16* wgu = (bf16*)(ws + WS_WGU) + (size_t)j * 2 * DFF * D;
                CONV(args.in[I_FG] + (size_t)j * D * DFF, DFF, D, 0, DFF, wgu, D, 0, 1, 0, gf, 1.f);
                CONV(args.in[I_FU] + (size_t)j * D * DFF, DFF, D, 0, DFF, wgu, D, 0, 1, 4, gf, 1.f);
                CONV(args.in[I_FD] + (size_t)j * DFF * D, D, DFF, 0, D, (bf16*)(ws + WS_WDN) + (size_t)j * D * DFF, DFF, 0, 0, 0, nullptr, 1.f);
            } else {
                for (int e = 0; e < NEXP; ++e) {
                    bf16* wgu = (bf16*)(ws + WS_WEGU) + (size_t)(j * NEXP + e) * 2 * DFE * D;
                    CONV(args.in[I_EG] + (size_t)(j * NEXP + e) * D * DFE, DFE, D, 0, DFE, wgu, D, 0, 1, 0, gf, 1.f);
                    CONV(args.in[I_EU] + (size_t)(j * NEXP + e) * D * DFE, DFE, D, 0, DFE, wgu, D, 0, 1, 4, gf, 1.f);
                    CONV(args.in[I_ED] + (size_t)(j * NEXP + e) * DFE * D, D, DFE, 0, D, (bf16*)(ws + WS_WEDN) + (size_t)(j * NEXP + e) * D * DFE, DFE, 0, 0, 0, nullptr, 1.f);
                }
            }
            CONV(args.in[I_WPG] + (size_t)L * D * D, D, D, 0, D, (bf16*)(ws + WS_WPG) + (size_t)L * D * D, D, 0, 0, 0, args.in[I_PLEN] + L * D, 1.f);
            CONV(args.in[I_WPP] + (size_t)L * 256 * D, D, 256, 0, D, (bf16*)(ws + WS_WPP) + (size_t)L * D * 256, 256, 0, 0, 0, nullptr, 1.f);
        }
#undef CONV
        { const f32x4* xs = (const f32x4*)args.in[I_X]; f32x4* xd = (f32x4*)X; for (int i = gtid; i < M * D / 4; i += NGT) xd[i] = xs[i]; }
        for (int i = gtid; i < M * 32; i += NGT) { const int row = i >> 5, j = i & 31; const float invf = powf(10000.0f, -(float)j / 32.0f); const float ang = (float)POS[row] * invf; float s, c; sincosf(ang, &s, &c); CS64[i] = (f32x2){c, s}; }
        for (int i = gtid; i < M * 16; i += NGT) { const int row = i >> 4, j = i & 15; const float invf = powf(10000.0f, -(float)j / 16.0f); const float ang = (float)POS[row] * invf; float s, c; sincosf(ang, &s, &c); CS32[i] = (f32x2){c, s}; }
        SEAM();
    }

    for (int L = args.l_lo; L < args.l_hi; ++L) {
        const int jl = L >> 1; const bool moe = (L & 1) != 0;
        unsigned* cnt = ctl + CW_CNT + 64 * jl;
        if (IN(1)) {
            for (int r = gw; r < M; r += NGW) { const f32x4* xr = (const f32x4*)(X + (size_t)r * D) + lane; f32x4 v[4];
#pragma unroll
                for (int j = 0; j < 4; ++j) v[j] = xr[64 * j];
                store_row_bf16(HB + (size_t)r * D, v, row_rstd(v), lane); }
            SEAM();
        }
        if (IN(2)) {
            pg8::Gemm g{HB, (const bf16*)(ws + WS_WIN) + (size_t)L * NPROJ * D, D, D, D}; pg8::StaticOrder S; S.init(M, NPROJ, G, bx, D, D);
            pg8::EpiProj E{PROJ, MISCF};
            pg8::gemm_phase(lds, g, S, E);
            SEAM();
        }
        if (IN(3)) {
            for (int i = gtid; i < M * 384; i += NGT) { const int row = i / 384, rem = i - row * 384, hd = rem >> 5, j = rem & 31;
                bf16* p = PROJ + (size_t)row * NPROJ + C_DQ + hd * 64 + j; const float a = bf2f(p[0]), b = bf2f(p[32]); const f32x2 cs = CS64[row * 32 + j];
                p[0] = (bf16)(cvt_pk_bf16(a * cs.x - b * cs.y, 0.f) & 0xffffu); p[32] = (bf16)(cvt_pk_bf16(b * cs.x + a * cs.y, 0.f) & 0xffffu); }
            for (int i = gtid; i < M * 16; i += NGT) { const int row = i >> 4, j = i & 15; const float a = MISCF[(size_t)row * 64 + j], b = MISCF[(size_t)row * 64 + 16 + j]; const f32x2 cs = CS32[i];
                KR[(size_t)row * 32 + j] = (bf16)(cvt_pk_bf16(a * cs.x - b * cs.y, 0.f) & 0xffffu); KR[(size_t)row * 32 + 16 + j] = (bf16)(cvt_pk_bf16(b * cs.x + a * cs.y, 0.f) & 0xffffu); }
            for (int i = gw; i < 2 * M; i += NGW) { const int which = i / M, row = i - which * M;
                const u32x2 w = *((const u32x2*)(PROJ + (size_t)row * NPROJ + (which ? C_CKV : C_CQ)) + lane);
                const float a = bf2f(w.x & 0xffffu), b = bf2f(w.x >> 16), c = bf2f(w.y & 0xffffu), d = bf2f(w.y >> 16);
                const float ss = wave_sum(a * a + b * b + c * c + d * d);
                if (lane == 0) RSTD[i] = 1.0f / sqrtf(ss * (1.0f / 256.0f) + EPS); }
            if (bx < 48) {
                LAS float* sc = (LAS float*)lds; const int b = bx / 6, h = bx % 6; const float bias = args.in[I_BF][L * 6 + h];
                float v[4], run = 0.f;
#pragma unroll
                for (int j = 0; j < 4; ++j) { const float z = MISCF[(size_t)(b * T + tid * 4 + j) * 64 + 32 + h] + bias; const float ls = fminf(z, 0.f) - log1pf(expf(-fabsf(z))); run += ls; v[j] = run; }
                sc[tid] = run; __syncthreads();
                for (int o = 1; o < NTHR; o <<= 1) { float add = (tid >= o) ? sc[tid - o] : 0.f; __syncthreads(); sc[tid] += add; __syncthreads(); }
                const float base = (tid > 0) ? sc[tid - 1] : 0.f;
#pragma unroll
                for (int j = 0; j < 4; ++j) DL[(size_t)bx * T + tid * 4 + j] = -LOG2E * (base + v[j]);
                __syncthreads();
            }
            SEAM();
        }
        if (IN(4)) {
            { pg8::Gemm g{PROJ + C_CQ, (const bf16*)(ws + WS_WUQ) + (size_t)L * 512 * 256, NPROJ, 256, 256}; pg8::StaticOrder S; S.init(M, 512, G, bx, NPROJ, 256);
              pg8::EpiStore E{QC, 512, RSTD}; pg8::gemm_phase(lds, g, S, E); }
            { pg8::Gemm g{PROJ + C_CKV, (const bf16*)(ws + WS_WUKV) + (size_t)L * 512 * 256, NPROJ, 256, 256}; pg8::StaticOrder S; S.init(M, 512, G, bx, NPROJ, 256);
              pg8::EpiStore E{KVC, 512, RSTD + M}; pg8::gemm_phase(lds, g, S, E); }
            SEAM();
        }
        if (IN(5)) {
            for (int i = gtid; i < M * 64; i += NGT) { const int row = i >> 6, rem = i & 63, hd = rem >> 4, j = rem & 15;
                bf16* p = QC + (size_t)row * 512 + 256 + hd * 32 + j; const float a = bf2f(p[0]), b = bf2f(p[16]); const f32x2 cs = CS32[row * 16 + j];
                p[0] = (bf16)(cvt_pk_bf16(a * cs.x - b * cs.y, 0.f) & 0xffffu); p[16] = (bf16)(cvt_pk_bf16(b * cs.x + a * cs.y, 0.f) & 0xffffu); }
            SEAM();
        }
        if (IN(6)) {
            const AttnPtrs AP{PROJ, QC, KVC, KR, DL, OALL};
            LAS float* qs = (LAS float*)lds + wave * 128;
            constexpr int nseq = BATCH * 16;
            constexpr int NBI = nseq * (T / 8);
            for (int it = bx; it < NBI; it += G) {
                const int seq = it >> 8, tb = (((it & 255) * 37) + seq * 101) & 255;
                const int b = seq >> 4, hh = seq & 15, t = tb * 8 + wave;
                if (hh < 6) naive_attn_item<0>(AP, b, hh, t, qs, lane);
                else if (hh < 12) naive_attn_item<1>(AP, b, hh - 6, t, qs, lane);
                else naive_attn_item<2>(AP, b, hh - 12, t, qs, lane);
            }
            SEAM();
        }
        if (IN(7)) {
            const bf16* wbr = (const bf16*)(ws + WS_WBR) + (size_t)L * D * D;
            { pg8::Gemm g{OALL, wbr, D, D, 384}; pg8::StaticOrder S; S.init(M, D, G, bx, D, D); pg8::EpiGated<true> E{MERGED, PROJ + C_G}; pg8::gemm_phase(lds, g, S, E); }
            { pg8::Gemm g{OALL + 384, wbr + 384, D, D, 384}; pg8::StaticOrder S; S.init(M, D, G, bx, D, D); pg8::EpiGated<false> E{MERGED, PROJ + C_G + 1024}; pg8::gemm_phase(lds, g, S, E); }
            { pg8::Gemm g{OALL + 768, wbr + 768, D, D, 256}; pg8::StaticOrder S; S.init(M, D, G, bx, D, D); pg8::EpiGated<false> E{MERGED, PROJ + C_G + 2048}; pg8::gemm_phase(lds, g, S, E); }
            SEAM();
        }
        if (IN(8)) {
            pg8::Gemm g{MERGED, (const bf16*)(ws + WS_WOUT) + (size_t)L * D * D, D, D, D}; pg8::StaticOrder S; S.init(M, D, G, bx, D, D);
            pg8::EpiResid E{X}; pg8::gemm_phase(lds, g, S, E);
            SEAM();
        }
        if (IN(9)) {
            const float* gf = args.in[I_FFNN] + L * D; const float* wr = args.in[I_WR] + (size_t)jl * D * NEXP;
            for (int r = gw; r < M; r += NGW) { const f32x4* xr = (const f32x4*)(X + (size_t)r * D) + lane; f32x4 v[4];
#pragma unroll
                for (int j = 0; j < 4; ++j) v[j] = xr[64 * j];
                const float rs = row_rstd(v);
                store_row_bf16(HB + (size_t)r * D, v, rs, lane);
                if (moe) {
                    float lg[8];
#pragma unroll
                    for (int e = 0; e < 8; ++e) lg[e] = 0.f;
#pragma unroll
                    for (int j = 0; j < 4; ++j) { const f32x4 gv = *((const f32x4*)gf + lane + 64 * j);
#pragma unroll
                        for (int q = 0; q < 4; ++q) { const int k = 4 * lane + 256 * j + q; const float hv = v[j][q] * rs * gv[q]; const f32x4 w0 = *(const f32x4*)(wr + (size_t)k * 8), w1 = *(const f32x4*)(wr + (size_t)k * 8 + 4);
                            lg[0] += hv * w0.x; lg[1] += hv * w0.y; lg[2] += hv * w0.z; lg[3] += hv * w0.w; lg[4] += hv * w1.x; lg[5] += hv * w1.y; lg[6] += hv * w1.z; lg[7] += hv * w1.w; } }
#pragma unroll
                    for (int e = 0; e < 8; ++e) lg[e] = wave_sum(lg[e]);
                    int e0 = 0; float l0 = lg[0];
#pragma unroll
                    for (int e = 1; e < 8; ++e) if (lg[e] > l0) { l0 = lg[e]; e0 = e; }
                    int e1 = -1; float l1 = -INFINITY;
#pragma unroll
                    for (int e = 0; e < 8; ++e) if (e != e0 && lg[e] > l1) { l1 = lg[e]; e1 = e; }
                    const float w1v = 1.0f / (1.0f + expf(l0 - l1)), w0v = 1.0f - w1v;
                    if (lane == 0) {
                        const unsigned r0 = __hip_atomic_fetch_add(cnt + e0, 1u, __ATOMIC_RELAXED, __HIP_MEMORY_SCOPE_AGENT);
                        const unsigned r1 = __hip_atomic_fetch_add(cnt + e1, 1u, __ATOMIC_RELAXED, __HIP_MEMORY_SCOPE_AGENT);
                        TOKS[e0 * M + r0] = r; TOKS[e1 * M + r1] = r;
                        unsigned* ro = ROUTE + (size_t)r * 8; ro[0] = e0; ro[1] = r0; ro[2] = __float_as_uint(w0v); ro[3] = e1; ro[4] = r1; ro[5] = __float_as_uint(w1v);
                    }
                }
            }
            SEAM();
        }
        pg8::MoeOrder MO;
        if (moe) { int c = 0;
#pragma unroll
            for (int e = 0; e < 8; ++e) { MO.cum[e] = c; c += (int)((__hip_atomic_load(cnt + e, __ATOMIC_RELAXED, __HIP_MEMORY_SCOPE_AGENT) + 255u) >> 8); }
            MO.cum[8] = c; MO.G = G; MO.c = bx; }
        if (IN(10)) {
            if (!moe) {
                pg8::Gemm g{HB, (const bf16*)(ws + WS_WGU) + (size_t)jl * 2 * DFF * D, D, D, D}; pg8::StaticOrder S; S.init(M, 2 * DFF, G, bx, D, D);
                pg8::EpiSwiGLU E{HID, DFF}; pg8::gemm_phase(lds, g, S, E);
            } else {
                for (int r = gw; r < M; r += NGW) { const unsigned* ro = ROUTE + (size_t)r * 8;
                    int o0 = 0, o1 = 0; const int e0 = (int)ro[0], e1 = (int)ro[3];
#pragma unroll
                    for (int e = 0; e < 8; ++e) { if (e == e0) o0 = MO.cum[e]; if (e == e1) o1 = MO.cum[e]; }
                    const size_t d0 = (size_t)o0 * 256 + ro[1], d1 = (size_t)o1 * 256 + ro[4];
                    const u32x4* src = (const u32x4*)(HB + (size_t)r * D) + lane; const u32x4 a = src[0], b2 = src[64];
                    u32x4* p0 = (u32x4*)(XG + d0 * D) + lane; p0[0] = a; p0[64] = b2;
                    u32x4* p1 = (u32x4*)(XG + d1 * D) + lane; p1[0] = a; p1[64] = b2; }
            }
            SEAM();
        }
        if (IN(11)) {
            if (!moe) {
                pg8::Gemm g{HID, (const bf16*)(ws + WS_WDN) + (size_t)jl * D * DFF, DFF, DFF, DFF}; pg8::StaticOrder S; S.init(M, D, G, bx, DFF, DFF);
                pg8::EpiResid E{X}; pg8::gemm_phase(lds, g, S, E);
            } else {
                pg8::Gemm g{XG, (const bf16*)(ws + WS_WEGU) + (size_t)jl * NEXP * 2 * DFE * D, D, D, D};
                MO.npn = 2 * DFE / 256; MO.ta = 256L * D * 2; MO.tb = 256L * D * 2; MO.eb = 2L * DFE * D * 2;
                pg8::EpiSwiGLU E{HID, DFE}; pg8::gemm_phase(lds, g, MO, E);
            }
            SEAM();
        }
        if (IN(12) && moe) {
            pg8::Gemm g{HID, (const bf16*)(ws + WS_WEDN) + (size_t)jl * NEXP * D * DFE, DFE, DFE, DFE};
            MO.npn = D / 256; MO.ta = 256L * DFE * 2; MO.tb = 256L * DFE * 2; MO.eb = (long)D * DFE * 2;
            pg8::EpiStore E{XG, D, nullptr}; pg8::gemm_phase(lds, g, MO, E);
            SEAM();
        }
        if (IN(13)) {
            for (int r = gw; r < M; r += NGW) { f32x4* xr = (f32x4*)(X + (size_t)r * D) + lane; f32x4 v[4];
#pragma unroll
                for (int j = 0; j < 4; ++j) v[j] = xr[64 * j];
                if (moe) { const unsigned* ro = ROUTE + (size_t)r * 8; int o0 = 0, o1 = 0; const int e0 = (int)ro[0], e1 = (int)ro[3];
#pragma unroll
                    for (int e = 0; e < 8; ++e) { if (e == e0) o0 = MO.cum[e]; if (e == e1) o1 = MO.cum[e]; }
                    const float w0 = __uint_as_float(ro[2]), w1 = __uint_as_float(ro[5]);
                    const u32x2* y0 = (const u32x2*)(XG + ((size_t)o0 * 256 + ro[1]) * D) + lane; const u32x2* y1 = (const u32x2*)(XG + ((size_t)o1 * 256 + ro[4]) * D) + lane;
#pragma unroll
                    for (int j = 0; j < 4; ++j) { const u32x2 a = y0[64 * j], b2 = y1[64 * j];
                        v[j].x += w0 * bf2f(a.x & 0xffffu) + w1 * bf2f(b2.x & 0xffffu); v[j].y += w0 * bf2f(a.x >> 16) + w1 * bf2f(b2.x >> 16);
                        v[j].z += w0 * bf2f(a.y & 0xffffu) + w1 * bf2f(b2.y & 0xffffu); v[j].w += w0 * bf2f(a.y >> 16) + w1 * bf2f(b2.y >> 16); xr[64 * j] = v[j]; } }
                store_row_bf16(HB + (size_t)r * D, v, row_rstd(v), lane); }
            { const f32x4* ps = (const f32x4*)(args.in[I_P] + (size_t)L * M * 256); u32x2* pd = (u32x2*)PB;
              for (int i = gtid; i < M * 64; i += NGT) { const f32x4 a = ps[i]; u32x2 w; w.x = cvt_pk_bf16(a.x, a.y); w.y = cvt_pk_bf16(a.z, a.w); pd[i] = w; } }
            SEAM();
        }
        if (IN(14)) {
            pg8::Gemm g{PB, (const bf16*)(ws + WS_WPP) + (size_t)L * D * 256, 256, 256, 256}; pg8::StaticOrder S; S.init(M, D, G, bx, 256, 256);
            pg8::EpiStore E{PP, D, nullptr}; pg8::gemm_phase(lds, g, S, E);
            SEAM();
        }
        if (IN(15)) {
            pg8::Gemm g{HB, (const bf16*)(ws + WS_WPG) + (size_t)L * D * D, D, D, D}; pg8::StaticOrder S; S.init(M, D, G, bx, D, D);
            pg8::EpiPle E{X, PP}; pg8::gemm_phase(lds, g, S, E);
            SEAM();
        }
    }
    if (IN(PH_FINAL) && args.l_hi == DEPTH) {
        const float* gn = args.in[I_FINN];
        for (int r = gw; r < M; r += NGW) { f32x4* xr = (f32x4*)(X + (size_t)r * D) + lane; f32x4 v[4];
#pragma unroll
            for (int j = 0; j < 4; ++j) v[j] = xr[64 * j];
            const float rs = row_rstd(v);
#pragma unroll
            for (int j = 0; j < 4; ++j) { const f32x4 gv = *((const f32x4*)gn + lane + 64 * j); xr[64 * j] = v[j] * rs * gv; } }
    }
#undef IN
#undef SEAM
}

typedef void (*kern_t)(Args);
template <int K> struct KTab { static void fill(kern_t* t) { t[K] = mk_fwd<(1u << K)>; KTab<K - 1>::fill(t); } };
template <> struct KTab<-1> { static void fill(kern_t*) {} };
extern "C" void kernel_launch(void* const* d_in, const int* in_sizes, int n_in, void* d_out, int out_size, void* d_ws, size_t ws_size, hipStream_t stream) {
    static int grid = 0; static kern_t tab[PH_FINAL + 1];
    if (grid == 0) {
        if (n_in != 26 || out_size != M * D || ws_size < WS_END) { fprintf(stderr, "kernel_launch: unexpected shapes / workspace (n_in %d out %d ws %zu need %zu)\n", n_in, out_size, ws_size, (size_t)WS_END); grid = -1; return; }
        int dev = 0, cus = 0;
        if (hipGetDevice(&dev) != hipSuccess || hipDeviceGetAttribute(&cus, hipDeviceAttributeMultiprocessorCount, dev) != hipSuccess) { grid = -1; return; }
        KTab<PH_FINAL>::fill(tab);
        for (int k = 0; k <= PH_FINAL; ++k)
            if (hipFuncSetAttribute((const void*)tab[k], hipFuncAttributeMaxDynamicSharedMemorySize, LDS_BYTES) != hipSuccess) { grid = -1; return; }
        (void)hipGetLastError();
        grid = cus;
    }
    if (grid < 0) return;
    (void)hipMemsetAsync((char*)d_ws + WS_CTL, 0, CTL_BYTES, stream);
    Args a{};
    for (int i = 0; i < 26; ++i) a.in[i] = (const float*)d_in[i];
    a.out = (float*)d_out; a.ws = (unsigned char*)d_ws; a.fused = 0; a.pad = 0;
    a.l_lo = 0; a.l_hi = 0; a.ph_lo = 0; a.ph_hi = 1;
    hipLaunchKernelGGL(tab[0], dim3(grid), dim3(NTHR), LDS_BYTES, stream, a);
    for (int L = 0; L < DEPTH; ++L)
        for (int ph = 1; ph <= 15; ++ph) {
            if (ph == 12 && !(L & 1)) continue;
            a.l_lo = L; a.l_hi = L + 1; a.ph_lo = ph; a.ph_hi = ph + 1;
            hipLaunchKernelGGL(tab[ph], dim3(grid), dim3(NTHR), LDS_BYTES, stream, a);
        }
    a.l_lo = DEPTH; a.l_hi = DEPTH; a.ph_lo = PH_FINAL; a.ph_hi = PH_FINAL + 1;
    hipLaunchKernelGGL(tab[PH_FINAL], dim3(grid), dim3(NTHR), LDS_BYTES, stream, a);
}
```

```cpp
#include <hip/hip_runtime.h>
#include <cstdio>
#include <cstdint>
#include <cmath>

#define GAS __attribute__((address_space(1)))
#define LAS __attribute__((address_space(3)))
typedef unsigned short bf16;
typedef unsigned u32x4 __attribute__((ext_vector_type(4)));
typedef unsigned u32x2 __attribute__((ext_vector_type(2)));
typedef float f32x4 __attribute__((ext_vector_type(4)));
typedef float f32x2 __attribute__((ext_vector_type(2)));
typedef short bf16x8 __attribute__((ext_vector_type(8)));
typedef int v4i_t __attribute__((ext_vector_type(4)));
typedef int v8i_t __attribute__((ext_vector_type(8)));

constexpr int BATCH = 8, T = 2048, D = 1024, DEPTH = 4, M = BATCH * T;
constexpr int NPROJ = 6144;
constexpr int C_FQ = 0, C_FK = 384, C_FV = 768, C_DQ = 1152, C_DK = 1536, C_DV = 1920, C_CQ = 2304, C_CKV = 2560, C_G = 2816, C_MISC = 5888;
constexpr int S_FQ = 0, S_FK = 384, S_FV = 768, S_FZ = 1152, S_DQ = 1158, S_DK = 1542, S_DV = 1926, S_CQ = 2310, S_CKV = 2566, S_KR = 2822, S_G = 2854, IN_W = 5926;
constexpr int DFF = 2816, DFE = 1408, NEXP = 8;
constexpr float LOG2E = 1.4426950408889634f;
constexpr float QS = 0.125f * LOG2E;
constexpr float MS = 0.10206207261596577f * LOG2E;
constexpr float EPS = 1e-6f;
constexpr int MOE_ROWS = 2 * M + NEXP * 256;

constexpr size_t MiB = 1u << 20;
constexpr size_t WS_CTL = 0, CTL_BYTES = 1 * MiB;
constexpr size_t WS_WIN = 1 * MiB;
constexpr size_t WS_WUQ = WS_WIN + 48 * MiB;
constexpr size_t WS_WUKV = WS_WUQ + 1 * MiB;
constexpr size_t WS_WBR = WS_WUKV + 1 * MiB;
constexpr size_t WS_WOUT = WS_WBR + 8 * MiB;
constexpr size_t WS_WGU = WS_WOUT + 8 * MiB;
constexpr size_t WS_WDN = WS_WGU + 22 * MiB;
constexpr size_t WS_WEGU = WS_WDN + 11 * MiB;
constexpr size_t WS_WEDN = WS_WEGU + 44 * MiB;
constexpr size_t WS_WPG = WS_WEDN + 22 * MiB;
constexpr size_t WS_WPP = WS_WPG + 8 * MiB;
constexpr size_t WS_HB = WS_WPP + 8 * MiB;
constexpr size_t WS_PROJ = WS_HB + 32 * MiB;
constexpr size_t WS_HID = WS_PROJ;
constexpr size_t WS_XG = WS_PROJ + 96 * MiB;
constexpr size_t WS_PB = WS_PROJ + 32 * MiB;
constexpr size_t WS_PP = WS_PROJ;
constexpr size_t WS_MISCF = WS_PROJ + 192 * MiB;
constexpr size_t WS_QC = WS_MISCF + 4 * MiB;
constexpr size_t WS_KVC = WS_QC + 16 * MiB;
constexpr size_t WS_KR = WS_KVC + 16 * MiB;
constexpr size_t WS_DL = WS_KR + 1 * MiB;
constexpr size_t WS_RSTD = WS_DL + 1 * MiB;
constexpr size_t WS_OALL = WS_RSTD + 1 * MiB;
constexpr size_t WS_MERGED = WS_OALL + 32 * MiB;
constexpr size_t WS_CS64 = WS_MERGED + 32 * MiB;
constexpr size_t WS_CS32 = WS_CS64 + 4 * MiB;
constexpr size_t WS_ROUTE = WS_CS32 + 2 * MiB;
constexpr size_t WS_TOKS = WS_ROUTE + 1 * MiB;
constexpr size_t WS_SSP = WS_TOKS + 1 * MiB;
constexpr size_t WS_RSG = WS_SSP + 3 * MiB;
constexpr size_t WS_RSL = WS_RSG;
constexpr size_t WS_FZ = WS_RSG + 1 * MiB;
constexpr size_t WS_SSC = WS_FZ + 1 * MiB;
constexpr size_t WS_XBN = WS_SSC + 1 * MiB;
constexpr size_t WS_PBALL = WS_XBN + 32 * MiB;
constexpr size_t WS_END = WS_PBALL + 32 * MiB;
constexpr int CW_BAR = 4096;
constexpr int CW_Q = 2048;
constexpr int CW_CNT = 1024;

__device__ __forceinline__ float bf2f(unsigned b) { return __uint_as_float(b << 16); }
typedef __bf16 bf16x2_b __attribute__((ext_vector_type(2)));
__device__ __forceinline__ unsigned cvt_pk_bf16(float lo, float hi) { const f32x2 v = {lo, hi}; const bf16x2_b b = __builtin_convertvector(v, bf16x2_b); return __builtin_bit_cast(unsigned, b); }
__device__ __forceinline__ unsigned pk4_fp8(float a, float b, float c, float d) {
    a = __builtin_amdgcn_fmed3f(a, -448.f, 448.f); b = __builtin_amdgcn_fmed3f(b, -448.f, 448.f); c = __builtin_amdgcn_fmed3f(c, -448.f, 448.f); d = __builtin_amdgcn_fmed3f(d, -448.f, 448.f);
    int p = __builtin_amdgcn_cvt_pk_fp8_f32(a, b, 0, false); p = __builtin_amdgcn_cvt_pk_fp8_f32(c, d, p, true); return (unsigned)p; }
__device__ __forceinline__ float fast_sigmoid(float x) { return __builtin_amdgcn_rcpf(1.0f + __builtin_amdgcn_exp2f(-LOG2E * x)); }
__device__ __forceinline__ float wave_sum(float v) {
#pragma unroll
    for (int o = 1; o < 64; o <<= 1) v += __shfl_xor(v, o);
    return v;
}
__device__ __forceinline__ float wave_max(float v) {
#pragma unroll
    for (int o = 1; o < 64; o <<= 1) v = fmaxf(v, __shfl_xor(v, o));
    return v;
}

__device__ __forceinline__ float rstd16(const float* sp) { const f32x4 a = ((const f32x4*)sp)[0], b = ((const f32x4*)sp)[1], c = ((const f32x4*)sp)[2], d = ((const f32x4*)sp)[3];
    const f32x4 s = (a + b) + (c + d); return 1.0f / sqrtf(((s.x + s.y) + (s.z + s.w)) * (1.0f / D) + EPS); }
namespace pg8 {
constexpr int BM = 256, BK = 64, HALF = 128, HTB = HALF * BK * 2, STAGE_BYTES = 8 * HTB, NXCD = 8, WGM = 8;
__host__ __device__ __forceinline__ int lds_byte(int r, int c) { const int st = (r >> 4) * 2 + (c >> 5), rr = r & 15, cc = c & 31, ob = rr * 64 + cc * 2; return st * 1024 + (ob ^ (((ob >> 9) & 1) << 5)); }
__host__ __device__ __forceinline__ void stage_rc(int b, int& R, int& C) { const int st = b / 1024, sb = b % 1024, swz = sb ^ (((sb >> 9) & 1) << 5); R = (st >> 1) * 16 + swz / 64; C = (st & 1) * 32 + (swz % 64) / 2; }
__host__ __device__ __forceinline__ int perm32(int rho) { const int n = rho >> 4, i = rho & 15; return 8 * (i >> 2) + 4 * n + (i & 3); }

struct Unit { int pm, pn, nt, tag; long aoff, boff; };
struct Gemm { const bf16* A; const bf16* Bt; int lda, ldb; };

__device__ __forceinline__ void tile_map(int wgid, int nM, int nN, int& pm, int& pn) {
    const int nwg = nM * nN; { const int q = nwg / NXCD, r = nwg % NXCD, xcd = wgid % NXCD, off = wgid / NXCD; wgid = (xcd < r ? xcd * (q + 1) : r * (q + 1) + (xcd - r) * q) + off; }
    const int nig = WGM * nN, gid = wgid / nig, fm = gid * WGM, gsz = (nM - fm) < WGM ? (nM - fm) : WGM;
    pm = fm + ((wgid % nig) % gsz); pn = (wgid % nig) / gsz;
}
struct StaticOrder {
    static constexpr bool GATHER = false, FP8 = false;
    int nM, nN, nwg, G, c, nt; long ta, tb;
    __device__ void init(int Mr, int N, int K, int G_, int c_, int lda, int ldb) { nM = Mr / BM; nN = N / BM; nwg = nM * nN; G = G_; c = c_; nt = K / BK; ta = 256L * lda * 2; tb = 256L * ldb * 2; }
    __device__ __forceinline__ bool next(int i, Unit& u) const {
        const long L = (long)i * G + c; if (L >= nwg) return false;
        tile_map((int)L, nM, nN, u.pm, u.pn); u.nt = nt; u.tag = 0; u.aoff = u.pm * ta; u.boff = u.pn * tb; return true;
    }
};
template <bool F8> struct SubsetOrder : StaticOrder {
    static constexpr bool FP8 = F8;
    int first, alt;
    __device__ __forceinline__ bool next(int i, Unit& u) const { if (!StaticOrder::next(i, u)) return false; u.pn = (alt >= 0 && u.pn == nN - 1) ? alt : first + u.pn; u.boff = u.pn * tb; return true; }
};
struct UpOrder {
    static constexpr bool GATHER = false, FP8 = false;
    int G, c;
    __device__ bool next(int i, Unit& u) const {
        const int L = i * G + c; if (L >= 256) return false;
        u.pm = L >> 2; u.pn = L & 3; u.nt = 4; u.tag = 0; u.aoff = u.pm * (256L * NPROJ * 2) + ((u.pn >= 2) ? 512 : 0); u.boff = u.pn * (256L * 256 * 2); return true;
    }
};
struct MergeOrder {
    static constexpr bool GATHER = false, FP8 = false;
    int G, c;
    __device__ bool next(int i, Unit& u) const {
        const int j = i / 3, sub = i - 3 * j; const int L = j * G + c; if (L >= 256) return false;
        tile_map(L, 64, 4, u.pm, u.pn); u.tag = sub; u.nt = (sub == 2) ? 4 : 6; const long ko = (sub == 0) ? 0 : (sub == 1 ? 768 : 1536);
        u.aoff = u.pm * (256L * D * 2) + ko; u.boff = u.pn * (256L * D * 2) + ko; return true;
    }
};
struct PleOrder {
    static constexpr bool GATHER = false, FP8 = false;
    int G, c; long a0, a1, b0, b1;
    __device__ bool next(int i, Unit& u) const {
        const int j = i >> 1, sub = i & 1; const int L = j * G + c; if (L >= 256) return false;
        tile_map(L, 64, 4, u.pm, u.pn); u.tag = sub; u.nt = sub ? 16 : 4;
        u.aoff = (sub ? a1 : a0) + u.pm * (256L * D * 2); u.boff = (sub ? b1 : b0) + u.pn * (256L * D * 2); return true;
    }
};
template <bool F8> struct PleSubOrder {
    static constexpr bool GATHER = false, FP8 = F8;
    int G, c, sub, nt; long a, b, ta, tb;
    __device__ __forceinline__ bool next(int i, Unit& u) const {
        const int L = i * G + c; if (L >= 256) return false;
        tile_map(L, 64, 4, u.pm, u.pn); u.tag = sub; u.nt = nt; u.aoff = a + u.pm * ta; u.boff = b + u.pn * tb; return true;
    }
};
struct MoeOrder {
    static constexpr bool GATHER = false, FP8 = false;
    int cum[9]; int npn, nt, G, c; long ta, tb, eb;
    __device__ __forceinline__ bool unit_tile(int i, int& tile, int& pn) const {
        if ((G & 7) == 0) { const int x = c & 7, idx = i * (G >> 3) + (c >> 3), ntx = (cum[8] - x + 7) >> 3; if (idx >= ntx * npn) return false; tile = x + 8 * (idx / npn); pn = idx % npn; return true; }
        const long L = (long)i * G + c; if (L >= (long)cum[8] * npn) return false;
        tile = (int)(L / npn); pn = (int)(L % npn); return true;
    }
    __device__ __forceinline__ bool next(int i, Unit& u) const {
        int tile, pn; if (!unit_tile(i, tile, pn)) return false;
        int e = 0;
#pragma unroll
        for (int k = 1; k < 8; ++k) e += (tile >= cum[k]) ? 1 : 0;
        u.pm = tile; u.pn = pn; u.nt = nt; u.tag = 0; u.aoff = tile * ta; u.boff = e * eb + pn * tb; return true;
    }
};

struct MoeGatherOrder : MoeOrder {
    static constexpr bool GATHER = true;
    __device__ __forceinline__ bool next(int i, Unit& u) const { if (!MoeOrder::next(i, u)) return false; u.aoff = 0; u.tag = i; return true; }
};
constexpr int TOK_TAB_OFF = 131072 + 8192;
constexpr int RSU_TAB_OFF = 131072 + 16384;

template <class T, class = void> struct epi_chain { static constexpr bool value = false; };
template <class T> struct epi_chain<T, decltype((void)T::CHAIN)> { static constexpr bool value = T::CHAIN; };
template <class Epi> __device__ __forceinline__ bool epi_keep(const Epi& E, const Unit& u) { if constexpr (epi_chain<Epi>::value) return E.keep(u); else return false; }
template <class Epi, class Sched>
__device__ __forceinline__ void gemm_phase(LAS unsigned char* lds, const Gemm g, const Sched& S, const Epi& E, int tid_) {
    int tid = tid_; asm volatile("" : "+v"(tid));
    const int wid = __builtin_amdgcn_readfirstlane(tid >> 6), lane = tid & 63, wr = wid >> 2, wc = wid & 3, fr = lane & 15, fq = lane >> 4;
    unsigned voffA[2], voffB[2];
#pragma unroll
    for (int i = 0; i < 2; ++i) { int R, C; stage_rc(tid * 16 + i * 8192, R, C); const int Rb = (R & ~31) + perm32(R & 31);
        voffA[i] = (unsigned)(R * g.lda + C) * 2u; voffB[i] = (unsigned)(Rb * g.ldb + C) * 2u; }
    const size_t kstep = (size_t)(BK * 2);
    const size_t hstepA = (size_t)HALF * g.lda * 2, hstepB = (size_t)HALF * g.ldb * 2;
    const unsigned ldsw = (unsigned)wid * 1024u;
    const int aoff = lds_byte(wr * 64 + fr, fq * 8), boff = lds_byte(wc * 32 + fr, fq * 8);
#define PG8_SA(b, h) (((b) * 2 + (h)) * HTB)
#define PG8_SB(b, h) ((4 + (b) * 2 + (h)) * HTB)
#define PG8_STAGE(bufoff, gbase, voff) do { _Pragma("unroll") for (int _i = 0; _i < 2; ++_i) \
        __builtin_amdgcn_global_load_lds((const unsigned*)((const char*)(gbase) + (voff)[_i]), (LAS unsigned*)(lds + (bufoff) + ldsw + _i * 8192), 16, 0, 0); } while (0)
#define PG8_STA(b, h, kb, nx) do { if constexpr (Sched::GATHER) { const LAS int* tt_ = (const LAS int*)(lds + TOK_TAB_OFF) + (ui + (((nx) && has_next) ? 1 : 0)) * 256 + (h) * HALF; unsigned v_[2]; \
            _Pragma("unroll") for (int i_ = 0; i_ < 2; ++i_) { int R_, C_; stage_rc(tid * 16 + i_ * 8192, R_, C_); v_[i_] = (unsigned)(tt_[R_] * g.lda + C_) * 2u; } PG8_STAGE(PG8_SA(b, h), (kb), v_); } \
        else PG8_STAGE(PG8_SA(b, h), (kb) + (h) * hstepA, voffA); } while (0)
#define PG8_LDA(dst, b, h) do { _Pragma("unroll") for (int m = 0; m < 4; ++m) { if constexpr (Sched::FP8) { dst##8[m].lo = *(const LAS v4i_t*)(lds + PG8_SA(b, h) + aoff + m * 2048); dst##8[m].hi = *(const LAS v4i_t*)(lds + PG8_SA(b, h) + aoff + m * 2048 + 1024); } \
        else { _Pragma("unroll") for (int k = 0; k < 2; ++k) dst[m][k] = *(const LAS bf16x8*)(lds + PG8_SA(b, h) + aoff + m * 2048 + k * 1024); } } } while (0)
#define PG8_LDB(dst, b, h) do { _Pragma("unroll") for (int n = 0; n < 2; ++n) { if constexpr (Sched::FP8) { dst##8[n].lo = *(const LAS v4i_t*)(lds + PG8_SB(b, h) + boff + n * 2048); dst##8[n].hi = *(const LAS v4i_t*)(lds + PG8_SB(b, h) + boff + n * 2048 + 1024); } \
        else { _Pragma("unroll") for (int k = 0; k < 2; ++k) dst[n][k] = *(const LAS bf16x8*)(lds + PG8_SB(b, h) + boff + n * 2048 + k * 1024); } } } while (0)
#define PG8_MMA(ai, bj, At, Bt) do { __builtin_amdgcn_s_setprio(1); _Pragma("unroll") for (int m = 0; m < 4; ++m) _Pragma("unroll") for (int n = 0; n < 2; ++n) { \
        if constexpr (Sched::FP8) asm volatile("v_mfma_f32_16x16x128_f8f6f4 %0, %1, %2, %0" : "+v"(acc[ai][bj][m][n]) : "v"(Bt##8[n]), "v"(At##8[m]));     \
        else { _Pragma("unroll") for (int k = 0; k < 2; ++k) acc[ai][bj][m][n] = __builtin_amdgcn_mfma_f32_16x16x32_bf16(Bt[n][k], At[m][k], acc[ai][bj][m][n], 0, 0, 0); } } \
        __builtin_amdgcn_s_setprio(0); } while (0)
#define PG8_WAIT_V(n) asm volatile("s_waitcnt vmcnt(" #n ")" ::: "memory")
#define PG8_WAIT_VR(r) asm volatile("s_cmp_eq_u32 %0, 0\n\ts_cbranch_scc1 1f\n\ts_waitcnt vmcnt(24)\n\ts_branch 2f\n1:\n\ts_waitcnt vmcnt(8)\n2:" :: "s"(r) : "memory", "scc")
#define PG8_WAIT_L(n) asm volatile("s_waitcnt lgkmcnt(" #n ")" ::: "memory")
#define PG8_BAR __builtin_amdgcn_s_barrier()
#define PG8_SCHED __builtin_amdgcn_sched_barrier(0)
    Unit cur, nxt; int ui = 0; bool has_next = false;
    if (!S.next(0, cur)) return;
    f32x4 acc[2][2][4][2];
#pragma unroll
    for (int a = 0; a < 2; ++a)
#pragma unroll
        for (int b = 0; b < 2; ++b)
#pragma unroll
            for (int m = 0; m < 4; ++m)
#pragma unroll
                for (int n = 0; n < 2; ++n) acc[a][b][m][n] = (f32x4){0.f, 0.f, 0.f, 0.f};
    bf16x8 At[4][2], B0[2][2], B1[2][2];
    v8i_t At8[4], B08[2], B18[2];
    const char* cA = (const char*)g.A + cur.aoff; const char* cB = (const char*)g.Bt + cur.boff;
    PG8_STAGE(PG8_SB(0, 0), cB, voffB); PG8_STAGE(PG8_SB(0, 1), cB + hstepB, voffB); PG8_STA(0, 0, cA, false); PG8_STA(0, 1, cA, false);
    if (wr == 1) PG8_BAR;
    PG8_WAIT_V(2); PG8_BAR;
    PG8_STAGE(PG8_SB(1, 0), cB + kstep, voffB); PG8_STA(1, 0, cA + kstep, false); PG8_STAGE(PG8_SB(1, 1), cB + hstepB + kstep, voffB);
    PG8_WAIT_V(6); PG8_BAR;
    for (;;) {
        has_next = S.next(ui + 1, nxt);
        const char* nA = has_next ? (const char*)g.A + nxt.aoff : cA; const char* nB = has_next ? (const char*)g.Bt + nxt.boff : cB;
        int nt = cur.nt; asm volatile("" : "+s"(nt));
        for (int t = 0; t < nt; t += 2) {
            const bool last = (t == nt - 2);
            const char* a1 = cA + (size_t)(t + 1) * kstep;
            const char* a2 = last ? nA : cA + (size_t)(t + 2) * kstep; const char* b2 = last ? nB : cB + (size_t)(t + 2) * kstep;
            const char* a3 = a2 + kstep; const char* b3 = b2 + kstep;
            int relax = __builtin_amdgcn_readfirstlane(((t == 0) & (ui > 0)) ? 1 : 0); asm volatile("" : "+s"(relax));
            PG8_LDB(B0, 0, 0); PG8_LDB(B1, 0, 1); PG8_SCHED; PG8_LDA(At, 0, 0); PG8_STA(1, 1, a1, false);
            PG8_WAIT_VR(relax);
            PG8_WAIT_L(0); PG8_BAR; PG8_MMA(0, 0, At, B0); PG8_MMA(0, 1, At, B1); PG8_BAR; PG8_SCHED;
            PG8_LDA(At, 0, 1); PG8_STAGE(PG8_SB(0, 0), b2, voffB); PG8_STAGE(PG8_SB(0, 1), b2 + hstepB, voffB); PG8_STA(0, 0, a2, last);
            PG8_WAIT_VR(relax);
            PG8_WAIT_L(0); PG8_BAR; PG8_MMA(1, 0, At, B0); PG8_MMA(1, 1, At, B1); PG8_BAR; PG8_SCHED;
            PG8_LDB(B0, 1, 0); PG8_LDB(B1, 1, 1); PG8_SCHED; PG8_LDA(At, 1, 0); PG8_STA(0, 1, a2, last);
            PG8_WAIT_V(8); PG8_WAIT_L(0); PG8_BAR; PG8_MMA(0, 0, At, B0); PG8_MMA(0, 1, At, B1); PG8_BAR; PG8_SCHED;
            PG8_LDA(At, 1, 1); PG8_STAGE(PG8_SB(1, 0), b3, voffB); PG8_STAGE(PG8_SB(1, 1), b3 + hstepB, voffB); PG8_STA(1, 0, a3, last);
            PG8_WAIT_V(8); PG8_WAIT_L(0); PG8_BAR; PG8_MMA(1, 0, At, B0); PG8_MMA(1, 1, At, B1); PG8_BAR; PG8_SCHED;
        }
        if constexpr (Sched::FP8) asm volatile("s_nop 15\n\ts_nop 7" ::: "memory");
        if (wr == 0) PG8_BAR;
        if constexpr (Epi::PRE) { E.pre(cur, lds, tid); asm volatile("s_waitcnt lgkmcnt(0)" ::: "memory"); PG8_BAR; }
        if constexpr (epi_chain<Epi>::value) E.chain(acc, cur, wr, wc, fr, fq, lds); else E(acc, cur, wr, wc, fr, fq, lds);
        if (!has_next) break;
        if (!epi_keep(E, cur))
#pragma unroll
        for (int a = 0; a < 2; ++a)
#pragma unroll
            for (int b = 0; b < 2; ++b)
#pragma unroll
                for (int m = 0; m < 4; ++m)
#pragma unroll
                    for (int n = 0; n < 2; ++n) acc[a][b][m][n] = (f32x4){0.f, 0.f, 0.f, 0.f};
        cur = nxt; cA = nA; cB = nB; ++ui;
        if (wr == 1) PG8_BAR;
    }
    PG8_WAIT_V(0);
    PG8_BAR;
#undef PG8_SA
#undef PG8_SB
#undef PG8_STAGE
#undef PG8_LDA
#undef PG8_STA
#undef PG8_LDB
#undef PG8_MMA
#undef PG8_WAIT_V
#undef PG8_WAIT_VR
#undef PG8_WAIT_L
#undef PG8_BAR
#undef PG8_SCHED
}

constexpr int RS_TAB_OFF = 131072 + 4096;
__device__ __forceinline__ u32x4 pack8(f32x4 v0, f32x4 v1) { u32x4 w; w.x = cvt_pk_bf16(v0[0], v0[1]); w.y = cvt_pk_bf16(v0[2], v0[3]); w.z = cvt_pk_bf16(v1[0], v1[1]); w.w = cvt_pk_bf16(v1[2], v1[3]); return w; }
__device__ __forceinline__ void unpack8(u32x4 w, f32x4& a, f32x4& b) {
    a = (f32x4){bf2f(w.x & 0xffffu), bf2f(w.x >> 16), bf2f(w.y & 0xffffu), bf2f(w.y >> 16)};
    b = (f32x4){bf2f(w.z & 0xffffu), bf2f(w.z >> 16), bf2f(w.w & 0xffffu), bf2f(w.w >> 16)}; }
__device__ __forceinline__ float sq8(f32x4 a, f32x4 b) { return ((a.x * a.x + a.y * a.y) + (a.z * a.z + a.w * a.w)) + ((b.x * b.x + b.y * b.y) + (b.z * b.z + b.w * b.w)); }
__device__ __forceinline__ float rstd16f(const float* sp) { const f32x4 a = ((const GAS f32x4*)sp)[0], b = ((const GAS f32x4*)sp)[1], c = ((const GAS f32x4*)sp)[2], d = ((const GAS f32x4*)sp)[3];
    const f32x4 s = (a + b) + (c + d); return __builtin_amdgcn_rsqf(((s.x + s.y) + (s.z + s.w)) * (1.0f / D) + EPS); }
__device__ __forceinline__ void rope4(f32x4& v0, f32x4& v1, const f32x2* cs) {
    const f32x4 a = ((const GAS f32x4*)cs)[0], b = ((const GAS f32x4*)cs)[1]; float x1, x2;
    x1 = v0[0]; x2 = v0[1]; v0[0] = x1 * a.x - x2 * a.y; v0[1] = x2 * a.x + x1 * a.y;
    x1 = v0[2]; x2 = v0[3]; v0[2] = x1 * a.z - x2 * a.w; v0[3] = x2 * a.z + x1 * a.w;
    x1 = v1[0]; x2 = v1[1]; v1[0] = x1 * b.x - x2 * b.y; v1[1] = x2 * b.x + x1 * b.y;
    x1 = v1[2]; x2 = v1[3]; v1[2] = x1 * b.z - x2 * b.w; v1[3] = x2 * b.z + x1 * b.w;
}
#define EPI_HEAD const int row0 = u.pm * BM + wr * 64 + fr, ct0 = wc * 32 + 8 * fq, pn = u.pn; (void)pn; const LAS float* rstab = (const LAS float*)(lds + RS_TAB_OFF) + wr * 64 + fr; (void)rstab;
#define EPI_ARGS const f32x4 (&acc)[2][2][4][2], const Unit& u, int wr, int wc, int fr, int fq, LAS unsigned char* lds
#define EPI_FOR_ROWS _Pragma("unroll") for (int ai = 0; ai < 2; ++ai) _Pragma("unroll") for (int m = 0; m < 4; ++m)
#define EPI_FOR_BJ _Pragma("unroll") for (int bj = 0; bj < 2; ++bj)
#define EPI_RS(ai, m) rstab[(ai) * HALF + (m) * 16]

struct EpiProj3 {
    static constexpr bool PRE = true;
    bf16* P; bf16* KR; float* FZ; float* SSC; const float* SSP; const f32x2* CS64; const f32x2* CS32;
    __device__ __forceinline__ void pre(const Unit& u, LAS unsigned char* lds, int tid) const { if (tid < 256) ((LAS float*)(lds + RS_TAB_OFF))[tid] = rstd16f(SSP + (size_t)(u.pm * BM + tid) * 16); }
    __device__ __forceinline__ void operator()(EPI_ARGS) const {
        EPI_HEAD
        const bool sig = (pn >= 11 && pn < 23), misc = (pn == 23), lat = (pn == 9 || pn == 10);
        if (sig) {
            EPI_FOR_ROWS { const int row = row0 + ai * HALF + m * 16; const float rsn = EPI_RS(ai, m) * (-LOG2E); const float k255 = 1.0f / 255.0f;
                EPI_FOR_BJ { const int col = pn * BM + bj * HALF + ct0; u32x2 q = {0u, 0u};
#pragma unroll
                    for (int e = 0; e < 4; ++e) {
                        q.x = __builtin_amdgcn_cvt_pk_u8_f32(__builtin_amdgcn_rcpf(__builtin_fmaf(__builtin_amdgcn_exp2f(acc[ai][bj][m][0][e] * rsn), k255, k255)), e, q.x);
                        q.y = __builtin_amdgcn_cvt_pk_u8_f32(__builtin_amdgcn_rcpf(__builtin_fmaf(__builtin_amdgcn_exp2f(acc[ai][bj][m][1][e] * rsn), k255, k255)), e, q.y); }
                    *(GAS u32x2*)((GAS unsigned char*)P + (size_t)row * (NPROJ * 2) + 2 * C_G + (col - C_G)) = q; } }
            return;
        }
        EPI_FOR_ROWS { const int row = row0 + ai * HALF + m * 16; const float rs = EPI_RS(ai, m); float ssq = 0.f;
            EPI_FOR_BJ { const int tc = bj * HALF + ct0, col = pn * BM + tc; f32x4 v0 = acc[ai][bj][m][0] * rs, v1 = acc[ai][bj][m][1] * rs;
                const int seg = col >> 6; const bool rope = (seg >= 18 && seg < 30), krt = (misc && bj == 0 && wc == 0);
                if (rope) rope4(v0, v1, CS64 + (size_t)row * 32 + ((col & 63) >> 1));
                if (krt) rope4(v0, v1, CS32 + (size_t)row * 16 + 4 * fq);
                if (lat) ssq += sq8(v0, v1);
                const u32x4 w = pack8(v0, v1);
                *(GAS u32x4*)(P + (size_t)row * NPROJ + col) = w;
                if (krt) *(GAS u32x4*)(KR + (size_t)row * 32 + 8 * fq) = w;
                if (misc && bj == 0 && wc == 1 && fq == 0) { float* fp = FZ + (size_t)row * 8; *(f32x4*)fp = v0; *(GAS f32x4*)(fp + 4) = v1; }
            }
            if (lat) { ssq += __shfl_xor(ssq, 16); ssq += __shfl_xor(ssq, 32); if (fq == 0) ((GAS float*)SSC)[((size_t)(pn - 9) * M + row) * 4 + wc] = ssq; }
        }
    }
};
struct EpiGate {
    static constexpr bool PRE = true;
    bf16* P; const float* SSP; float wscale;
    __device__ __forceinline__ void pre(const Unit& u, LAS unsigned char* lds, int tid) const { if (tid < 256) ((LAS float*)(lds + RS_TAB_OFF))[tid] = rstd16f(SSP + (size_t)(u.pm * BM + tid) * 16); }
    __device__ __forceinline__ void operator()(EPI_ARGS) const {
        EPI_HEAD
        EPI_FOR_ROWS { const int row = row0 + ai * HALF + m * 16; const float rsn = EPI_RS(ai, m) * (-LOG2E) * wscale; const float k255 = 1.0f / 255.0f;
            EPI_FOR_BJ { const int gcol = pn * BM + bj * HALF + ct0; u32x2 q = {0u, 0u};
#pragma unroll
                for (int e = 0; e < 4; ++e) {
                    q.x = __builtin_amdgcn_cvt_pk_u8_f32(__builtin_amdgcn_rcpf(__builtin_fmaf(__builtin_amdgcn_exp2f(acc[ai][bj][m][0][e] * rsn), k255, k255)), e, q.x);
                    q.y = __builtin_amdgcn_cvt_pk_u8_f32(__builtin_amdgcn_rcpf(__builtin_fmaf(__builtin_amdgcn_exp2f(acc[ai][bj][m][1][e] * rsn), k255, k255)), e, q.y); }
                *(GAS u32x2*)((GAS unsigned char*)P + (size_t)row * (NPROJ * 2) + 2 * C_G + gcol) = q; } }
    }
};
struct EpiUp {
    static constexpr bool PRE = true;
    bf16* QC; bf16* KVC; const float* SSC; const f32x2* CS32;
    __device__ __forceinline__ void pre(const Unit& u, LAS unsigned char* lds, int tid) const {
        if (tid < 256) { const f32x4 sp = *(const GAS f32x4*)(SSC + ((size_t)(u.pn >> 1) * M + u.pm * BM + tid) * 4);
            ((LAS float*)(lds + RS_TAB_OFF))[tid] = __builtin_amdgcn_rsqf(((sp.x + sp.y) + (sp.z + sp.w)) * (1.0f / 256.0f) + EPS); } }
    __device__ __forceinline__ void operator()(EPI_ARGS) const {
        EPI_HEAD
        bf16* const dbase = ((pn < 2) ? QC : KVC) + (pn & 1) * 256;
        EPI_FOR_ROWS { const int row = row0 + ai * HALF + m * 16; const float rs = EPI_RS(ai, m);
            EPI_FOR_BJ { const int tc = bj * HALF + ct0; f32x4 v0 = acc[ai][bj][m][0] * rs, v1 = acc[ai][bj][m][1] * rs;
                if (pn == 1 && bj == 0) rope4(v0, v1, CS32 + (size_t)row * 16 + 4 * fq);
                *(GAS u32x4*)(dbase + (size_t)row * 512 + tc) = pack8(v0, v1);
            } }
    }
};
struct EpiMerge {
    static constexpr bool PRE = false;
    bf16* O; const bf16* gate;
    __device__ __forceinline__ void pre(const Unit&, LAS unsigned char*, int) const {}
    __device__ __forceinline__ void operator()(EPI_ARGS) const {
        EPI_HEAD
#pragma unroll
        for (int ai = 0; ai < 2; ++ai) { u32x2 gin[4][2]; u32x4 oin[4][2];
#pragma unroll
            for (int m = 0; m < 4; ++m) EPI_FOR_BJ { const size_t row = (size_t)(row0 + ai * HALF + m * 16); const int col = pn * BM + bj * HALF + ct0;
                gin[m][bj] = *(const GAS u32x2*)((const GAS unsigned char*)gate + row * (NPROJ * 2) + u.tag * 1024 + col); oin[m][bj] = (u.tag != 0) ? *(const GAS u32x4*)(O + row * D + col) : (u32x4){0u, 0u, 0u, 0u}; }
#pragma unroll
            for (int m = 0; m < 4; ++m) EPI_FOR_BJ { const size_t row = (size_t)(row0 + ai * HALF + m * 16); const int col = pn * BM + bj * HALF + ct0;
                f32x4 g0, g1, o0, o1; unpack8(oin[m][bj], o0, o1); const unsigned ga = gin[m][bj].x, gb = gin[m][bj].y; const float k255 = 1.0f / 255.0f;
                g0 = (f32x4){(float)(ga & 255u), (float)((ga >> 8) & 255u), (float)((ga >> 16) & 255u), (float)(ga >> 24)} * k255; g1 = (f32x4){(float)(gb & 255u), (float)((gb >> 8) & 255u), (float)((gb >> 16) & 255u), (float)(gb >> 24)} * k255;
                *(GAS u32x4*)(O + row * D + col) = pack8(acc[ai][bj][m][0] * g0 + o0, acc[ai][bj][m][1] * g1 + o1); } }
    }
};
struct EpiMergeChain {
    static constexpr bool PRE = false, CHAIN = true;
    bf16* O; const bf16* gate;
    __device__ __forceinline__ void pre(const Unit&, LAS unsigned char*, int) const {}
    __device__ __forceinline__ bool keep(const Unit& u) const { return u.tag < 2; }
    static __device__ __forceinline__ void dec8(u32x2 w, bool clamp, f32x4& a, f32x4& b) {
        a = (f32x4){(float)(w.x & 255u), (float)((w.x >> 8) & 255u), (float)((w.x >> 16) & 255u), (float)(w.x >> 24)}; b = (f32x4){(float)(w.y & 255u), (float)((w.y >> 8) & 255u), (float)((w.y >> 16) & 255u), (float)(w.y >> 24)};
        if (clamp) {
#pragma unroll
            for (int e = 0; e < 4; ++e) { a[e] = __builtin_fmaxf(a[e], 1.0f); b[e] = __builtin_fmaxf(b[e], 1.0f); } } }
    __device__ __forceinline__ void chain(f32x4 (&acc)[2][2][4][2], const Unit& u, int wr, int wc, int fr, int fq, LAS unsigned char* lds) const {
        EPI_HEAD
        const int tg = u.tag; const bool last = tg == 2;
#pragma unroll
        for (int ai = 0; ai < 2; ++ai) { u32x2 gc[4][2], gn[4][2];
#pragma unroll
            for (int m = 0; m < 4; ++m) EPI_FOR_BJ { const size_t row = (size_t)(row0 + ai * HALF + m * 16); const int col = pn * BM + bj * HALF + ct0;
                const GAS unsigned char* gp = (const GAS unsigned char*)gate + row * (NPROJ * 2) + tg * 1024 + col;
                gc[m][bj] = *(const GAS u32x2*)gp; gn[m][bj] = last ? (u32x2){0u, 0u} : *(const GAS u32x2*)(gp + 1024); }
#pragma unroll
            for (int m = 0; m < 4; ++m) EPI_FOR_BJ { const size_t row = (size_t)(row0 + ai * HALF + m * 16); const int col = pn * BM + bj * HALF + ct0;
                f32x4 c0, c1, n0, n1; dec8(gc[m][bj], tg != 0, c0, c1);
                if (!last) { dec8(gn[m][bj], true, n0, n1);
#pragma unroll
                    for (int e = 0; e < 4; ++e) { acc[ai][bj][m][0][e] *= c0[e] * __builtin_amdgcn_rcpf(n0[e]); acc[ai][bj][m][1][e] *= c1[e] * __builtin_amdgcn_rcpf(n1[e]); } }
                if (last) { const float k255 = 1.0f / 255.0f; *(GAS u32x4*)(O + row * D + col) = pack8(acc[ai][bj][m][0] * (c0 * k255), acc[ai][bj][m][1] * (c1 * k255)); } } }
    }
};
template <bool Q8> struct EpiResidX {
    static constexpr bool PRE = false;
    const bf16* XBi; bf16* XBo; float* SSPo; unsigned char* XQ8; float ascale;
    __device__ __forceinline__ void pre(const Unit&, LAS unsigned char*, int) const {}
    __device__ __forceinline__ void operator()(EPI_ARGS) const {
        EPI_HEAD
#pragma unroll
        for (int ai = 0; ai < 2; ++ai) { u32x4 xin[4][2];
#pragma unroll
            for (int m = 0; m < 4; ++m) EPI_FOR_BJ xin[m][bj] = *(const GAS u32x4*)(XBi + (size_t)(row0 + ai * HALF + m * 16) * D + pn * BM + bj * HALF + ct0);
#pragma unroll
            for (int m = 0; m < 4; ++m) { const int row = row0 + ai * HALF + m * 16; float ss = 0.f;
                EPI_FOR_BJ { const int col = pn * BM + bj * HALF + ct0; f32x4 x0, x1; unpack8(xin[m][bj], x0, x1);
                    x0 = x0 + acc[ai][bj][m][0] * ascale; x1 = x1 + acc[ai][bj][m][1] * ascale;
                    *(GAS u32x4*)(XBo + (size_t)row * D + col) = pack8(x0, x1); ss += sq8(x0, x1);
                    if (Q8) { u32x2 q8; q8.x = pk4_fp8(x0[0], x0[1], x0[2], x0[3]); q8.y = pk4_fp8(x1[0], x1[1], x1[2], x1[3]); *(GAS u32x2*)(XQ8 + (size_t)row * D + col) = q8; } }
                ss += __shfl_xor(ss, 16); ss += __shfl_xor(ss, 32); if (fq == 0) ((GAS float*)SSPo)[(size_t)row * 16 + pn * 4 + wc] = ss; } }
    }
};
template <bool GATH, bool F8O = false> struct EpiSwiGLU2 {
    static constexpr bool PRE = !GATH;
    bf16* Hd; int ldh; const float* rsp;
    __device__ __forceinline__ void pre(const Unit& u, LAS unsigned char* lds, int tid) const {
        if (tid < 256) ((LAS float*)(lds + RS_TAB_OFF))[tid] = rstd16f(rsp + (size_t)(u.pm * BM + tid) * 16); }
    __device__ __forceinline__ void operator()(EPI_ARGS) const {
        EPI_HEAD
        const LAS float* rsu = (const LAS float*)(lds + RSU_TAB_OFF) + u.tag * 256 + wr * 64 + fr;
        EPI_FOR_ROWS { const int row = row0 + ai * HALF + m * 16; const float rs = GATH ? rsu[ai * HALF + m * 16] : EPI_RS(ai, m);
            EPI_FOR_BJ { const int col = pn * BM + bj * HALF + ct0; const f32x4 g = acc[ai][bj][m][0] * rs, up = acc[ai][bj][m][1] * rs; f32x4 h;
#pragma unroll
                for (int e = 0; e < 4; ++e) h[e] = g[e] * fast_sigmoid(g[e]) * up[e];
                if (F8O) *(GAS unsigned*)((GAS unsigned char*)Hd + (size_t)row * ldh + (col >> 1)) = pk4_fp8(h[0] * 8.f, h[1] * 8.f, h[2] * 8.f, h[3] * 8.f);
                else { u32x2 w; w.x = cvt_pk_bf16(h[0], h[1]); w.y = cvt_pk_bf16(h[2], h[3]); *(GAS u32x2*)(Hd + (size_t)row * ldh + (col >> 1)) = w; } } }
    }
};
struct EpiStore {
    static constexpr bool PRE = false;
    bf16* O; int ldc;
    __device__ __forceinline__ void pre(const Unit&, LAS unsigned char*, int) const {}
    __device__ __forceinline__ void operator()(EPI_ARGS) const {
        EPI_HEAD
        EPI_FOR_ROWS { const int row = row0 + ai * HALF + m * 16;
            EPI_FOR_BJ { const int col = pn * BM + bj * HALF + ct0; *(GAS u32x4*)(O + (size_t)row * ldc + col) = pack8(acc[ai][bj][m][0], acc[ai][bj][m][1]); } }
    }
};
struct EpiPle3 {
    static constexpr bool PRE = true;
    const bf16* XBi; bf16* XBo; bf16* PPS; const float* SSPi; float* SSPo; unsigned char* XQ8; float wscale;
    __device__ __forceinline__ void pre(const Unit& u, LAS unsigned char* lds, int tid) const { if (u.tag != 0 && tid < 256) ((LAS float*)(lds + RS_TAB_OFF))[tid] = rstd16f(SSPi + (size_t)(u.pm * BM + tid) * 16) * wscale; }
    __device__ __forceinline__ void operator()(EPI_ARGS) const {
        EPI_HEAD
        if (u.tag == 0) {
            EPI_FOR_ROWS { const int row = row0 + ai * HALF + m * 16;
                EPI_FOR_BJ { const int col = pn * BM + bj * HALF + ct0; *(GAS u32x4*)(PPS + (size_t)row * D + col) = pack8(acc[ai][bj][m][0], acc[ai][bj][m][1]); } }
        } else {
#pragma unroll
            for (int aq = 0; aq < 4; ++aq) { const int ai = aq >> 1, m0 = (aq & 1) * 2; u32x4 xin[4][2], pin[4][2];
#pragma unroll
                for (int m = m0; m < m0 + 2; ++m) EPI_FOR_BJ { const size_t off = (size_t)(row0 + ai * HALF + m * 16) * D + pn * BM + bj * HALF + ct0; xin[m][bj] = *(const GAS u32x4*)(XBi + off); pin[m][bj] = *(const GAS u32x4*)(PPS + off); }
#pragma unroll
                for (int m = m0; m < m0 + 2; ++m) { const int row = row0 + ai * HALF + m * 16; const float rs = EPI_RS(ai, m); float ss = 0.f;
                    EPI_FOR_BJ { const int col = pn * BM + bj * HALF + ct0; f32x4 p0, p1, x0, x1; unpack8(pin[m][bj], p0, p1); unpack8(xin[m][bj], x0, x1);
                        const f32x4 v0 = acc[ai][bj][m][0] * rs, v1 = acc[ai][bj][m][1] * rs;
#pragma unroll
                        for (int e = 0; e < 4; ++e) { x0[e] += fast_sigmoid(v0[e]) * p0[e]; x1[e] += fast_sigmoid(v1[e]) * p1[e]; }
                        *(GAS u32x4*)(XBo + (size_t)row * D + col) = pack8(x0, x1); ss += sq8(x0, x1);
                        { u32x2 q8; q8.x = pk4_fp8(x0[0], x0[1], x0[2], x0[3]); q8.y = pk4_fp8(x1[0], x1[1], x1[2], x1[3]); *(GAS u32x2*)(XQ8 + (size_t)row * D + col) = q8; } }
                    ss += __shfl_xor(ss, 16); ss += __shfl_xor(ss, 32); if (fq == 0) ((GAS float*)SSPo)[(size_t)row * 16 + pn * 4 + wc] = ss; } }
        }
    }
};
}

#define XB_TMO      128
#define XB_XCNT(j)  (256  + 64 * (j))
#define XB_XSUB(j)  (1280 + 64 * (j))
#define XB_XGEN(j)  (2304 + 64 * (j))
#define XB_TOP      3328
#define XB_TOPGEN   3392
#define XCD_BAR_WORDS 3456
#define XB_SPIN_CAP (1u << 18)
__device__ __forceinline__ unsigned xb_ld(unsigned* p)              { return __hip_atomic_load(p, __ATOMIC_RELAXED, __HIP_MEMORY_SCOPE_AGENT); }
__device__ __forceinline__ unsigned xb_add(unsigned* p, unsigned v) { return __hip_atomic_fetch_add(p, v, __ATOMIC_RELAXED, __HIP_MEMORY_SCOPE_AGENT); }
__device__ __forceinline__ unsigned xb_xcc_id() { return (unsigned)__builtin_amdgcn_s_getreg((3 << 11) | 20) & 0xFu; }
#define XB_SPIN(cond, bar) do { unsigned _sp = 0; while (cond) { __builtin_amdgcn_s_sleep(1); \
    if ((++_sp & 255u) == 0u) { if (xb_ld(&(bar)[XB_TMO])) break; if (_sp > XB_SPIN_CAP) { atomicAdd(&(bar)[XB_TMO], 1u); break; } } } } while (0)
struct XcdBarrier { unsigned* bar; unsigned x; volatile LAS unsigned* st; };
__device__ __forceinline__ XcdBarrier xcd_barrier_post(unsigned* bar, volatile LAS unsigned* st) {
    XcdBarrier b; b.bar = bar; b.x = xb_xcc_id(); b.st = st;
    if (threadIdx.x == 0) (void)xb_add(&bar[XB_XCNT(b.x)], 1u);
    return b;
}
__device__ __forceinline__ void xcd_barrier_complete(unsigned* bar, unsigned x, unsigned& nloc, unsigned& nx) {
    const unsigned G = gridDim.x * gridDim.y * gridDim.z;
    unsigned sum, cnt, mine, sp = 0u;
    for (;;) {
        sum = 0u; cnt = 0u; mine = 0u;
#pragma unroll
        for (unsigned j = 0; j < 16; ++j) { const unsigned c = xb_ld(&bar[XB_XCNT(j)]); sum += c; cnt += (c > 0u) ? 1u : 0u; mine = (j == x) ? c : mine; }
        if (sum == G) break;
        __builtin_amdgcn_s_sleep(1);
        if ((++sp & 255u) == 0u) { if (xb_ld(&bar[XB_TMO])) break; if (sp > XB_SPIN_CAP) { atomicAdd(&bar[XB_TMO], 1u); break; } }
    }
    nloc = mine > 0u ? mine : 1u; nx = cnt > 0u ? cnt : 1u;
}
__device__ __forceinline__ void xcd_barrier(const XcdBarrier& b, bool leader) {
    asm volatile("s_waitcnt vmcnt(0)" ::: "memory");
    __syncthreads();
    if (leader) {
        unsigned* bar = b.bar;
        __builtin_amdgcn_s_waitcnt(0);
        unsigned nloc = b.st[0], nx = b.st[1];
        if (nloc == 0u) { xcd_barrier_complete(bar, b.x, nloc, nx); b.st[0] = nloc; b.st[1] = nx; }
        const unsigned old = xb_add(&bar[XB_XSUB(b.x)], 1u);
        const unsigned gen = old / nloc;
        if (old + 1u == (gen + 1u) * nloc) {
            __builtin_amdgcn_fence(__ATOMIC_RELEASE, "agent");
            asm volatile("s_waitcnt vmcnt(0)" ::: "memory");
            const unsigned og = xb_add(&bar[XB_TOP], 1u);
            const unsigned tg = og / nx;
            if (og + 1u == (tg + 1u) * nx) xb_add(&bar[XB_TOPGEN], 1u);
            else XB_SPIN(xb_ld(&bar[XB_TOPGEN]) == tg, bar);
            __builtin_amdgcn_fence(__ATOMIC_ACQUIRE, "agent");
            xb_add(&bar[XB_XGEN(b.x)], 1u);
            asm volatile("s_waitcnt vmcnt(0)" ::: "memory");
        } else {
            XB_SPIN(xb_ld(&bar[XB_XGEN(b.x)]) == gen, bar);
            __builtin_amdgcn_fence(__ATOMIC_ACQUIRE, "agent");
            asm volatile("s_waitcnt vmcnt(0)" ::: "memory");
        }
    }
    __syncthreads();
}

constexpr int RING_BYTES = 131072;
constexpr int MISC_OFF = RING_BYTES;
constexpr int LDS_BYTES = 155648;
constexpr int NWAVES = 8, NTHR = 512;

struct Args { const float* in[26]; float* out; unsigned char* ws; int l_lo, l_hi, ph_lo, ph_hi, fused, pad; };
enum { I_X = 0, I_P, I_POS, I_MIXN, I_WIN, I_BF, I_QN, I_KVN, I_WUQ, I_WUKV, I_BRF, I_BRD, I_BRM, I_WOUT, I_FFNN, I_FG, I_FU, I_FD, I_WR, I_EG, I_EU, I_ED, I_PLEN, I_WPG, I_WPP, I_FINN };
constexpr int PH_FINAL = 16;
constexpr unsigned DBL_MASK = 0u;

__device__ __forceinline__ int map_row(int c, int mode, int sub) {
    if (mode == 1) return (c >> 2) * 8 + sub + (c & 3);
    if (mode == 2) { const int d = c & 63; return (c & ~63) + (d < 32 ? 2 * d : 2 * (d - 32) + 1); }
    if (mode == 3) { const int d = c & 31; return (c & ~31) + (d < 16 ? 2 * d : 2 * (d - 16) + 1); }
    return c;
}
__device__ __forceinline__ void conv_job(LAS float* scr, const float* src, int lds_, int K, int col0, int ncols, bf16* dst, int ldd, int row0, int mode, int sub,
                                         const float* gain, float scale, int wg, int nwg) {
    const int tid = threadIdx.x;
    const int nct = (ncols + 63) >> 6, nkt = K >> 6, ntiles = nct * nkt;
    for (int t = wg; t < ntiles; t += nwg) {
        const int kt = t / nct, ct = t - kt * nct, k0 = kt * 64, c0 = ct * 64;
#pragma unroll
        for (int j = 0; j < 8; ++j) { const int kk = (tid >> 6) + 8 * j, cc = tid & 63; float v = 0.f;
            if (c0 + cc < ncols) v = src[(size_t)(k0 + kk) * lds_ + col0 + c0 + cc];
            if (gain) v *= gain[k0 + kk];
            scr[kk * 65 + cc] = v * scale; }
        __syncthreads();
        { const int cc = tid >> 3, kc = (tid & 7) * 8;
          if (c0 + cc < ncols) { const int c = c0 + cc; const int dr = row0 + map_row(c, mode, sub);
              u32x4 o; o.x = cvt_pk_bf16(scr[(kc + 0) * 65 + cc], scr[(kc + 1) * 65 + cc]); o.y = cvt_pk_bf16(scr[(kc + 2) * 65 + cc], scr[(kc + 3) * 65 + cc]);
              o.z = cvt_pk_bf16(scr[(kc + 4) * 65 + cc], scr[(kc + 5) * 65 + cc]); o.w = cvt_pk_bf16(scr[(kc + 6) * 65 + cc], scr[(kc + 7) * 65 + cc]);
              *(u32x4*)(dst + (size_t)dr * ldd + k0 + kc) = o; } }
        __syncthreads();
    }
}
__device__ __forceinline__ void conv_items(LAS float* scr, const float* src, int lds_, int K, int col0, int ncols, bf16* dst, int ldd, int row0, int mode, int sub,
                                           const float* gain, float scale, int start, int nw, int lane) {
    const int nct = (ncols + 31) >> 5, nkt = K >> 6, nitems = nct * nkt;
    for (int it = start; it < nitems; it += nw) {
        const int kt = it / nct, ct = it - kt * nct, k0 = kt * 64, c0 = ct * 32;
        const int cp = 2 * (lane & 15), kr = lane >> 4; const bool okc = (c0 + cp) < ncols; const float* sp = src + (size_t)(k0 + kr) * lds_ + col0 + c0 + cp;
        f32x2 v[16];
#pragma unroll
        for (int i = 0; i < 16; ++i) v[i] = okc ? __builtin_nontemporal_load((const f32x2*)(sp + (size_t)(4 * i) * lds_)) : (f32x2){0.f, 0.f};
#pragma unroll
        for (int i = 0; i < 16; ++i) { scr[(4 * i + kr) * 33 + cp] = v[i].x; scr[(4 * i + kr) * 33 + cp + 1] = v[i].y; }
        asm volatile("s_waitcnt lgkmcnt(0)" ::: "memory");
        const int c = lane & 7;
        f32x4 g0 = (f32x4){scale, scale, scale, scale}, g1 = g0;
        if (gain) { g0 = *(const f32x4*)(gain + k0 + 8 * c) * scale; g1 = *(const f32x4*)(gain + k0 + 8 * c + 4) * scale; }
#pragma unroll
        for (int j = 0; j < 4; ++j) { const int n = (lane >> 3) + 8 * j; const LAS float* s = scr + (8 * c) * 33 + n;
            u32x4 o; o.x = cvt_pk_bf16(s[0 * 33] * g0.x, s[1 * 33] * g0.y); o.y = cvt_pk_bf16(s[2 * 33] * g0.z, s[3 * 33] * g0.w);
            o.z = cvt_pk_bf16(s[4 * 33] * g1.x, s[5 * 33] * g1.y); o.w = cvt_pk_bf16(s[6 * 33] * g1.z, s[7 * 33] * g1.w);
            if (mode == 4) {
                u32x2 o8; o8.x = pk4_fp8(s[0 * 33] * g0.x * 32.f, s[1 * 33] * g0.y * 32.f, s[2 * 33] * g0.z * 32.f, s[3 * 33] * g0.w * 32.f); o8.y = pk4_fp8(s[4 * 33] * g1.x * 32.f, s[5 * 33] * g1.y * 32.f, s[6 * 33] * g1.z * 32.f, s[7 * 33] * g1.w * 32.f);
                if (c0 + n < ncols) *(u32x2*)((unsigned char*)(dst + (size_t)row0 * ldd) + (size_t)(c0 + n) * ldd + k0 + 8 * c) = o8; }
            else if (c0 + n < ncols) *(u32x4*)(dst + (size_t)(row0 + map_row(c0 + n, mode, sub)) * ldd + k0 + 8 * c) = o; }
        asm volatile("s_waitcnt lgkmcnt(0)" ::: "memory");
    }
}
__device__ __forceinline__ void zero_rows(bf16* dst, int ldd, int row0, int nrows, int K, int gtid, int ngt) {
    const int per = K >> 3, n = nrows * per;
    for (int i = gtid; i < n; i += ngt) { const int r = i / per, k = (i - r * per) * 8; *(u32x4*)(dst + (size_t)(row0 + r) * ldd + k) = (u32x4){0u, 0u, 0u, 0u}; }
}

__device__ __forceinline__ float row_rstd(const f32x4 (&v)[4]) {
    float s = 0.f;
#pragma unroll
    for (int j = 0; j < 4; ++j) s += (v[j].x * v[j].x + v[j].y * v[j].y) + (v[j].z * v[j].z + v[j].w * v[j].w);
    return 1.0f / sqrtf(wave_sum(s) * (1.0f / D) + EPS);
}
__device__ __forceinline__ void store_row_bf16(bf16* orow, const f32x4 (&v)[4], float s, int lane) {
    u32x2* o8 = (u32x2*)orow + lane;
#pragma unroll
    for (int j = 0; j < 4; ++j) { u32x2 w; w.x = cvt_pk_bf16(v[j].x * s, v[j].y * s); w.y = cvt_pk_bf16(v[j].z * s, v[j].w * s); o8[64 * j] = w; }
}

__device__ __forceinline__ void load_row_bf16(const bf16* row, f32x4 (&v)[4], int lane) {
    const u32x2* p = (const u32x2*)row + lane;
#pragma unroll
    for (int j = 0; j < 4; ++j) { const u32x2 w = p[64 * j]; v[j] = (f32x4){bf2f(w.x & 0xffffu), bf2f(w.x >> 16), bf2f(w.y & 0xffffu), bf2f(w.y >> 16)}; }
}
namespace at {
typedef float f32x16 __attribute__((ext_vector_type(16)));
typedef short s16x4 __attribute__((ext_vector_type(4)));
typedef __bf16 bf16x2_t __attribute__((ext_vector_type(2)));
constexpr int VSLOT = 8192;
constexpr int L_K = 0, L_V = 49152, L_DL = L_V + 49152, L_WS = L_DL + 8192, L_END = L_WS + 8 * 256;
constexpr int BIGW = 1 << 24;
__device__ __forceinline__ int crow(int r, int hi) { return (r & 3) + 8 * (r >> 2) + 4 * hi; }
__device__ __forceinline__ void glds16(const void* gsrc, unsigned lds_dst) { unsigned keep;
    asm volatile("s_mov_b32 %0, m0\n\ts_mov_b32 m0, %2\n\ts_nop 0\n\tglobal_load_lds_dwordx4 %1, off\n\ts_mov_b32 m0, %0" : "=&s"(keep) : "v"(gsrc), "s"(lds_dst) : "memory"); }
__device__ __forceinline__ unsigned cvtpk(float lo, float hi) { f32x2 v = {lo, hi}; bf16x2_t b = __builtin_convertvector(v, bf16x2_t); return __builtin_bit_cast(unsigned, b); }
struct VFrag { s16x4 lo[4], hi[4]; };
template <int H> __device__ __forceinline__ void vload(VFrag& f, int vb) {
#pragma unroll
    for (int i = 0; i < 4; ++i) {
        asm volatile("ds_read_b64_tr_b16 %0,%1 offset:%c2" : "=&v"(f.lo[i]) : "v"(vb), "i"(H * 4096 + i * 1024) : "memory");
        asm volatile("ds_read_b64_tr_b16 %0,%1 offset:%c2" : "=&v"(f.hi[i]) : "v"(vb), "i"(H * 4096 + i * 1024 + 512) : "memory"); }
}
__device__ __forceinline__ void vwait(VFrag& f) {
    asm volatile("s_waitcnt lgkmcnt(0)" : "+v"(f.lo[0]), "+v"(f.lo[1]), "+v"(f.lo[2]), "+v"(f.lo[3]), "+v"(f.hi[0]), "+v"(f.hi[1]), "+v"(f.hi[2]), "+v"(f.hi[3]) :: "memory");
}
__device__ __forceinline__ f32x16 pvmma(f32x16 o, const VFrag& f, bf16x8 pa0, bf16x8 pa1, bf16x8 pa2, bf16x8 pa3) {
#define AT_PK(i) (bf16x8){f.lo[i][0], f.lo[i][1], f.lo[i][2], f.lo[i][3], f.hi[i][0], f.hi[i][1], f.hi[i][2], f.hi[i][3]}
    o = __builtin_amdgcn_mfma_f32_32x32x16_bf16(pa0, AT_PK(0), o, 0, 0, 0); o = __builtin_amdgcn_mfma_f32_32x32x16_bf16(pa1, AT_PK(1), o, 0, 0, 0);
    o = __builtin_amdgcn_mfma_f32_32x32x16_bf16(pa2, AT_PK(2), o, 0, 0, 0); o = __builtin_amdgcn_mfma_f32_32x32x16_bf16(pa3, AT_PK(3), o, 0, 0, 0);
#undef AT_PK
    return o;
}
struct Geo { int mode, b, r, rho, u; };
__device__ __forceinline__ int g_kt0(const Geo& g) { const int k = 4 * g.u - 2; return k > 0 ? k : 0; }
__device__ __forceinline__ int g_nt(const Geo& g) { return g.mode == 0 ? 4 * (g.u + 1) : (g.mode == 1 ? 4 * g.u + 4 - g_kt0(g) : 4); }
__device__ __forceinline__ int g_str(const Geo& g) { return g.mode == 0 ? 1 : (g.mode == 1 ? g.r : 16); }
__device__ __forceinline__ int g_qrow0(const Geo& g, int w) { return g.mode == 0 ? g.b * T + 256 * g.u + 32 * w : (g.mode == 1 ? g.b * T + g.rho + g.r * (256 * g.u + 32 * w) : g.b * T + 2 * g.rho + (w >> 2) + 512 * (w & 3)); }
__device__ __forceinline__ int g_qpos0(const Geo& g, int w) { return g.mode == 2 ? 1024 * (w >> 2) + 32 * (w & 3) : 256 * g.u + 32 * w; }
__device__ __forceinline__ int g_kpos0(const Geo& g, int t) { return g.mode == 0 ? 64 * t : (g.mode == 1 ? 64 * (g_kt0(g) + t) : 1024 * (t >> 1) + 64 * (t & 1)); }
__device__ __forceinline__ int g_krow0(const Geo& g, int t) { return g.mode == 0 ? g.b * T + 64 * t : (g.mode == 1 ? g.b * T + g.rho + g.r * 64 * (g_kt0(g) + t) : g.b * T + 2 * g.rho + (t >> 1) + 1024 * (t & 1)); }
struct Tens { const bf16* q0; const bf16* q1; int qp; const bf16* k0; int kp; const bf16* k1; const bf16* v; int vp; const float* dl; bf16* o; int op; float* lse; };

template <bool MLA, bool BIAS> __device__ __forceinline__ void attn_unit(LAS unsigned char* lds, const Tens& P, const Geo& g, int lane, int wid) {
    constexpr int ND0 = MLA ? 6 : 4; constexpr int KSLOT = MLA ? 12288 : 8192; constexpr bool NEGM = !MLA && !BIAS;
    const int r32 = lane & 31, hi = lane >> 5;
    const unsigned lds0 = (unsigned)(size_t)lds;
    LAS float* wsf = (LAS float*)(lds + L_WS) + wid * 64;
    const LAS float* dls = (const LAS float*)(lds + L_DL);
    const int NT = g_nt(g), str = g_str(g), W = (g.mode == 0) ? BIGW : 128;
    const int qrow0 = g_qrow0(g, wid), qpos0 = g_qpos0(g, wid);
#define AT_ISSUE(t, slot) do { const int kr0_ = g_krow0(g, (t)); \
        glds16(P.k0 + (size_t)(kr0_ + str * lane) * P.kp + 8 * wid, (unsigned)__builtin_amdgcn_readfirstlane(lds0 + L_K + (slot) * KSLOT + wid * 1024)); \
        if (MLA) glds16(P.k1 + (size_t)(kr0_ + str * lane) * 32 + 8 * (wid & 3), (unsigned)__builtin_amdgcn_readfirstlane(lds0 + L_K + (slot) * KSLOT + (8 + (wid & 3)) * 1024)); \
        glds16(P.v + (size_t)(kr0_ + str * (16 * (wid & 3) + (lane >> 2))) * P.vp + (wid >> 2) * 32 + (lane & 3) * 8, (unsigned)__builtin_amdgcn_readfirstlane(lds0 + L_V + (slot) * VSLOT + wid * 1024)); } while (0)
    const bool resident = !MLA && !BIAS && (g.mode != 0);
#define AT_SLOT(t) (resident ? (t) : ((t) & 3))
    if (resident) { for (int t = 0; t < NT; ++t) AT_ISSUE(t, t); } else { AT_ISSUE(0, 0); AT_ISSUE(1, 1); }
    bf16x8 qr[ND0];
    { const size_t qrow = (size_t)(qrow0 + str * r32);
#pragma unroll
      for (int d0 = 0; d0 < 4; ++d0) qr[d0] = *(const GAS bf16x8*)(P.q0 + qrow * P.qp + d0 * 16 + hi * 8);
      if (MLA) {
#pragma unroll
          for (int d0 = 4; d0 < ND0; ++d0) qr[d0] = *(const GAS bf16x8*)(P.q1 + qrow * P.qp + (d0 - 4) * 16 + hi * 8); } }
    if (P.dl) { const f32x4 dv = *((const GAS f32x4*)P.dl + (wid * 64 + lane)); *(LAS f32x4*)(lds + L_DL + (wid * 64 + lane) * 16) = dv; }
    float m = 0.f, l = 0.f; f32x16 o[2]; o[0] = f32x16{}; o[1] = f32x16{}; f32x16 negm = f32x16{};
    const int vb0 = (int)(lds0 + L_V) + ((lane >> 4) & 1) * 32 + (lane & 3) * 8 + (4 * hi + ((lane & 15) >> 2)) * 64;
#define AT_QK(t, P0, P1, USE, MREF) do { MREF = m; const int kpos0_ = g_kpos0(g, (t)); const int dmin_ = qpos0 - (kpos0_ + 63), dmax_ = qpos0 + 31 - kpos0_; \
        USE = !(dmax_ < 0 || dmin_ > W); \
        if (USE) { \
            const LAS unsigned char* kb_ = lds + L_K + AT_SLOT(t) * KSLOT + hi * 1024 + r32 * 16; bf16x8 kf_[4], kh_[4]; \
            _Pragma("unroll") for (int d0 = 0; d0 < 2; ++d0) { kf_[2 * d0] = *(const LAS bf16x8*)(kb_ + d0 * 2048); kf_[2 * d0 + 1] = *(const LAS bf16x8*)(kb_ + d0 * 2048 + 512); } \
            if (BIAS) { _Pragma("unroll") for (int g4 = 0; g4 < 4; ++g4) { const f32x4 a_ = *(const LAS f32x4*)(dls + kpos0_ + 8 * g4 + 4 * hi), c_ = *(const LAS f32x4*)(dls + kpos0_ + 32 + 8 * g4 + 4 * hi); \
                P0[4 * g4] = a_.x; P0[4 * g4 + 1] = a_.y; P0[4 * g4 + 2] = a_.z; P0[4 * g4 + 3] = a_.w; P1[4 * g4] = c_.x; P1[4 * g4 + 1] = c_.y; P1[4 * g4 + 2] = c_.z; P1[4 * g4 + 3] = c_.w; } } \
            __builtin_amdgcn_sched_barrier(0); \
            _Pragma("unroll") for (int d0 = 2; d0 < 4; ++d0) { kh_[2 * (d0 - 2)] = *(const LAS bf16x8*)(kb_ + d0 * 2048); kh_[2 * (d0 - 2) + 1] = *(const LAS bf16x8*)(kb_ + d0 * 2048 + 512); } \
            if (BIAS) { P0 = __builtin_amdgcn_mfma_f32_32x32x16_bf16(kf_[0], qr[0], P0, 0, 0, 0); P1 = __builtin_amdgcn_mfma_f32_32x32x16_bf16(kf_[1], qr[0], P1, 0, 0, 0); } \
            else if (NEGM) { P0 = __builtin_amdgcn_mfma_f32_32x32x16_bf16(kf_[0], qr[0], negm, 0, 0, 0); P1 = __builtin_amdgcn_mfma_f32_32x32x16_bf16(kf_[1], qr[0], negm, 0, 0, 0); } \
            else { P0 = __builtin_amdgcn_mfma_f32_32x32x16_bf16(kf_[0], qr[0], f32x16{}, 0, 0, 0); P1 = __builtin_amdgcn_mfma_f32_32x32x16_bf16(kf_[1], qr[0], f32x16{}, 0, 0, 0); } \
            P0 = __builtin_amdgcn_mfma_f32_32x32x16_bf16(kf_[2], qr[1], P0, 0, 0, 0); P1 = __builtin_amdgcn_mfma_f32_32x32x16_bf16(kf_[3], qr[1], P1, 0, 0, 0); \
            __builtin_amdgcn_sched_barrier(0); \
            P0 = __builtin_amdgcn_mfma_f32_32x32x16_bf16(kh_[0], qr[2], P0, 0, 0, 0); P1 = __builtin_amdgcn_mfma_f32_32x32x16_bf16(kh_[1], qr[2], P1, 0, 0, 0); \
            P0 = __builtin_amdgcn_mfma_f32_32x32x16_bf16(kh_[2], qr[3], P0, 0, 0, 0); P1 = __builtin_amdgcn_mfma_f32_32x32x16_bf16(kh_[3], qr[3], P1, 0, 0, 0); \
            if (MLA) { bf16x8 kg_[4];     \
                _Pragma("unroll") for (int d0 = 4; d0 < ND0; ++d0) { kg_[2 * (d0 - 4)] = *(const LAS bf16x8*)(kb_ + d0 * 2048); kg_[2 * (d0 - 4) + 1] = *(const LAS bf16x8*)(kb_ + d0 * 2048 + 512); } \
                _Pragma("unroll") for (int d0 = 4; d0 < ND0; ++d0) { \
                    P0 = __builtin_amdgcn_mfma_f32_32x32x16_bf16(kg_[2 * (d0 - 4)], qr[d0], P0, 0, 0, 0); P1 = __builtin_amdgcn_mfma_f32_32x32x16_bf16(kg_[2 * (d0 - 4) + 1], qr[d0], P1, 0, 0, 0); } } \
        } } while (0)
#define AT_MAX3(a, b, c) __builtin_fmaxf(__builtin_fmaxf((a), (b)), (c))
#define AT_STEP(t, PC0, PC1, UC, MC, PN0, PN1, UN, MN) do { \
        UN = false; \
        if ((t) + 1 < NT) AT_QK((t) + 1, PN0, PN1, UN, MN); \
        __builtin_amdgcn_sched_barrier(0); \
        if (UC) { \
            const int kpos0_ = g_kpos0(g, (t)); const int dmin_ = qpos0 - (kpos0_ + 63), dmax_ = qpos0 + 31 - kpos0_; \
            if (dmin_ < 0 || dmax_ > W) { const int dq_ = qpos0 + r32 - kpos0_ - 4 * hi; \
                _Pragma("unroll") for (int r = 0; r < 16; ++r) { const int d_ = dq_ - ((r & 3) + 8 * (r >> 2)); if (d_ < 0 || d_ > W) PC0[r] = -INFINITY; if (d_ - 32 < 0 || d_ - 32 > W) PC1[r] = -INFINITY; } } \
            float ra_ = AT_MAX3(PC0[0], PC0[1], PC1[0]), rb_ = AT_MAX3(PC0[2], PC0[3], PC1[1]); ra_ = AT_MAX3(ra_, PC1[2], PC1[3]); \
            _Pragma("unroll") for (int r = 4; r < 16; r += 4) { ra_ = AT_MAX3(ra_, PC0[r], PC0[r + 1]); rb_ = AT_MAX3(rb_, PC0[r + 2], PC0[r + 3]); ra_ = AT_MAX3(ra_, PC1[r], PC1[r + 1]); rb_ = AT_MAX3(rb_, PC1[r + 2], PC1[r + 3]); } \
            float rm_ = __builtin_fmaxf(ra_, rb_); \
            { auto rr_ = __builtin_amdgcn_permlane32_swap(__float_as_uint(rm_), __float_as_uint(rm_), false, false); rm_ = __builtin_fmaxf(__uint_as_float(rr_[0]), __uint_as_float(rr_[1])); } \
              \
            if (!NEGM) rm_ -= m; else rm_ -= (m - MC); \
            VFrag vf_; vload<0>(vf_, vb0 + AT_SLOT(t) * VSLOT);      \
            if (__builtin_expect(__any(rm_ > 8.0f), 0)) { const float dl_ = __builtin_fmaxf(rm_, 0.f); m += dl_; const float alpha_ = __builtin_amdgcn_exp2f(-dl_); l *= alpha_; \
                int lz_ = lane; asm volatile("" : "+v"(lz_));     \
                LAS float* wz_ = (LAS float*)(lds + L_WS) + wid * 64; if ((lz_ >> 5) == 0) wz_[lz_ & 31] = alpha_; \
                _Pragma("unroll") for (int r = 0; r < 16; ++r) { const float f_ = wz_[crow(r, lz_ >> 5)]; o[0][r] *= f_; o[1][r] *= f_; } \
                if (NEGM) { _Pragma("unroll") for (int r = 0; r < 16; ++r) negm[r] = -m; } } \
            const float sub_ = !NEGM ? m : (m - MC); float sacc_ = 0.f; \
            if (!NEGM || __any(sub_ != 0.f)) { _Pragma("unroll") for (int r = 0; r < 16; ++r) { PC0[r] = __builtin_amdgcn_exp2f(PC0[r] - sub_); PC1[r] = __builtin_amdgcn_exp2f(PC1[r] - sub_); sacc_ += PC0[r] + PC1[r]; } } \
            else { _Pragma("unroll") for (int r = 0; r < 16; ++r) { PC0[r] = __builtin_amdgcn_exp2f(PC0[r]); PC1[r] = __builtin_amdgcn_exp2f(PC1[r]); sacc_ += PC0[r] + PC1[r]; } } \
            l += sacc_; \
            const u32x4 w0_ = (u32x4){cvtpk(PC0[0], PC0[1]), cvtpk(PC0[2], PC0[3]), cvtpk(PC0[4], PC0[5]), cvtpk(PC0[6], PC0[7])}; \
            const u32x4 w1_ = (u32x4){cvtpk(PC0[8], PC0[9]), cvtpk(PC0[10], PC0[11]), cvtpk(PC0[12], PC0[13]), cvtpk(PC0[14], PC0[15])}; \
            const u32x4 w2_ = (u32x4){cvtpk(PC1[0], PC1[1]), cvtpk(PC1[2], PC1[3]), cvtpk(PC1[4], PC1[5]), cvtpk(PC1[6], PC1[7])}; \
            const u32x4 w3_ = (u32x4){cvtpk(PC1[8], PC1[9]), cvtpk(PC1[10], PC1[11]), cvtpk(PC1[12], PC1[13]), cvtpk(PC1[14], PC1[15])}; \
            vwait(vf_); o[0] = pvmma(o[0], vf_, __builtin_bit_cast(bf16x8, w0_), __builtin_bit_cast(bf16x8, w1_), __builtin_bit_cast(bf16x8, w2_), __builtin_bit_cast(bf16x8, w3_)); \
            __builtin_amdgcn_sched_barrier(0); vload<1>(vf_, vb0 + AT_SLOT(t) * VSLOT); \
            vwait(vf_); o[1] = pvmma(o[1], vf_, __builtin_bit_cast(bf16x8, w0_), __builtin_bit_cast(bf16x8, w1_), __builtin_bit_cast(bf16x8, w2_), __builtin_bit_cast(bf16x8, w3_)); \
        } \
        if (!resident) { asm volatile("s_waitcnt vmcnt(0) lgkmcnt(0)\n\ts_barrier" ::: "memory"); \
            if ((t) + 3 < NT) AT_ISSUE((t) + 3, ((t) + 3) & 3); } } while (0)
    f32x16 pa0, pa1, pb0, pb1; bool ua = false, ub = false; float mra = 0.f, mrb = 0.f;
    asm volatile("s_waitcnt vmcnt(0) lgkmcnt(0)\n\ts_barrier" ::: "memory");
    if (!resident) AT_ISSUE(2, 2);
    AT_QK(0, pa0, pa1, ua, mra);
    for (int t = 0; t < NT; t += 2) {
        AT_STEP(t, pa0, pa1, ua, mra, pb0, pb1, ub, mrb);
        AT_STEP(t + 1, pb0, pb1, ub, mrb, pa0, pa1, ua, mra);
    }
#undef AT_QK
#undef AT_STEP
#undef AT_MAX3
#undef AT_ISSUE
#undef AT_SLOT
    { auto rr = __builtin_amdgcn_permlane32_swap(__float_as_uint(l), __float_as_uint(l), false, false); l = __uint_as_float(rr[0]) + __uint_as_float(rr[1]); }
    if (hi == 0) wsf[32 + r32] = l;
    if (P.lse && hi == 0) ((GAS float*)P.lse)[(size_t)(qrow0 + str * r32) * 8] = m + log2f(l);
#pragma unroll
    for (int r = 0; r < 16; ++r) { const float rl = __builtin_amdgcn_rcpf(wsf[32 + crow(r, hi)]); GAS bf16* orow = (GAS bf16*)(P.o + (size_t)(qrow0 + str * crow(r, hi)) * P.op + r32);
        orow[0] = (bf16)(cvtpk(o[0][r] * rl, 0.f) & 0xffffu); orow[32] = (bf16)(cvtpk(o[1][r] * rl, 0.f) & 0xffffu); }
    asm volatile("s_waitcnt lgkmcnt(0)\n\ts_barrier" ::: "memory");
}
}

namespace fx {
using at::f32x16; using at::s16x4; using at::crow; using at::glds16; using at::cvtpk;
typedef short v4i16_t __attribute__((ext_vector_type(4)));
constexpr int NSLOT = 3, SLOTB = 8192, LDS_K = 0, LDS_V = NSLOT * SLOTB, LDS_WS = 2 * NSLOT * SLOTB, LDS_OST = LDS_WS + 8 * 256, LDS_DL = LDS_OST + 8 * 4096, LDS_END = LDS_DL + 8192;
typedef const LAS unsigned char* lptr;
__device__ __forceinline__ void cmask(f32x16& p0, f32x16& p1, int jb, int qrel, int hi) {
    const float NEG = -INFINITY; const int kb = 64 * jb + 4 * hi;
#pragma unroll
    for (int r = 0; r < 16; ++r) { const int kv = kb + (r & 3) + 8 * (r >> 2); if (kv > qrel) p0[r] = NEG; if (kv + 32 > qrel) p1[r] = NEG; }
}
__device__ __forceinline__ void kload8(bf16x8* kf, lptr kp) {
    kf[0] = *(const LAS bf16x8*)(kp);        kf[1] = *(const LAS bf16x8*)(kp + 512);  kf[2] = *(const LAS bf16x8*)(kp + 2048); kf[3] = *(const LAS bf16x8*)(kp + 2560);
    kf[4] = *(const LAS bf16x8*)(kp + 4096); kf[5] = *(const LAS bf16x8*)(kp + 4608); kf[6] = *(const LAS bf16x8*)(kp + 6144); kf[7] = *(const LAS bf16x8*)(kp + 6656);
}
__device__ __forceinline__ void kload2(bf16x8* kf, lptr kp, int j) { kf[2 * j] = *(const LAS bf16x8*)(kp + j * 2048); kf[2 * j + 1] = *(const LAS bf16x8*)(kp + j * 2048 + 512); }
__device__ __forceinline__ s16x4 vtr(lptr p) { return __builtin_bit_cast(s16x4, __builtin_amdgcn_ds_read_tr16_b64_v4i16((LAS v4i16_t*)p)); }
__device__ __forceinline__ bf16x8 mk_qx(float m, int hi) {
    const unsigned h = cvtpk(m, 0.f) & 0xffffu; const unsigned l = cvtpk(m - __uint_as_float(h << 16), 0.f) & 0xffffu;
    u32x4 w = (u32x4){0x3F803F80u, (h ^ 0x8000u) | ((l ^ 0x8000u) << 16), 0u, 0u}; if (hi) w = (u32x4){0u, 0u, 0u, 0u};
    return __builtin_bit_cast(bf16x8, w);
}
__device__ __forceinline__ void mk_kx(bf16x8& k0, bf16x8& k1, float d0, float d1, int hi) {
    const unsigned u = cvtpk(d0, d1); const unsigned v = cvtpk(d0 - __uint_as_float(u << 16), d1 - __uint_as_float(u & 0xffff0000u));
    u32x4 a = (u32x4){(u & 0xffffu) | (v << 16), 0x3F803F80u, 0u, 0u}, b = (u32x4){(u >> 16) | (v & 0xffff0000u), 0x3F803F80u, 0u, 0u};
    if (hi) { a = (u32x4){0u, 0u, 0u, 0u}; b = a; }
    k0 = __builtin_bit_cast(bf16x8, a); k1 = __builtin_bit_cast(bf16x8, b);
}
#define FX_MX3(a, b, c) __builtin_fmaxf(__builtin_fmaxf((a), (b)), (c))
#define FX_SBAR() __builtin_amdgcn_sched_barrier(0)
#define FX_WAIT_BAR(N) asm volatile("s_waitcnt vmcnt(" #N ") lgkmcnt(0)\n\ts_barrier" ::: "memory")
#define FX_MFMA(a, b, c) __builtin_amdgcn_mfma_f32_32x32x16_bf16(a, b, c, 0, 0, 0)
template <int THRL, int KP, int OP> __device__ __forceinline__ void fox_unit(LAS unsigned char* shm, const bf16* Qh, const bf16* Kh, const bf16* Vh, const float* dl, bf16* Oh, int qb, int lane_, int wid_) {
    int lane = lane_, wid = wid_; asm volatile("" : "+v"(lane), "+s"(wid));
    const int r32 = lane & 31, hi = lane >> 5; const int q0 = qb * 256;
    const bf16* Qw = Qh + (size_t)(q0 + wid * 32) * KP;
    const unsigned lds0 = (unsigned)(size_t)shm;
    LAS float* wsf = (LAS float*)(shm + LDS_WS) + wid * 64;
    int j0;
    { const float dq = ((const GAS float*)dl)[q0], de = ((const GAS float*)dl)[64 * (lane & 31) + 63];
      const unsigned far = (unsigned)__ballot(dq - de > 56.0f);
      j0 = far == 0xffffffffu ? 32 : __builtin_ctz(~far); j0 &= ~1; const int jmax = (q0 + 256) / 64 - 4; j0 = j0 < jmax ? j0 : jmax; j0 = __builtin_amdgcn_readfirstlane(j0); }
    const bf16* ksrc = Kh + (size_t)(64 * j0 + lane) * KP + wid * 8;
    const bf16* vsrc = Vh + (size_t)(64 * j0 + 16 * (wid & 3) + (lane >> 2)) * KP + (wid >> 2) * 32 + (lane & 3) * 8;
    const unsigned kdst = lds0 + LDS_K + wid * 1024, vdst = lds0 + LDS_V + wid * 1024;
#define FX_DMA_K(t, slot) glds16(ksrc + (size_t)(t) * 64 * KP, (unsigned)__builtin_amdgcn_readfirstlane(kdst + (slot)))
#define FX_DMA_V(t, slot) glds16(vsrc + (size_t)(t) * 64 * KP, (unsigned)__builtin_amdgcn_readfirstlane(vdst + (slot)))
    const int vb0 = (int)(lds0 + LDS_V) + ((lane >> 4) & 1) * 32 + (lane & 3) * 8 + (4 * hi + ((lane & 15) >> 2)) * 64;
    bf16x8 kf[8];
    const lptr kp0 = shm + LDS_K + hi * 1024 + r32 * 16; const lptr vp0 = shm + LDS_V + ((lane >> 4) & 1) * 32 + (lane & 3) * 8 + (4 * hi + ((lane & 15) >> 2)) * 64;
    const LAS float* dlt = (const LAS float*)(shm + LDS_DL) + 64 * j0 + r32;
    const int NT = (q0 + 256) / 64 - j0;
    FX_DMA_K(0, 0); FX_DMA_V(0, 0); FX_DMA_K(1, SLOTB);
    { const f32x4 dv = *((const GAS f32x4*)dl + (wid * 64 + lane)); *(LAS f32x4*)(shm + LDS_DL + (wid * 64 + lane) * 16) = dv; }
    bf16x8 qr[4];
#pragma unroll
    for (int d0 = 0; d0 < 4; ++d0) qr[d0] = *(const GAS bf16x8*)(Qw + (size_t)r32 * KP + d0 * 16 + hi * 8);
    float mhat = 0.f, l_reg = 0.f; f32x16 o[2]; o[0] = f32x16{}; o[1] = f32x16{};
    bf16x8 qx = mk_qx(0.f, hi);
    const int qrel = wid * 32 + r32;
#define FX_CMASK(P0, P1, t) do { const int jb_ = (t) - (NT - 4); if (jb_ >= 0) cmask(P0, P1, jb_, qrel, hi); } while (0)
    bool resc = false;
#define FX_RESC() do { if (resc) { asm volatile("s_waitcnt lgkmcnt(0)" ::: "memory"); \
        _Pragma("unroll") for (int d_ = 0; d_ < 2; ++d_) _Pragma("unroll") for (int r = 0; r < 16; ++r) o[d_][r] *= wsf[crow(r, hi)]; } } while (0)
    f32x16 pA0, pA1, pB0, pB1;
    int sl_prev = 0, sl_cur = 0, sl_next = SLOTB;
#define FX_ROT() do { sl_prev = sl_cur; sl_cur = sl_next; sl_next = (sl_next == (NSLOT - 1) * SLOTB) ? 0 : sl_next + SLOTB; } while (0)
    FX_DMA_K(2, 2 * SLOTB);
    FX_WAIT_BAR(3);
    { kload8(kf, kp0); bf16x8 kx0, kx1; mk_kx(kx0, kx1, dlt[0], dlt[32], hi);
      pA0 = FX_MFMA(kf[0], qr[0], f32x16{}); pA1 = FX_MFMA(kf[1], qr[0], f32x16{});
#pragma unroll
      for (int d0 = 1; d0 < 4; ++d0) { pA0 = FX_MFMA(kf[2 * d0], qr[d0], pA0); pA1 = FX_MFMA(kf[2 * d0 + 1], qr[d0], pA1); }
      pA0 = FX_MFMA(kx0, qx, pA0); pA1 = FX_MFMA(kx1, qx, pA1); }
    FX_CMASK(pA0, pA1, 0);
    { float a = FX_MX3(pA0[0], pA0[1], pA1[0]), b = FX_MX3(pA0[2], pA0[3], pA1[1]); a = FX_MX3(a, pA1[2], pA1[3]);
#pragma unroll
      for (int r = 4; r < 16; r += 4) { a = FX_MX3(a, pA0[r], pA0[r + 1]); b = FX_MX3(b, pA0[r + 2], pA0[r + 3]); a = FX_MX3(a, pA1[r], pA1[r + 1]); b = FX_MX3(b, pA1[r + 2], pA1[r + 3]); }
      float rm = __builtin_fmaxf(a, b); { auto rr = __builtin_amdgcn_permlane32_swap(__float_as_uint(rm), __float_as_uint(rm), false, false); rm = __builtin_fmaxf(__uint_as_float(rr[0]), __uint_as_float(rr[1])); }
      mhat = rm; qx = mk_qx(mhat, hi);
#pragma unroll
      for (int r = 0; r < 16; ++r) { pA0[r] = __builtin_amdgcn_exp2f(pA0[r] - rm); pA1[r] = __builtin_amdgcn_exp2f(pA1[r] - rm); } }
    FX_WAIT_BAR(0);
    FX_DMA_K(3, 0); FX_DMA_V(1, SLOTB);
    FX_ROT();
    kload8(kf, kp0 + sl_cur);
    FX_WAIT_BAR(2);
    s16x4 vlo[8], vhi[8]; u32x4 pw0, pw1, pw2, pw3;
#define FX_PKW(P, B) cvtpk(P[B], P[B + 1])
#define FX_PAF(k) __builtin_bit_cast(bf16x8, pw##k)
#define FX_VFR(i) (bf16x8){vlo[i][0], vlo[i][1], vlo[i][2], vlo[i][3], vhi[i][0], vhi[i][1], vhi[i][2], vhi[i][3]}
#define FX_PIN(x) asm volatile("" : "+v"(x))
#define FX_GAPA(MF, A0, A1, A2, A3, W0, W1, PW) do { MF; sacc += A0; sacc += A1; sacc += A2; sacc += A3; FX_PIN(sacc); W0; W1; FX_PIN(PW); FX_SBAR(); } while (0)
#define FX_EX(v) __builtin_amdgcn_exp2f(v)
#define FX_GAPB(MF, X, B) do { MF; X[B] = FX_EX(X[B]); X[B + 1] = FX_EX(X[B + 1]); X[B + 2] = FX_EX(X[B + 2]); X[B + 3] = FX_EX(X[B + 3]); FX_PIN(X); FX_SBAR(); } while (0)
#define FX_VRD(i) do { vlo[i] = vtr(vp_ + (((i) >> 2) * 4096 + ((i) & 3) * 1024)); vhi[i] = vtr(vp_ + (((i) >> 2) * 4096 + ((i) & 3) * 1024 + 512)); } while (0)
#define FX_KRD(G, j) do { if (G) { kload2(kf, kp0 + sl_next, j); FX_SBAR(); } } while (0)
#define FX_STEP(C0, C1, P0, P1, t, GK, GV, GL) do { FX_SBAR(); \
        const lptr vp_ = vp0 + sl_prev; const float d0_ = dlt[64 * (t)], d1_ = dlt[64 * (t) + 32]; \
        FX_VRD(0); FX_SBAR(); float sacc = (P0[0] + P0[1]); \
        FX_GAPA(C0 = FX_MFMA(kf[0], qr[0], f32x16{}), P0[2], P0[3], P0[4], P0[5],     pw0[0] = FX_PKW(P0, 0), pw0[1] = FX_PKW(P0, 2), pw0); \
        FX_VRD(4); FX_SBAR(); FX_GAPA(C1 = FX_MFMA(kf[1], qr[0], f32x16{}), P0[6], P0[7], P0[8], P0[9],     pw0[2] = FX_PKW(P0, 4), pw0[3] = FX_PKW(P0, 6), pw0); \
        FX_VRD(1); FX_SBAR(); FX_GAPA(C0 = FX_MFMA(kf[2], qr[1], C0),   P0[10], P0[11], P0[12], P0[13], pw1[0] = FX_PKW(P0, 8), pw1[1] = FX_PKW(P0, 10), pw1); \
        FX_VRD(5); FX_SBAR(); FX_GAPA(C1 = FX_MFMA(kf[3], qr[1], C1),   P0[14], P0[15], P1[0], P1[1],   pw1[2] = FX_PKW(P0, 12), pw1[3] = FX_PKW(P0, 14), pw1); \
        FX_VRD(2); FX_SBAR(); FX_GAPA(C0 = FX_MFMA(kf[4], qr[2], C0),   P1[2], P1[3], P1[4], P1[5],     pw2[0] = FX_PKW(P1, 0), pw2[1] = FX_PKW(P1, 2), pw2); \
        FX_VRD(6); FX_SBAR(); FX_GAPA(C1 = FX_MFMA(kf[5], qr[2], C1),   P1[6], P1[7], P1[8], P1[9],     pw2[2] = FX_PKW(P1, 4), pw2[3] = FX_PKW(P1, 6), pw2); \
        FX_VRD(3); FX_SBAR(); FX_GAPA(C0 = FX_MFMA(kf[6], qr[3], C0),   P1[10], P1[11], P1[12], P1[13], pw3[0] = FX_PKW(P1, 8), pw3[1] = FX_PKW(P1, 10), pw3); \
        FX_VRD(7); FX_SBAR(); FX_GAPA(C1 = FX_MFMA(kf[7], qr[3], C1),   P1[14], P1[15], 0.f, 0.f,       pw3[2] = FX_PKW(P1, 12), pw3[3] = FX_PKW(P1, 14), pw3); \
        l_reg += sacc; \
        { bf16x8 kx0_, kx1_; mk_kx(kx0_, kx1_, d0_, d1_, hi); FX_PIN(kx0_); FX_PIN(kx1_); FX_SBAR(); C0 = FX_MFMA(kx0_, qx, C0); C1 = FX_MFMA(kx1_, qx, C1); FX_SBAR(); }     \
        if (GK) { FX_DMA_K((t) + 3, sl_cur); } if (GV) { FX_DMA_V((t) + 1, sl_next); } \
        FX_CMASK(C0, C1, t); \
        { float a = FX_MX3(C0[0], C0[1], C1[0]), b = FX_MX3(C0[2], C0[3], C1[1]); a = FX_MX3(a, C1[2], C1[3]); \
          _Pragma("unroll") for (int r = 4; r < 16; r += 4) { a = FX_MX3(a, C0[r], C0[r + 1]); b = FX_MX3(b, C0[r + 2], C0[r + 3]); a = FX_MX3(a, C1[r], C1[r + 1]); b = FX_MX3(b, C1[r + 2], C1[r + 3]); } \
          float rm = __builtin_fmaxf(a, b); { auto rr = __builtin_amdgcn_permlane32_swap(__float_as_uint(rm), __float_as_uint(rm), false, false); rm = __builtin_fmaxf(__uint_as_float(rr[0]), __uint_as_float(rr[1])); } \
          resc = false; \
          if (__builtin_expect(__any(rm > (float)THRL), 0)) { const float dl_ = __builtin_fmaxf(rm, 0.f); mhat += dl_; \
              _Pragma("unroll") for (int r = 0; r < 16; ++r) { C0[r] -= dl_; C1[r] -= dl_; } \
              qx = mk_qx(mhat, hi); \
              const float f = __builtin_amdgcn_exp2f(-dl_); l_reg *= f; if (hi == 0) wsf[r32] = f; resc = true; } } \
        FX_SBAR(); \
        FX_GAPB(o[0] = FX_MFMA(FX_PAF(0), FX_VFR(0), o[0]), C0, 0); \
        FX_GAPB(o[1] = FX_MFMA(FX_PAF(0), FX_VFR(4), o[1]), C0, 4); \
        FX_KRD(GL, 0); FX_GAPB(o[0] = FX_MFMA(FX_PAF(1), FX_VFR(1), o[0]), C0, 8); \
        FX_KRD(GL, 1); FX_GAPB(o[1] = FX_MFMA(FX_PAF(1), FX_VFR(5), o[1]), C0, 12); \
        FX_KRD(GL, 2); FX_GAPB(o[0] = FX_MFMA(FX_PAF(2), FX_VFR(2), o[0]), C1, 0); \
        FX_KRD(GL, 3); FX_GAPB(o[1] = FX_MFMA(FX_PAF(2), FX_VFR(6), o[1]), C1, 4); \
        FX_GAPB(o[0] = FX_MFMA(FX_PAF(3), FX_VFR(3), o[0]), C1, 8); \
        FX_GAPB(o[1] = FX_MFMA(FX_PAF(3), FX_VFR(7), o[1]), C1, 12); \
    } while (0)
    int t = 1;
#undef FX_CMASK
#define FX_CMASK(P0, P1, t) do {} while (0)
    for (; t + 5 < NT; t += 2) {
        FX_STEP(pB0, pB1, pA0, pA1, t, true, true, true);     FX_WAIT_BAR(2); FX_RESC(); FX_ROT();
        FX_STEP(pA0, pA1, pB0, pB1, t + 1, true, true, true); FX_WAIT_BAR(2); FX_RESC(); FX_ROT();
    }
#undef FX_CMASK
#define FX_CMASK(P0, P1, t) do { const int jb_ = (t) - (NT - 4); if (jb_ >= 0) cmask(P0, P1, jb_, qrel, hi); } while (0)
#define FX_ENDW(tt) do { if ((tt) + 3 < NT) { FX_WAIT_BAR(2); } else if ((tt) + 2 < NT) { FX_WAIT_BAR(1); } else { FX_WAIT_BAR(0); } } while (0)
    for (; t + 1 < NT; t += 2) {
        FX_STEP(pB0, pB1, pA0, pA1, t, (t + 3 < NT), (t + 1 < NT), (t + 1 < NT));         FX_ENDW(t);     FX_RESC(); FX_ROT();
        FX_STEP(pA0, pA1, pB0, pB1, t + 1, (t + 4 < NT), (t + 2 < NT), (t + 2 < NT));     FX_ENDW(t + 1); FX_RESC(); FX_ROT();
    }
    FX_STEP(pB0, pB1, pA0, pA1, NT - 1, false, false, false); FX_RESC();
    { float sacc = pB0[0] + pB0[1];
#pragma unroll
      for (int r = 2; r < 16; ++r) sacc += pB0[r];
#pragma unroll
      for (int r = 0; r < 16; ++r) sacc += pB1[r];
      l_reg += sacc;
      pw0 = (u32x4){FX_PKW(pB0, 0), FX_PKW(pB0, 2), FX_PKW(pB0, 4), FX_PKW(pB0, 6)}; pw1 = (u32x4){FX_PKW(pB0, 8), FX_PKW(pB0, 10), FX_PKW(pB0, 12), FX_PKW(pB0, 14)};
      pw2 = (u32x4){FX_PKW(pB1, 0), FX_PKW(pB1, 2), FX_PKW(pB1, 4), FX_PKW(pB1, 6)}; pw3 = (u32x4){FX_PKW(pB1, 8), FX_PKW(pB1, 10), FX_PKW(pB1, 12), FX_PKW(pB1, 14)};
      FX_SBAR();
      at::VFrag vf_; at::vload<0>(vf_, vb0 + sl_cur); at::vwait(vf_); o[0] = at::pvmma(o[0], vf_, FX_PAF(0), FX_PAF(1), FX_PAF(2), FX_PAF(3));
      FX_SBAR(); at::vload<1>(vf_, vb0 + sl_cur); at::vwait(vf_); o[1] = at::pvmma(o[1], vf_, FX_PAF(0), FX_PAF(1), FX_PAF(2), FX_PAF(3)); }
    { auto rr = __builtin_amdgcn_permlane32_swap(__float_as_uint(l_reg), __float_as_uint(l_reg), false, false); l_reg = __uint_as_float(rr[0]) + __uint_as_float(rr[1]); }
    if (hi == 0) wsf[32 + r32] = l_reg; asm volatile("s_waitcnt lgkmcnt(0)" ::: "memory");
    { LAS bf16* stg = (LAS bf16*)(shm + LDS_OST) + wid * 2048;
#pragma unroll
      for (int r = 0; r < 16; ++r) { const float rl = __builtin_amdgcn_rcpf(wsf[32 + crow(r, hi)]); const int orow = crow(r, hi);
          stg[orow * 64 + r32] = (bf16)(cvtpk(o[0][r] * rl, 0.f) & 0xffffu); stg[orow * 64 + 32 + r32] = (bf16)(cvtpk(o[1][r] * rl, 0.f) & 0xffffu); }
      asm volatile("s_waitcnt lgkmcnt(0)" ::: "memory");
      bf16* Ow = Oh + (size_t)(q0 + wid * 32) * OP;
#pragma unroll
      for (int i = 0; i < 4; ++i) { const int row = i * 8 + (lane >> 3), ch = lane & 7; const u32x4 v = *(const LAS u32x4*)(stg + row * 64 + ch * 8); *(GAS u32x4*)(Ow + (size_t)row * OP + ch * 8) = v; } }
    asm volatile("s_waitcnt lgkmcnt(0)\n\ts_barrier" ::: "memory");
#undef FX_DMA_K
#undef FX_DMA_V
#undef FX_CMASK
#undef FX_RESC
#undef FX_ROT
#undef FX_PKW
#undef FX_PAF
#undef FX_VFR
#undef FX_PIN
#undef FX_GAPA
#undef FX_GAPB
#undef FX_EX
#undef FX_VRD
#undef FX_KRD
#undef FX_STEP
#undef FX_ENDW
}
#undef FX_SBAR
#undef FX_MX3
#undef FX_WAIT_BAR
#undef FX_MFMA
}

template <unsigned MASK> __global__ void __launch_bounds__(NTHR, 2) mk_fwd(Args args) {
    extern __shared__ __attribute__((aligned(16))) unsigned char lds_raw[];
    LAS unsigned char* lds = (LAS unsigned char*)lds_raw;
    volatile LAS unsigned* MISC = (volatile LAS unsigned*)(lds + MISC_OFF);
    const int tid0 = threadIdx.x; const int wave0 = __builtin_amdgcn_readfirstlane(tid0 >> 6);
    const int G = gridDim.x, bx0 = blockIdx.x;
    const int NGW = G * NWAVES, NGT = G * NTHR;
    unsigned char* ws0 = args.ws;
    unsigned* ctl = (unsigned*)(ws0 + WS_CTL);
    for (int u = tid0; u < (LDS_BYTES - MISC_OFF) / 4; u += NTHR) ((LAS unsigned*)(lds + MISC_OFF))[u] = 0u;
    __syncthreads();
    XcdBarrier bar; bar.bar = ctl + CW_BAR; bar.x = 0; bar.st = nullptr;
    if (args.fused) bar = xcd_barrier_post(ctl + CW_BAR, MISC + 8);
#define SEAM() do { if (args.fused) { XcdBarrier b_ = bar; asm volatile("" : "+s"(b_.bar)); xcd_barrier(b_, tid == 0); } } while (0)
    const int lo = args.ph_lo, hi = args.ph_hi;
#define IN(k) (((MASK >> (k)) & 1u) && lo <= (k) && (k) < hi)
#define REPEAT(k) for (int rep_ = 0; rep_ < 1 + (int)((DBL_MASK >> (k)) & 1u); ++rep_)

#define PHASE_BEGIN \
    unsigned char* ws = ws0; asm volatile("" : "+s"(ws)); int bx = bx0; asm volatile("" : "+s"(bx)); float* X = args.out; asm volatile("" : "+s"(X)); \
    ws = (unsigned char*)(GAS unsigned char*)ws; X = (float*)(GAS float*)X;     \
    int lane; asm volatile("v_mbcnt_lo_u32_b32 %0, -1, 0\n\tv_mbcnt_hi_u32_b32 %0, -1, %0" : "=v"(lane)); int wave = wave0; asm volatile("" : "+s"(wave)); const int tid = wave * 64 + lane; (void)tid; \
    const int gw = bx * NWAVES + wave, gtid = bx * NTHR + tid; (void)gw; (void)gtid; \
    bf16* HB = (bf16*)(ws + WS_HB); bf16* PROJ = (bf16*)(ws + WS_PROJ); float* MISCF = (float*)(ws + WS_MISCF); \
    bf16* QC = (bf16*)(ws + WS_QC); bf16* KVC = (bf16*)(ws + WS_KVC); bf16* KR = (bf16*)(ws + WS_KR); float* DL = (float*)(ws + WS_DL); \
    float* RSTD = (float*)(ws + WS_RSTD); bf16* OALL = (bf16*)(ws + WS_OALL); bf16* MERGED = (bf16*)(ws + WS_MERGED); \
    f32x2* CS64 = (f32x2*)(ws + WS_CS64); f32x2* CS32 = (f32x2*)(ws + WS_CS32); \
    bf16* HID = (bf16*)(ws + WS_HID); bf16* XG = (bf16*)(ws + WS_XG); bf16* PB = (bf16*)(ws + WS_PB); bf16* PP = (bf16*)(ws + WS_PP); \
    float* FZ = (float*)(ws + WS_FZ); float* SSC = (float*)(ws + WS_SSC); (void)FZ; (void)SSC; \
    float* SSP_E = (float*)(ws + WS_SSP); float* SSP_G = SSP_E + (size_t)M * 16; float* SSP_H = SSP_G + (size_t)M * 16; float* RSG = (float*)(ws + WS_RSG); bf16* XB = HB; bf16* XBN = (bf16*)(ws + WS_XBN); (void)SSP_E; (void)SSP_G; (void)SSP_H; (void)RSG; (void)XB; (void)XBN; \
    unsigned* ROUTE = (unsigned*)(ws + WS_ROUTE); const int* POS = (const int*)args.in[I_POS]; \
    (void)HB; (void)PROJ; (void)MISCF; (void)QC; (void)KVC; (void)KR; (void)DL; (void)RSTD; (void)OALL; (void)MERGED; (void)CS64; (void)CS32; (void)HID; (void)XG; (void)PB; (void)PP; (void)ROUTE; (void)POS; (void)X;
#define MOE_CUM_ASSIGN { int c_ = 0; _Pragma("unroll") for (int e = 0; e < 8; ++e) { MO.cum[e] = c_; c_ += (int)((__builtin_amdgcn_readfirstlane(__hip_atomic_load(cnt + e, __ATOMIC_RELAXED, __HIP_MEMORY_SCOPE_AGENT)) + 255u) >> 8); } MO.cum[8] = c_; MO.G = G; MO.c = bx; }
#define MOE_CUM \
    pg8::MoeOrder MO; { int c_ = 0; _Pragma("unroll") for (int e = 0; e < 8; ++e) { MO.cum[e] = c_; c_ += (int)((__builtin_amdgcn_readfirstlane(__hip_atomic_load(cnt + e, __ATOMIC_RELAXED, __HIP_MEMORY_SCOPE_AGENT)) + 255u) >> 8); } MO.cum[8] = c_; MO.G = G; MO.c = bx; }

    if (IN(0) && args.l_lo == 0) REPEAT(0) {
        PHASE_BEGIN
        LAS float* scr = (LAS float*)lds + wave * (64 * 33);
        int jid = 0;
#define CONV(src, lds_, K, col0, ncols, dst, ldd, row0, mode, sub, gain, scale) do { conv_items(scr, src, lds_, K, col0, ncols, dst, ldd, row0, mode, sub, gain, scale, (gw + jid * 397) % NGW, NGW, lane); ++jid; } while (0)
        for (int L = 0; L < DEPTH; ++L) {
            const float* win = args.in[I_WIN] + (size_t)L * D * IN_W; const float* gm = args.in[I_MIXN] + L * D;
            bf16* wt = (bf16*)(ws + WS_WIN) + (size_t)L * NPROJ * D;
            CONV(win, IN_W, D, S_FQ, 384, wt, D, C_FQ, 0, 0, gm, QS);
            CONV(win, IN_W, D, S_FK, 768, wt, D, C_FK, 0, 0, gm, 1.f);
            CONV(win, IN_W, D, S_DQ, 384, wt, D, C_DQ, 2, 0, gm, QS);
            CONV(win, IN_W, D, S_DK, 384, wt, D, C_DK, 2, 0, gm, 1.f);
            CONV(win, IN_W, D, S_DV, 384, wt, D, C_DV, 0, 0, gm, 1.f);
            CONV(win, IN_W, D, S_CQ, 512, wt, D, C_CQ, 0, 0, gm, 1.f);
            CONV(win, IN_W, D, S_G, 3072, wt, D, C_G, 4, 0, gm, 1.f);
            CONV(win, IN_W, D, S_KR, 32, wt, D, C_MISC, 3, 0, gm, 1.f);
            CONV(win, IN_W, D, S_FZ, 6, wt, D, C_MISC + 32, 0, 0, gm, 1.f);
            zero_rows(wt, D, C_MISC + 38, NPROJ - (C_MISC + 38), D, gtid, NGT);
            const float* wuq = args.in[I_WUQ] + (size_t)L * 256 * 384; const float* gq = args.in[I_QN] + L * 256;
            const float* wukv = args.in[I_WUKV] + (size_t)L * 256 * 512; const float* gkv = args.in[I_KVN] + L * 256;
            bf16* wup = (bf16*)(ws + WS_WUQ) + (size_t)L * 1024 * 256;
            for (int h = 0; h < 4; ++h) {
                CONV(wuq, 384, 256, h * 96, 64, wup, 256, h * 64, 0, 0, gq, MS);
                CONV(wuq, 384, 256, h * 96 + 64, 32, wup, 256, 256 + h * 32, 3, 0, gq, MS);
                CONV(wukv, 512, 256, h * 128, 64, wup, 256, 512 + h * 64, 0, 0, gkv, 1.f);
                CONV(wukv, 512, 256, h * 128 + 64, 64, wup, 256, 768 + h * 64, 0, 0, gkv, 1.f);
            }
            zero_rows(wup, 256, 384, 128, 256, gtid, NGT);
            bf16* wbr = (bf16*)(ws + WS_WBR) + (size_t)L * D * D;
            CONV(args.in[I_BRF] + (size_t)L * 384 * D, D, 384, 0, D, wbr, D, 0, 0, 0, nullptr, 1.f);
            CONV(args.in[I_BRD] + (size_t)L * 384 * D, D, 384, 0, D, wbr + 384, D, 0, 0, 0, nullptr, 1.f);
            CONV(args.in[I_BRM] + (size_t)L * 256 * D, D, 256, 0, D, wbr + 768, D, 0, 0, 0, nullptr, 1.f);
            CONV(args.in[I_WOUT] + (size_t)L * D * D, D, D, 0, D, (bf16*)(ws + WS_WOUT) + (size_t)L * D * D, D, 0, 0, 0, nullptr, 1.f);
            const float* gf = args.in[I_FFNN] + L * D; const int j = L >> 1;
            if ((L & 1) == 0) {
                bf16* wgu = (bf16*)(ws + WS_WGU) + (size_t)j * 2 * DFF * D;
                CONV(args.in[I_FG] + (size_t)j * D * DFF, DFF, D, 0, DFF, wgu, D, 0, 1, 0, gf, 1.f);
                CONV(args.in[I_FU] + (size_t)j * D * DFF, DFF, D, 0, DFF, wgu, D, 0, 1, 4, gf, 1.f);
                CONV(args.in[I_FD] + (size_t)j * DFF * D, D, DFF, 0, D, (bf16*)(ws + WS_WDN) + (size_t)j * D * DFF, DFF, 0, 4, 0, nullptr, 1.f);
            } else if (L == 1) {
                for (int e = 0; e < NEXP; ++e) {
                    bf16* wgu = (bf16*)(ws + WS_WEGU) + (size_t)e * 2 * DFE * D;
                    CONV(args.in[I_EG] + (size_t)(j * NEXP + e) * D * DFE, DFE, D, 0, DFE, wgu, D, 0, 1, 0, gf, 1.f);
                    CONV(args.in[I_EU] + (size_t)(j * NEXP + e) * D * DFE, DFE, D, 0, DFE, wgu, D, 0, 1, 4, gf, 1.f);
                    CONV(args.in[I_ED] + (size_t)(j * NEXP + e) * DFE * D, D, DFE, 0, D, (bf16*)(ws + WS_WEDN) + (size_t)e * D * DFE, DFE, 0, 0, 0, nullptr, 1.f);
                }
            }
            CONV(args.in[I_WPG] + (size_t)L * D * D, D, D, 0, D, (bf16*)(ws + WS_WPG) + (size_t)L * D * D, D, 0, 4, 0, args.in[I_PLEN] + L * D, 1.f);
            CONV(args.in[I_WPP] + (size_t)L * 256 * D, D, 256, 0, D, (bf16*)(ws + WS_WPP) + (size_t)L * D * D, D, 0, 0, 0, nullptr, 1.f);
        }
        for (int r = gw; r < M; r += NGW) { const f32x4* xs = (const f32x4*)(args.in[I_X] + (size_t)r * D) + lane; f32x4 v[4]; float s_ = 0.f;
#pragma unroll
            for (int j = 0; j < 4; ++j) { v[j] = xs[64 * j]; s_ += (v[j].x * v[j].x + v[j].y * v[j].y) + (v[j].z * v[j].z + v[j].w * v[j].w); }
            store_row_bf16(XBN + (size_t)r * D, v, 1.0f, lane); const float ss = wave_sum(s_);
            { unsigned* o4 = (unsigned*)((unsigned char*)MERGED + (size_t)r * D) + lane;
#pragma unroll
              for (int j = 0; j < 4; ++j) o4[64 * j] = pk4_fp8(v[j].x, v[j].y, v[j].z, v[j].w); }
            if (lane < 16) SSP_H[(size_t)r * 16 + lane] = (lane == 0) ? ss : 0.f; }
        { const f32x4* ps = (const f32x4*)args.in[I_P]; bf16* PBALL = (bf16*)(ws + WS_PBALL);
          for (int i = gtid; i < DEPTH * M * 64; i += NGT) { const int Lp = i / (M * 64), rem = i - Lp * (M * 64), row = rem >> 6, q = rem & 63; const f32x4 a = ps[i];
              u32x2 w; w.x = cvt_pk_bf16(a.x, a.y); w.y = cvt_pk_bf16(a.z, a.w); *(u32x2*)(PBALL + (size_t)row * D + Lp * 256 + 4 * q) = w; } }
        for (int i = gtid; i < M * 32; i += NGT) { const int row = i >> 5, j = i & 31; const float invf = powf(10000.0f, -(float)j / 32.0f); const float ang = (float)POS[row] * invf; float s, c; sincosf(ang, &s, &c); CS64[i] = (f32x2){c, s}; }
        for (int i = gtid; i < M * 16; i += NGT) { const int row = i >> 4, j = i & 15; const float invf = powf(10000.0f, -(float)j / 16.0f); const float ang = (float)POS[row] * invf; float s, c; sincosf(ang, &s, &c); CS32[i] = (f32x2){c, s}; }
        SEAM();
    }

    for (int L = args.l_lo; L < args.l_hi; ++L) {
        const int jl = L >> 1; const bool moe = (L & 1) != 0;
        unsigned* cnt = ctl + CW_CNT + 64 * jl;
        if (IN(2)) REPEAT(2) {
            PHASE_BEGIN
            { pg8::Gemm g{XBN, (const bf16*)(ws + WS_WIN) + (size_t)L * NPROJ * D, D, D}; pg8::SubsetOrder<false> S; S.init(M, 12 * 256, D, G, bx, D, D); S.first = 0; S.alt = 23;
              pg8::EpiProj3 E{PROJ, KR, FZ, SSC, SSP_H, CS64, CS32}; pg8::gemm_phase(lds, g, S, E, tid); }
            { pg8::Gemm g{MERGED, (const bf16*)(ws + WS_WIN) + (size_t)L * NPROJ * D + (size_t)C_G * D, D / 2, D / 2}; pg8::SubsetOrder<true> S; S.init(M, 12 * 256, D / 2, G, bx, D / 2, D / 2); S.first = 0; S.alt = -1;
              pg8::EpiGate EG{PROJ, SSP_H, 1.0f / 32.0f}; pg8::gemm_phase(lds, g, S, EG, tid); }
            SEAM();
        }
        if (IN(4)) REPEAT(4) {
            PHASE_BEGIN
            { pg8::Gemm g{PROJ + C_CQ, (const bf16*)(ws + WS_WUQ) + (size_t)L * 1024 * 256, NPROJ, 256}; pg8::UpOrder S{G, bx};
              pg8::EpiUp E{QC, KVC, SSC, CS32}; pg8::gemm_phase(lds, g, S, E, tid); }
            if (bx < 48) {
                LAS float* sc = (LAS float*)lds; const int b = bx / 6, h = bx % 6; const float bias = args.in[I_BF][L * 6 + h];
                float v[4], run = 0.f;
#pragma unroll
                for (int j = 0; j < 4; ++j) { const float z = FZ[(size_t)(b * T + tid * 4 + j) * 8 + h] + bias; const float ls = fminf(z, 0.f) - log1pf(expf(-fabsf(z))); run += ls; v[j] = run; }
                sc[tid] = run; __syncthreads();
                for (int o = 1; o < NTHR; o <<= 1) { float add = (tid >= o) ? sc[tid - o] : 0.f; __syncthreads(); sc[tid] += add; __syncthreads(); }
                const float base = (tid > 0) ? sc[tid - 1] : 0.f;
#pragma unroll
                for (int j = 0; j < 4; ++j) DL[(size_t)bx * T + tid * 4 + j] = -LOG2E * (base + v[j]);
                __syncthreads();
            }
            SEAM();
        }
        if (IN(6)) REPEAT(6) {
            PHASE_BEGIN
            bf16* DILO = HB;
            float* LSE = (float*)(ws + WS_HB + 24 * MiB);
            const bool perb = (G & 7) == 0; const int xq = bx & 7;
            unsigned* queue = ctl + CW_Q + 64 * L + (perb ? 8 * xq : 0);
            const int NU = perb ? 80 + 3 * 48 : 640 + 3 * 384;
            for (;;) {
                if (tid == 0) MISC[16] = __hip_atomic_fetch_add(queue, 1u, __ATOMIC_RELAXED, __HIP_MEMORY_SCOPE_AGENT);
                asm volatile("s_waitcnt vmcnt(0) lgkmcnt(0)\n\ts_barrier" ::: "memory");
                const int idx = (int)MISC[16];
                asm volatile("s_waitcnt lgkmcnt(0)\n\ts_barrier" ::: "memory");
                if (idx >= NU) break;
                int ln = lane, wv = wave; asm volatile("" : "+v"(ln), "+s"(wv));
                int kind, b, h, qb = 0, br = 0, sub = 0;
                if (perb) { b = xq;
                    if (idx < 80) { qb = 7 - idx / 10; const int jl = idx % 10; kind = (jl < 4) ? 0 : 1; h = (jl < 4) ? jl : jl - 4; }
                    else { const int d = idx - 80; br = d / 48; const int jj = d % 48; kind = 2; h = jj >> 3; sub = jj & 7; }
                } else {
                    if (idx < 640) { qb = 7 - idx / 80; const int j = idx % 80; kind = (j < 32) ? 0 : 1; b = (j < 32) ? (j >> 2) : (j - 32) / 6; h = (j < 32) ? (j & 3) : (j - 32) % 6; }
                    else { const int j = idx - 640; br = j / 384; const int jj = j % 384; kind = 2; b = (jj >> 3) / 6; h = (jj >> 3) % 6; sub = jj & 7; }
                }
                at::Geo g; at::Tens P; g.b = b;
                if (kind == 0) { g.mode = 0; g.r = 1; g.rho = 0; g.u = qb;
                    P.q0 = QC + h * 64; P.q1 = QC + 256 + h * 32; P.qp = 512; P.k0 = KVC + h * 64; P.kp = 512; P.k1 = KR; P.v = KVC + 256 + h * 64; P.vp = 512; P.dl = nullptr;
                    P.o = OALL + 768 + h * 64; P.op = D; P.lse = nullptr;
                    at::attn_unit<true, false>(lds, P, g, ln, wv);
                } else if (kind == 1) {
                    fx::fox_unit<8, NPROJ, D>(lds, PROJ + (size_t)b * T * NPROJ + C_FQ + h * 64, PROJ + (size_t)b * T * NPROJ + C_FK + h * 64, PROJ + (size_t)b * T * NPROJ + C_FV + h * 64,
                                              DL + (size_t)(b * 6 + h) * T, OALL + (size_t)b * T * D + h * 64, qb, ln, wv);
                } else {
                    if (br == 0) { g.mode = 1; g.r = 1; g.rho = 0; g.u = sub; }
                    else if (br == 1) { g.mode = 1; g.r = 4; g.u = sub & 1; g.rho = (sub >> 1) & 3; }
                    else { g.mode = 2; g.r = 16; g.u = 0; g.rho = sub; }
                    P.q0 = PROJ + C_DQ + h * 64; P.q1 = nullptr; P.qp = NPROJ; P.k0 = PROJ + C_DK + h * 64; P.kp = NPROJ; P.k1 = nullptr; P.v = PROJ + C_DV + h * 64; P.vp = NPROJ; P.dl = nullptr;
                    if (br == 0) { P.o = OALL + 384 + h * 64; P.op = D; } else { P.o = DILO + (size_t)(br - 1) * M * 384 + h * 64; P.op = 384; }
                    P.lse = LSE + (size_t)br * M * 8 + h;
                    at::attn_unit<false, false>(lds, P, g, ln, wv);
                }
            }
            SEAM();
        }
        if (IN(7)) REPEAT(7) {
            PHASE_BEGIN
            { const bf16* DILO = HB; const float* LSE = (const float*)(ws + WS_HB + 24 * MiB);
              for (int i = gtid; i < M * 48; i += NGT) { const int row = i / 48, c8 = i - row * 48, h = c8 >> 3;
                  const float l0 = LSE[(size_t)row * 8 + h], l1 = LSE[(size_t)(M + row) * 8 + h], l2 = LSE[(size_t)(2 * M + row) * 8 + h];
                  const float mx = fmaxf(l0, fmaxf(l1, l2)); float w0 = exp2f(l0 - mx), w1 = exp2f(l1 - mx), w2 = exp2f(l2 - mx); const float inv = 1.0f / (w0 + w1 + w2); w0 *= inv; w1 *= inv; w2 *= inv;
                  u32x4* op = (u32x4*)(OALL + (size_t)row * D + 384 + c8 * 8);
                  f32x4 a0, a1, b0, b1, c0, c1; pg8::unpack8(*op, a0, a1); pg8::unpack8(*(const u32x4*)(DILO + (size_t)row * 384 + c8 * 8), b0, b1); pg8::unpack8(*(const u32x4*)(DILO + (size_t)(M + row) * 384 + c8 * 8), c0, c1);
                  *op = pg8::pack8(a0 * w0 + b0 * w1 + c0 * w2, a1 * w0 + b1 * w1 + c1 * w2); }
              SEAM(); }
            { pg8::Gemm g{OALL, (const bf16*)(ws + WS_WBR) + (size_t)L * D * D, D, D}; pg8::MergeOrder S{G, bx};
              pg8::EpiMergeChain E{MERGED, PROJ + C_G}; pg8::gemm_phase(lds, g, S, E, tid); }
            SEAM();
        }
        if (IN(8)) REPEAT(8) {
            PHASE_BEGIN
            pg8::Gemm g{MERGED, (const bf16*)(ws + WS_WOUT) + (size_t)L * D * D, D, D}; pg8::StaticOrder S; S.init(M, D, D, G, bx, D, D);
            pg8::EpiResidX<false> E{XBN, XB, SSP_E, nullptr, 1.0f}; pg8::gemm_phase(lds, g, S, E, tid);
            SEAM();
        }
        if (IN(9) && moe) REPEAT(9) {
            PHASE_BEGIN
            const float* gf = args.in[I_FFNN] + L * D; const float* wr = args.in[I_WR] + (size_t)jl * D * NEXP;
            LAS unsigned* lcnt = (LAS unsigned*)lds;
            LAS unsigned* info = (LAS unsigned*)lds + 16;
            f32x4 wq[4][4][2];
#pragma unroll
            for (int j = 0; j < 4; ++j) { const f32x4 gv = *((const f32x4*)gf + lane + 64 * j);
#pragma unroll
                for (int q = 0; q < 4; ++q) { const int k = 4 * lane + 256 * j + q; wq[j][q][0] = *(const f32x4*)(wr + (size_t)k * 8) * gv[q]; wq[j][q][1] = *(const f32x4*)(wr + (size_t)k * 8 + 4) * gv[q]; } }
            for (int blk = bx; blk < M / 64; blk += G) {
                if (tid < 16) lcnt[tid] = 0u;
                __syncthreads();
                u32x2 raw[8][4];
#pragma unroll
                for (int i = 0; i < 8; ++i) { const u32x2* p = (const u32x2*)(XB + (size_t)(blk * 64 + wave * 8 + i) * D) + lane;
#pragma unroll
                    for (int j = 0; j < 4; ++j) raw[i][j] = p[64 * j]; }
#pragma unroll
                for (int i = 0; i < 8; ++i) { const int lr = wave * 8 + i;
                    f32x4 v[4];
#pragma unroll
                    for (int j = 0; j < 4; ++j) v[j] = (f32x4){bf2f(raw[i][j].x & 0xffffu), bf2f(raw[i][j].x >> 16), bf2f(raw[i][j].y & 0xffffu), bf2f(raw[i][j].y >> 16)};
                    const float rs = row_rstd(v);
                    f32x4 la = (f32x4){0.f, 0.f, 0.f, 0.f}, lb = la;
#pragma unroll
                    for (int j = 0; j < 4; ++j)
#pragma unroll
                        for (int q = 0; q < 4; ++q) { la += wq[j][q][0] * v[j][q]; lb += wq[j][q][1] * v[j][q]; }
                    float lg[8] = {la.x * rs, la.y * rs, la.z * rs, la.w * rs, lb.x * rs, lb.y * rs, lb.z * rs, lb.w * rs};
#pragma unroll
                    for (int e = 0; e < 8; ++e) lg[e] = wave_sum(lg[e]);
                    int e0 = 0; float l0 = lg[0];
#pragma unroll
                    for (int e = 1; e < 8; ++e) if (lg[e] > l0) { l0 = lg[e]; e0 = e; }
                    int e1 = -1; float l1 = -INFINITY;
#pragma unroll
                    for (int e = 0; e < 8; ++e) if (e != e0 && lg[e] > l1) { l1 = lg[e]; e1 = e; }
                    const float w1v = 1.0f / (1.0f + expf(l0 - l1)), w0v = 1.0f - w1v;
                    if (lane == 0) { const unsigned r0 = atomicAdd((unsigned*)(lcnt + e0), 1u), r1 = atomicAdd((unsigned*)(lcnt + e1), 1u);
                        LAS unsigned* io = info + lr * 8; io[0] = e0; io[1] = r0; io[2] = __float_as_uint(w0v); io[3] = e1; io[4] = r1; io[5] = __float_as_uint(w1v); io[6] = __float_as_uint(rs); }
                }
                __syncthreads();
                if (tid < 8) lcnt[8 + tid] = __hip_atomic_fetch_add(cnt + tid, lcnt[tid], __ATOMIC_RELAXED, __HIP_MEMORY_SCOPE_AGENT);
                __syncthreads();
                if (tid < 64) { const LAS unsigned* io = info + tid * 8; unsigned* ro = ROUTE + (size_t)(blk * 64 + tid) * 8;
                    const unsigned e0 = io[0], e1 = io[3]; const unsigned s0 = lcnt[8 + e0] + io[1], s1 = lcnt[8 + e1] + io[4]; ro[0] = e0; ro[1] = s0; ro[2] = io[2]; ro[3] = e1; ro[4] = s1; ro[5] = io[5];
                    int* TOKS = (int*)(ws + WS_TOKS); TOKS[(size_t)e0 * M + s0] = blk * 64 + tid; TOKS[(size_t)e1 * M + s1] = blk * 64 + tid;
                    float* RSL = (float*)(ws + WS_RSL); const float rsv = __uint_as_float(io[6]); RSL[(size_t)e0 * M + s0] = rsv; RSL[(size_t)e1 * M + s1] = rsv; }
                __syncthreads();
            }
            if (L == 3) { LAS float* scr = (LAS float*)lds + wave * (64 * 33); int jid = 0;
                for (int e = 0; e < NEXP; ++e) { bf16* wgu = (bf16*)(ws + WS_WEGU) + (size_t)e * 2 * DFE * D;
                    CONV(args.in[I_EG] + (size_t)(NEXP + e) * D * DFE, DFE, D, 0, DFE, wgu, D, 0, 1, 0, gf, 1.f);
                    CONV(args.in[I_EU] + (size_t)(NEXP + e) * D * DFE, DFE, D, 0, DFE, wgu, D, 0, 1, 4, gf, 1.f);
                    CONV(args.in[I_ED] + (size_t)(NEXP + e) * DFE * D, D, DFE, 0, D, (bf16*)(ws + WS_WEDN) + (size_t)e * D * DFE, DFE, 0, 0, 0, nullptr, 1.f); } }
            SEAM();
        }
        if (IN(10) && !moe) REPEAT(10) {
            PHASE_BEGIN
            pg8::Gemm g{XB, (const bf16*)(ws + WS_WGU) + (size_t)jl * 2 * DFF * D, D, D}; pg8::StaticOrder S; S.init(M, 2 * DFF, D, G, bx, D, D);
            pg8::EpiSwiGLU2<false, true> E{HID, DFF, SSP_E}; pg8::gemm_phase(lds, g, S, E, tid);
            SEAM();
        }
        if (IN(11)) REPEAT(11) {
            PHASE_BEGIN
            if (!moe) {
                pg8::Gemm g{HID, (const bf16*)(ws + WS_WDN) + (size_t)jl * D * DFF, DFF / 2, DFF / 2}; pg8::SubsetOrder<true> S; S.init(M, D, DFF / 2, G, bx, DFF / 2, DFF / 2); S.first = 0; S.alt = -1;
                pg8::EpiResidX<true> E{XB, XB, SSP_G, (unsigned char*)OALL, 1.0f / 256.0f}; pg8::gemm_phase(lds, g, S, E, tid);
            } else {
                pg8::MoeGatherOrder MO; MOE_CUM_ASSIGN
                pg8::Gemm g{XB, (const bf16*)(ws + WS_WEGU), D, D};
                MO.nt = (D) / 64; MO.npn = 2 * DFE / 256; MO.ta = 256L * D * 2; MO.tb = 256L * D * 2; MO.eb = 2L * DFE * D * 2;
                { LAS int* tt = (LAS int*)(lds + pg8::TOK_TAB_OFF); const int* TOKS = (const int*)(ws + WS_TOKS); const float* RSL = (const float*)(ws + WS_RSL);
                  for (int i = 0; i < 8; ++i) { int tile, pnu; if (!MO.unit_tile(i, tile, pnu)) break;
                      int e = 0, c0 = 0;
#pragma unroll
                      for (int k = 1; k < 8; ++k) if (tile >= MO.cum[k]) { e = k; c0 = MO.cum[k]; }
                      const int r0 = (tile - c0) * 256, n = (int)__builtin_amdgcn_readfirstlane(__hip_atomic_load(cnt + e, __ATOMIC_RELAXED, __HIP_MEMORY_SCOPE_AGENT)) - r0;
                      if (tid < 256) { const size_t li = (size_t)e * M + r0 + (tid < n ? tid : 0); tt[i * 256 + tid] = TOKS[li]; ((LAS float*)(lds + pg8::RSU_TAB_OFF))[i * 256 + tid] = RSL[li]; } }
                  __syncthreads(); }
                pg8::EpiSwiGLU2<true> E{HID, DFE, nullptr}; pg8::gemm_phase(lds, g, MO, E, tid);
            }
            SEAM();
        }
        if (IN(12) && moe) REPEAT(12) {
            PHASE_BEGIN
            MOE_CUM
            pg8::Gemm g{HID, (const bf16*)(ws + WS_WEDN), DFE, DFE};
            MO.nt = (DFE) / 64; MO.npn = D / 256; MO.ta = 256L * DFE * 2; MO.tb = 256L * DFE * 2; MO.eb = (long)D * DFE * 2;
            pg8::EpiStore E{XG, D}; pg8::gemm_phase(lds, g, MO, E, tid);
            SEAM();
        }
        if (IN(13) && moe) REPEAT(13) {
            PHASE_BEGIN
            { pg8::MoeOrder MO; MOE_CUM_ASSIGN
            for (int r = gw; r < M; r += NGW) { f32x4 v[4]; load_row_bf16(XB + (size_t)r * D, v, lane);
                const unsigned* ro = ROUTE + (size_t)r * 8; int o0 = 0, o1 = 0; const int e0 = (int)ro[0], e1 = (int)ro[3];
#pragma unroll
                for (int e = 0; e < 8; ++e) { if (e == e0) o0 = MO.cum[e]; if (e == e1) o1 = MO.cum[e]; }
                const float w0 = __uint_as_float(ro[2]), w1 = __uint_as_float(ro[5]);
                const u32x2* y0 = (const u32x2*)(XG + ((size_t)o0 * 256 + ro[1]) * D) + lane; const u32x2* y1 = (const u32x2*)(XG + ((size_t)o1 * 256 + ro[4]) * D) + lane; float s_ = 0.f;
#pragma unroll
                for (int j = 0; j < 4; ++j) { const u32x2 a = y0[64 * j], b2 = y1[64 * j];
                    v[j].x += w0 * bf2f(a.x & 0xffffu) + w1 * bf2f(b2.x & 0xffffu); v[j].y += w0 * bf2f(a.x >> 16) + w1 * bf2f(b2.x >> 16);
                    v[j].z += w0 * bf2f(a.y & 0xffffu) + w1 * bf2f(b2.y & 0xffffu); v[j].w += w0 * bf2f(a.y >> 16) + w1 * bf2f(b2.y >> 16);
                    s_ += (v[j].x * v[j].x + v[j].y * v[j].y) + (v[j].z * v[j].z + v[j].w * v[j].w); }
                store_row_bf16(XB + (size_t)r * D, v, 1.0f, lane); const float ss = wave_sum(s_);
                { unsigned* o4 = (unsigned*)((unsigned char*)OALL + (size_t)r * D) + lane;
#pragma unroll
                  for (int j = 0; j < 4; ++j) o4[64 * j] = pk4_fp8(v[j].x, v[j].y, v[j].z, v[j].w); }
                if (lane < 16) SSP_G[(size_t)r * 16 + lane] = (lane == 0) ? ss : 0.f; } }
            SEAM();
        }
        if (IN(15)) REPEAT(15) {
            PHASE_BEGIN
            { pg8::Gemm g{(const bf16*)ws, (const bf16*)ws, D, D};
              pg8::PleSubOrder<false> S{G, bx, 0, 4, (long)(WS_PBALL + (size_t)L * 512), (long)(WS_WPP + (size_t)L * D * D * 2), 256L * D * 2, 256L * D * 2};
              pg8::EpiStore E{PP, D}; pg8::gemm_phase(lds, g, S, E, tid); }
            { pg8::Gemm g{(const bf16*)ws, (const bf16*)ws, D / 2, D / 2};
              pg8::PleSubOrder<true> S{G, bx, 1, 8, (long)WS_OALL, (long)(WS_WPG + (size_t)L * D * D * 2), 256L * D, 256L * D};
              pg8::EpiPle3 E{XB, XBN, PP, SSP_G, SSP_H, (unsigned char*)MERGED, 1.0f / 32.0f}; pg8::gemm_phase(lds, g, S, E, tid); }
            SEAM();
        }
    }
    if (IN(PH_FINAL) && args.l_hi == DEPTH) {
        PHASE_BEGIN
        const float* gn = args.in[I_FINN];
        for (int r = gw; r < M; r += NGW) { f32x4* xr = (f32x4*)(X + (size_t)r * D) + lane; const float rs = rstd16(SSP_H + (size_t)r * 16); f32x4 v[4]; load_row_bf16(XBN + (size_t)r * D, v, lane);
#pragma unroll
            for (int j = 0; j < 4; ++j) { const f32x4 gv = *((const f32x4*)gn + lane + 64 * j); xr[64 * j] = v[j] * rs * gv; } }
    }
#undef IN
#undef SEAM
}

#ifndef MK_PER_PHASE
#define MK_PER_PHASE 0
#endif
typedef void (*kern_t)(Args);
#if MK_PER_PHASE
template <int K> struct KTab { static void fill(kern_t* t) { t[K] = mk_fwd<(1u << K)>; KTab<K - 1>::fill(t); } };
template <> struct KTab<-1> { static void fill(kern_t*) {} };
#endif
extern "C" void kernel_launch(void* const* d_in, const int* in_sizes, int n_in, void* d_out, int out_size, void* d_ws, size_t ws_size, hipStream_t stream) {
    static int grid = 0; static kern_t tab[PH_FINAL + 1];
    if (grid == 0) {
        if (n_in != 26 || out_size != M * D || ws_size < WS_END) { fprintf(stderr, "kernel_launch: unexpected shapes / workspace (n_in %d out %d ws %zu need %zu)\n", n_in, out_size, ws_size, (size_t)WS_END); grid = -1; return; }
        int dev = 0, cus = 0;
        if (hipGetDevice(&dev) != hipSuccess || hipDeviceGetAttribute(&cus, hipDeviceAttributeMultiprocessorCount, dev) != hipSuccess) { grid = -1; return; }
#if MK_PER_PHASE
        KTab<PH_FINAL>::fill(tab);
#else
        for (int k = 0; k <= PH_FINAL; ++k) tab[k] = mk_fwd<0x1FFFFu>;
#endif
        for (int k = 0; k <= PH_FINAL; ++k)
            if (hipFuncSetAttribute((const void*)tab[k], hipFuncAttributeMaxDynamicSharedMemorySize, LDS_BYTES) != hipSuccess) { grid = -1; return; }
        int per_cu = 0;
        if (hipOccupancyMaxActiveBlocksPerMultiprocessor(&per_cu, (const void*)tab[0], NTHR, LDS_BYTES) != hipSuccess || per_cu < 1) { fprintf(stderr, "kernel_launch: occupancy query reports %d workgroups per CU\n", per_cu); grid = -1; (void)hipGetLastError(); return; }
        (void)hipGetLastError();
        grid = cus;
    }
    if (grid < 0) return;
    (void)hipMemsetAsync((char*)d_ws + WS_CTL, 0, CTL_BYTES, stream);
    Args a{};
    for (int i = 0; i < 26; ++i) a.in[i] = (const float*)d_in[i];
    a.out = (float*)d_out; a.ws = (unsigned char*)d_ws; a.pad = 0;
#if MK_PER_PHASE
    a.fused = 0;
    a.l_lo = 0; a.l_hi = 0; a.ph_lo = 0; a.ph_hi = 1;
    hipLaunchKernelGGL(tab[0], dim3(grid), dim3(NTHR), LDS_BYTES, stream, a);
    for (int L = 0; L < DEPTH; ++L)
        for (int ph = 1; ph <= 15; ++ph) {
            if (ph == 12 && !(L & 1)) continue;
            a.l_lo = L; a.l_hi = L + 1; a.ph_lo = ph; a.ph_hi = ph + 1;
            hipLaunchKernelGGL(tab[ph], dim3(grid), dim3(NTHR), LDS_BYTES, stream, a);
        }
    a.l_lo = DEPTH; a.l_hi = DEPTH; a.ph_lo = PH_FINAL; a.ph_hi = PH_FINAL + 1;
    hipLaunchKernelGGL(tab[PH_FINAL], dim3(grid), dim3(NTHR), LDS_BYTES, stream, a);
#else
    a.fused = 1; a.l_lo = 0; a.l_hi = DEPTH; a.ph_lo = 0; a.ph_hi = PH_FINAL + 1;
    hipLaunchKernelGGL(tab[0], dim3(grid), dim3(NTHR), LDS_BYTES, stream, a);
#endif
}
```

```cpp
#include <hip/hip_runtime.h>
#include <cstdio>
#include <cstdint>
#include <cmath>

#define GAS __attribute__((address_space(1)))
#define LAS __attribute__((address_space(3)))
typedef unsigned short bf16;
typedef unsigned u32x4 __attribute__((ext_vector_type(4)));
typedef unsigned u32x2 __attribute__((ext_vector_type(2)));
typedef float f32x4 __attribute__((ext_vector_type(4)));
typedef float f32x2 __attribute__((ext_vector_type(2)));
typedef short bf16x8 __attribute__((ext_vector_type(8)));
typedef int v4i_t __attribute__((ext_vector_type(4)));
typedef int v8i_t __attribute__((ext_vector_type(8)));

constexpr int BATCH = 8, T = 2048, D = 1024, DEPTH = 4, M = BATCH * T;
constexpr int NPROJ = 6144;
constexpr int C_FQ = 0, C_FK = 384, C_FV = 768, C_DQ = 1152, C_DK = 1536, C_DV = 1920, C_CQ = 2304, C_CKV = 2560, C_G = 2816, C_MISC = 5888;
constexpr int S_FQ = 0, S_FK = 384, S_FV = 768, S_FZ = 1152, S_DQ = 1158, S_DK = 1542, S_DV = 1926, S_CQ = 2310, S_CKV = 2566, S_KR = 2822, S_G = 2854, IN_W = 5926;
constexpr int DFF = 2816, DFE = 1408, NEXP = 8;
constexpr float LOG2E = 1.4426950408889634f;
constexpr float QS = 0.125f * LOG2E;
constexpr float MS = 0.10206207261596577f * LOG2E;
constexpr float EPS = 1e-6f;
constexpr int MOE_ROWS = 2 * M + NEXP * 256;

constexpr size_t MiB = 1u << 20;
constexpr size_t WS_CTL = 0, CTL_BYTES = 1 * MiB;
constexpr size_t WS_WIN = 1 * MiB;
constexpr size_t WS_WUQ = WS_WIN + 48 * MiB;
constexpr size_t WS_WUKV = WS_WUQ + 1 * MiB;
constexpr size_t WS_WBR = WS_WUKV + 1 * MiB;
constexpr size_t WS_WOUT = WS_WBR + 8 * MiB;
constexpr size_t WS_WGU = WS_WOUT + 8 * MiB;
constexpr size_t WS_WDN = WS_WGU + 22 * MiB;
constexpr size_t WS_WEGU = WS_WDN + 11 * MiB;
constexpr size_t WS_WEDN = WS_WEGU + 44 * MiB;
constexpr size_t WS_WPG = WS_WEDN + 22 * MiB;
constexpr size_t WS_WPP = WS_WPG + 8 * MiB;
constexpr size_t WS_HB = WS_WPP + 8 * MiB;
constexpr size_t WS_PROJ = WS_HB + 32 * MiB;
constexpr size_t WS_HID = WS_PROJ;
constexpr size_t WS_XG = WS_PROJ + 96 * MiB;
constexpr size_t WS_PB = WS_PROJ + 32 * MiB;
constexpr size_t WS_PP = WS_PROJ;
constexpr size_t WS_MISCF = WS_PROJ + 192 * MiB;
constexpr size_t WS_QC = WS_MISCF + 4 * MiB;
constexpr size_t WS_KVC = WS_QC + 16 * MiB;
constexpr size_t WS_KR = WS_KVC + 16 * MiB;
constexpr size_t WS_DL = WS_KR + 1 * MiB;
constexpr size_t WS_RSTD = WS_DL + 1 * MiB;
constexpr size_t WS_OALL = WS_RSTD + 1 * MiB;
constexpr size_t WS_MERGED = WS_OALL + 32 * MiB;
constexpr size_t WS_CS64 = WS_MERGED + 32 * MiB;
constexpr size_t WS_CS32 = WS_CS64 + 4 * MiB;
constexpr size_t WS_ROUTE = WS_CS32 + 2 * MiB;
constexpr size_t WS_TOKS = WS_ROUTE + 1 * MiB;
constexpr size_t WS_SSP = WS_TOKS + 1 * MiB;
constexpr size_t WS_RSG = WS_SSP + 3 * MiB;
constexpr size_t WS_RSL = WS_RSG;
constexpr size_t WS_FZ = WS_RSG + 1 * MiB;
constexpr size_t WS_SSC = WS_FZ + 1 * MiB;
constexpr size_t WS_XBN = WS_SSC + 1 * MiB;
constexpr size_t WS_PBALL = WS_XBN + 32 * MiB;
constexpr size_t WS_END = WS_PBALL + 32 * MiB;
constexpr int CW_BAR = 4096;
constexpr int CW_Q = 2048;
constexpr int CW_CNT = 1024;

__device__ __forceinline__ float bf2f(unsigned b) { return __uint_as_float(b << 16); }
typedef __bf16 bf16x2_b __attribute__((ext_vector_type(2)));
__device__ __forceinline__ unsigned cvt_pk_bf16(float lo, float hi) { const f32x2 v = {lo, hi}; const bf16x2_b b = __builtin_convertvector(v, bf16x2_b); return __builtin_bit_cast(unsigned, b); }
__device__ __forceinline__ unsigned pk4_fp8(float a, float b, float c, float d) {
    a = __builtin_amdgcn_fmed3f(a, -448.f, 448.f); b = __builtin_amdgcn_fmed3f(b, -448.f, 448.f); c = __builtin_amdgcn_fmed3f(c, -448.f, 448.f); d = __builtin_amdgcn_fmed3f(d, -448.f, 448.f);
    int p = __builtin_amdgcn_cvt_pk_fp8_f32(a, b, 0, false); p = __builtin_amdgcn_cvt_pk_fp8_f32(c, d, p, true); return (unsigned)p; }
__device__ __forceinline__ float fast_sigmoid(float x) { return __builtin_amdgcn_rcpf(1.0f + __builtin_amdgcn_exp2f(-LOG2E * x)); }
__device__ __forceinline__ float wave_sum(float v) {
#pragma unroll
    for (int o = 1; o < 64; o <<= 1) v += __shfl_xor(v, o);
    return v;
}
__device__ __forceinline__ float wave_max(float v) {
#pragma unroll
    for (int o = 1; o < 64; o <<= 1) v = fmaxf(v, __shfl_xor(v, o));
    return v;
}

__device__ __forceinline__ float rstd16(const float* sp) { const f32x4 a = ((const f32x4*)sp)[0], b = ((const f32x4*)sp)[1], c = ((const f32x4*)sp)[2], d = ((const f32x4*)sp)[3];
    const f32x4 s = (a + b) + (c + d); return 1.0f / sqrtf(((s.x + s.y) + (s.z + s.w)) * (1.0f / D) + EPS); }
namespace pg8 {
constexpr int BM = 256, BK = 64, HALF = 128, HTB = HALF * BK * 2, STAGE_BYTES = 8 * HTB, NXCD = 8, WGM = 8;
__host__ __device__ __forceinline__ int lds_byte(int r, int c) { const int st = (r >> 4) * 2 + (c >> 5), rr = r & 15, cc = c & 31, ob = rr * 64 + cc * 2; return st * 1024 + (ob ^ (((ob >> 9) & 1) << 5)); }
__host__ __device__ __forceinline__ void stage_rc(int b, int& R, int& C) { const int st = b / 1024, sb = b % 1024, swz = sb ^ (((sb >> 9) & 1) << 5); R = (st >> 1) * 16 + swz / 64; C = (st & 1) * 32 + (swz % 64) / 2; }
__host__ __device__ __forceinline__ int perm32(int rho) { const int n = rho >> 4, i = rho & 15; return 8 * (i >> 2) + 4 * n + (i & 3); }

struct Unit { int pm, pn, nt, tag; long aoff, boff; };
struct Gemm { const bf16* A; const bf16* Bt; int lda, ldb; };

__device__ __forceinline__ void tile_map(int wgid, int nM, int nN, int& pm, int& pn) {
    const int nwg = nM * nN; { const int q = nwg / NXCD, r = nwg % NXCD, xcd = wgid % NXCD, off = wgid / NXCD; wgid = (xcd < r ? xcd * (q + 1) : r * (q + 1) + (xcd - r) * q) + off; }
    const int nig = WGM * nN, gid = wgid / nig, fm = gid * WGM, gsz = (nM - fm) < WGM ? (nM - fm) : WGM;
    pm = fm + ((wgid % nig) % gsz); pn = (wgid % nig) / gsz;
}
struct StaticOrder {
    static constexpr bool GATHER = false, FP8 = false;
    int nM, nN, nwg, G, c, nt; long ta, tb;
    __device__ void init(int Mr, int N, int K, int G_, int c_, int lda, int ldb) { nM = Mr / BM; nN = N / BM; nwg = nM * nN; G = G_; c = c_; nt = K / BK; ta = 256L * lda * 2; tb = 256L * ldb * 2; }
    __device__ __forceinline__ bool next(int i, Unit& u) const {
        const long L = (long)i * G + c; if (L >= nwg) return false;
        tile_map((int)L, nM, nN, u.pm, u.pn); u.nt = nt; u.tag = 0; u.aoff = u.pm * ta; u.boff = u.pn * tb; return true;
    }
};
template <bool F8> struct SubsetOrder : StaticOrder {
    static constexpr bool FP8 = F8;
    int first, alt;
    __device__ __forceinline__ bool next(int i, Unit& u) const { if (!StaticOrder::next(i, u)) return false; u.pn = (alt >= 0 && u.pn == nN - 1) ? alt : first + u.pn; u.boff = u.pn * tb; return true; }
};
struct UpOrder {
    static constexpr bool GATHER = false, FP8 = false;
    int G, c;
    __device__ bool next(int i, Unit& u) const {
        const int L = i * G + c; if (L >= 256) return false;
        u.pm = L >> 2; u.pn = L & 3; u.nt = 4; u.tag = 0; u.aoff = u.pm * (256L * NPROJ * 2) + ((u.pn >= 2) ? 512 : 0); u.boff = u.pn * (256L * 256 * 2); return true;
    }
};
struct MergeOrder {
    static constexpr bool GATHER = false, FP8 = false;
    int G, c;
    __device__ bool next(int i, Unit& u) const {
        const int j = i / 3, sub = i - 3 * j; const int L = j * G + c; if (L >= 256) return false;
        tile_map(L, 64, 4, u.pm, u.pn); u.tag = sub; u.nt = (sub == 2) ? 4 : 6; const long ko = (sub == 0) ? 0 : (sub == 1 ? 768 : 1536);
        u.aoff = u.pm * (256L * D * 2) + ko; u.boff = u.pn * (256L * D * 2) + ko; return true;
    }
};
struct PleOrder {
    static constexpr bool GATHER = false, FP8 = false;
    int G, c; long a0, a1, b0, b1;
    __device__ bool next(int i, Unit& u) const {
        const int j = i >> 1, sub = i & 1; const int L = j * G + c; if (L >= 256) return false;
        tile_map(L, 64, 4, u.pm, u.pn); u.tag = sub; u.nt = sub ? 16 : 4;
        u.aoff = (sub ? a1 : a0) + u.pm * (256L * D * 2); u.boff = (sub ? b1 : b0) + u.pn * (256L * D * 2); return true;
    }
};
template <bool F8> struct PleSubOrder {
    static constexpr bool GATHER = false, FP8 = F8;
    int G, c, sub, nt; long a, b, ta, tb;
    __device__ __forceinline__ bool next(int i, Unit& u) const {
        const int L = i * G + c; if (L >= 256) return false;
        tile_map(L, 64, 4, u.pm, u.pn); u.tag = sub; u.nt = nt; u.aoff = a + u.pm * ta; u.boff = b + u.pn * tb; return true;
    }
};
struct MoeOrder {
    static constexpr bool GATHER = false, FP8 = false;
    int cum[9]; int npn, nt, G, c; long ta, tb, eb;
    __device__ __forceinline__ bool unit_tile(int i, int& tile, int& pn) const {
        if ((G & 7) == 0) { const int x = c & 7, idx = i * (G >> 3) + (c >> 3), ntx = (cum[8] - x + 7) >> 3; if (idx >= ntx * npn) return false; tile = x + 8 * (idx / npn); pn = idx % npn; return true; }
        const long L = (long)i * G + c; if (L >= (long)cum[8] * npn) return false;
        tile = (int)(L / npn); pn = (int)(L % npn); return true;
    }
    __device__ __forceinline__ bool next(int i, Unit& u) const {
        int tile, pn; if (!unit_tile(i, tile, pn)) return false;
        int e = 0;
#pragma unroll
        for (int k = 1; k < 8; ++k) e += (tile >= cum[k]) ? 1 : 0;
        u.pm = tile; u.pn = pn; u.nt = nt; u.tag = 0; u.aoff = tile * ta; u.boff = e * eb + pn * tb; return true;
    }
};

struct MoeGatherOrder : MoeOrder {
    static constexpr bool GATHER = true;
    __device__ __forceinline__ bool next(int i, Unit& u) const { if (!MoeOrder::next(i, u)) return false; u.aoff = 0; u.tag = i; return true; }
};
constexpr int TOK_TAB_OFF = 131072 + 8192;
constexpr int RSU_TAB_OFF = 131072 + 16384;

template <class T, class = void> struct epi_chain { static constexpr bool value = false; };
template <class T> struct epi_chain<T, decltype((void)T::CHAIN)> { static constexpr bool value = T::CHAIN; };
template <class Epi> __device__ __forceinline__ bool epi_keep(const Epi& E, const Unit& u) { if constexpr (epi_chain<Epi>::value) return E.keep(u); else return false; }
template <class Epi, class Sched>
__device__ __forceinline__ void gemm_phase(LAS unsigned char* lds, const Gemm g, const Sched& S, const Epi& E, int tid_) {
    int tid = tid_; asm volatile("" : "+v"(tid));
    const int wid = __builtin_amdgcn_readfirstlane(tid >> 6), lane = tid & 63, wr = wid >> 2, wc = wid & 3, fr = lane & 15, fq = lane >> 4;
    unsigned voffA[2], voffB[2];
#pragma unroll
    for (int i = 0; i < 2; ++i) { int R, C; stage_rc(tid * 16 + i * 8192, R, C); const int Rb = (R & ~31) + perm32(R & 31);
        voffA[i] = (unsigned)(R * g.lda + C) * 2u; voffB[i] = (unsigned)(Rb * g.ldb + C) * 2u; }
    const size_t kstep = (size_t)(BK * 2);
    const size_t hstepA = (size_t)HALF * g.lda * 2, hstepB = (size_t)HALF * g.ldb * 2;
    const unsigned ldsw = (unsigned)wid * 1024u;
    const int aoff = lds_byte(wr * 64 + fr, fq * 8), boff = lds_byte(wc * 32 + fr, fq * 8);
#define PG8_SA(b, h) (((b) * 2 + (h)) * HTB)
#define PG8_SB(b, h) ((4 + (b) * 2 + (h)) * HTB)
#define PG8_STAGE(bufoff, gbase, voff) do { _Pragma("unroll") for (int _i = 0; _i < 2; ++_i) \
        __builtin_amdgcn_global_load_lds((const unsigned*)((const char*)(gbase) + (voff)[_i]), (LAS unsigned*)(lds + (bufoff) + ldsw + _i * 8192), 16, 0, 0); } while (0)
#define PG8_STA(b, h, kb, nx) do { if constexpr (Sched::GATHER) { const LAS int* tt_ = (const LAS int*)(lds + TOK_TAB_OFF) + (ui + (((nx) && has_next) ? 1 : 0)) * 256 + (h) * HALF; unsigned v_[2]; \
            _Pragma("unroll") for (int i_ = 0; i_ < 2; ++i_) { int R_, C_; stage_rc(tid * 16 + i_ * 8192, R_, C_); v_[i_] = (unsigned)(tt_[R_] * g.lda + C_) * 2u; } PG8_STAGE(PG8_SA(b, h), (kb), v_); } \
        else PG8_STAGE(PG8_SA(b, h), (kb) + (h) * hstepA, voffA); } while (0)
#define PG8_LDA(dst, b, h) do { _Pragma("unroll") for (int m = 0; m < 4; ++m) { if constexpr (Sched::FP8) { dst##8[m].lo = *(const LAS v4i_t*)(lds + PG8_SA(b, h) + aoff + m * 2048); dst##8[m].hi = *(const LAS v4i_t*)(lds + PG8_SA(b, h) + aoff + m * 2048 + 1024); } \
        else { _Pragma("unroll") for (int k = 0; k < 2; ++k) dst[m][k] = *(const LAS bf16x8*)(lds + PG8_SA(b, h) + aoff + m * 2048 + k * 1024); } } } while (0)
#define PG8_LDB(dst, b, h) do { _Pragma("unroll") for (int n = 0; n < 2; ++n) { if constexpr (Sched::FP8) { dst##8[n].lo = *(const LAS v4i_t*)(lds + PG8_SB(b, h) + boff + n * 2048); dst##8[n].hi = *(const LAS v4i_t*)(lds + PG8_SB(b, h) + boff + n * 2048 + 1024); } \
        else { _Pragma("unroll") for (int k = 0; k < 2; ++k) dst[n][k] = *(const LAS bf16x8*)(lds + PG8_SB(b, h) + boff + n * 2048 + k * 1024); } } } while (0)
#define PG8_MMA(ai, bj, At, Bt) do { __builtin_amdgcn_s_setprio(1); _Pragma("unroll") for (int m = 0; m < 4; ++m) _Pragma("unroll") for (int n = 0; n < 2; ++n) { \
        if constexpr (Sched::FP8) asm volatile("v_mfma_f32_16x16x128_f8f6f4 %0, %1, %2, %0" : "+v"(acc[ai][bj][m][n]) : "v"(Bt##8[n]), "v"(At##8[m]));     \
        else { _Pragma("unroll") for (int k = 0; k < 2; ++k) acc[ai][bj][m][n] = __builtin_amdgcn_mfma_f32_16x16x32_bf16(Bt[n][k], At[m][k], acc[ai][bj][m][n], 0, 0, 0); } } \
        __builtin_amdgcn_s_setprio(0); } while (0)
#define PG8_WAIT_V(n) asm volatile("s_waitcnt vmcnt(" #n ")" ::: "memory")
#define PG8_WAIT_L(n) asm volatile("s_waitcnt lgkmcnt(" #n ")" ::: "memory")
#define PG8_BAR __builtin_amdgcn_s_barrier()
#define PG8_SCHED __builtin_amdgcn_sched_barrier(0)
    Unit cur, nxt; int ui = 0; bool has_next = false;
    if (!S.next(0, cur)) return;
    f32x4 acc[2][2][4][2];
#pragma unroll
    for (int a = 0; a < 2; ++a)
#pragma unroll
        for (int b = 0; b < 2; ++b)
#pragma unroll
            for (int m = 0; m < 4; ++m)
#pragma unroll
                for (int n = 0; n < 2; ++n) acc[a][b][m][n] = (f32x4){0.f, 0.f, 0.f, 0.f};
    bf16x8 At[4][2], B0[2][2], B1[2][2];
    v8i_t At8[4], B08[2], B18[2];
    const char* cA = (const char*)g.A + cur.aoff; const char* cB = (const char*)g.Bt + cur.boff;
    PG8_STAGE(PG8_SB(0, 0), cB, voffB); PG8_STAGE(PG8_SB(0, 1), cB + hstepB, voffB); PG8_STA(0, 0, cA, false); PG8_STA(0, 1, cA, false);
    if (wr == 1) PG8_BAR;
    PG8_WAIT_V(2); PG8_BAR;
    PG8_STAGE(PG8_SB(1, 0), cB + kstep, voffB); PG8_STA(1, 0, cA + kstep, false); PG8_STAGE(PG8_SB(1, 1), cB + hstepB + kstep, voffB);
    PG8_WAIT_V(6); PG8_BAR;
    for (;;) {
        has_next = S.next(ui + 1, nxt);
        const char* nA = has_next ? (const char*)g.A + nxt.aoff : cA; const char* nB = has_next ? (const char*)g.Bt + nxt.boff : cB;
        int nt = cur.nt; asm volatile("" : "+s"(nt));
        for (int t = 0; t < nt; t += 2) {
            const bool last = (t == nt - 2);
            const char* a1 = cA + (size_t)(t + 1) * kstep;
            const char* a2 = last ? nA : cA + (size_t)(t + 2) * kstep; const char* b2 = last ? nB : cB + (size_t)(t + 2) * kstep;
            const char* a3 = a2 + kstep; const char* b3 = b2 + kstep;
            PG8_LDB(B0, 0, 0); PG8_LDB(B1, 0, 1); PG8_SCHED; PG8_LDA(At, 0, 0); PG8_STA(1, 1, a1, false);
            PG8_WAIT_V(8); PG8_WAIT_L(0); PG8_BAR; PG8_MMA(0, 0, At, B0); PG8_MMA(0, 1, At, B1); PG8_BAR; PG8_SCHED;
            PG8_LDA(At, 0, 1); PG8_STAGE(PG8_SB(0, 0), b2, voffB); PG8_STAGE(PG8_SB(0, 1), b2 + hstepB, voffB); PG8_STA(0, 0, a2, last);
            PG8_WAIT_V(8); PG8_WAIT_L(0); PG8_BAR; PG8_MMA(1, 0, At, B0); PG8_MMA(1, 1, At, B1); PG8_BAR; PG8_SCHED;
            PG8_LDB(B0, 1, 0); PG8_LDB(B1, 1, 1); PG8_SCHED; PG8_LDA(At, 1, 0); PG8_STA(0, 1, a2, last);
            PG8_WAIT_V(8); PG8_WAIT_L(0); PG8_BAR; PG8_MMA(0, 0, At, B0); PG8_MMA(0, 1, At, B1); PG8_BAR; PG8_SCHED;
            PG8_LDA(At, 1, 1); PG8_STAGE(PG8_SB(1, 0), b3, voffB); PG8_STAGE(PG8_SB(1, 1), b3 + hstepB, voffB); PG8_STA(1, 0, a3, last);
            PG8_WAIT_V(8); PG8_WAIT_L(0); PG8_BAR; PG8_MMA(1, 0, At, B0); PG8_MMA(1, 1, At, B1); PG8_BAR; PG8_SCHED;
        }
        if constexpr (Sched::FP8) asm volatile("s_nop 15\n\ts_nop 7" ::: "memory");
        if (wr == 0) PG8_BAR;
        if constexpr (Epi::PRE) { E.pre(cur, lds, tid); asm volatile("s_waitcnt lgkmcnt(0)" ::: "memory"); PG8_BAR; }
        if constexpr (epi_chain<Epi>::value) E.chain(acc, cur, wr, wc, fr, fq, lds); else E(acc, cur, wr, wc, fr, fq, lds);
        if (!has_next) break;
        if (!epi_keep(E, cur))
#pragma unroll
        for (int a = 0; a < 2; ++a)
#pragma unroll
            for (int b = 0; b < 2; ++b)
#pragma unroll
                for (int m = 0; m < 4; ++m)
#pragma unroll
                    for (int n = 0; n < 2; ++n) acc[a][b][m][n] = (f32x4){0.f, 0.f, 0.f, 0.f};
        cur = nxt; cA = nA; cB = nB; ++ui;
        if (wr == 1) PG8_BAR;
    }
    PG8_WAIT_V(0);
    PG8_BAR;
#undef PG8_SA
#undef PG8_SB
#undef PG8_STAGE
#undef PG8_LDA
#undef PG8_STA
#undef PG8_LDB
#undef PG8_MMA
#undef PG8_WAIT_V
#undef PG8_WAIT_L
#undef PG8_BAR
#undef PG8_SCHED
}

constexpr int RS_TAB_OFF = 131072 + 4096;
__device__ __forceinline__ u32x4 pack8(f32x4 v0, f32x4 v1) { u32x4 w; w.x = cvt_pk_bf16(v0[0], v0[1]); w.y = cvt_pk_bf16(v0[2], v0[3]); w.z = cvt_pk_bf16(v1[0], v1[1]); w.w = cvt_pk_bf16(v1[2], v1[3]); return w; }
__device__ __forceinline__ void unpack8(u32x4 w, f32x4& a, f32x4& b) {
    a = (f32x4){bf2f(w.x & 0xffffu), bf2f(w.x >> 16), bf2f(w.y & 0xffffu), bf2f(w.y >> 16)};
    b = (f32x4){bf2f(w.z & 0xffffu), bf2f(w.z >> 16), bf2f(w.w & 0xffffu), bf2f(w.w >> 16)}; }
__device__ __forceinline__ float sq8(f32x4 a, f32x4 b) { return ((a.x * a.x + a.y * a.y) + (a.z * a.z + a.w * a.w)) + ((b.x * b.x + b.y * b.y) + (b.z * b.z + b.w * b.w)); }
__device__ __forceinline__ float rstd16f(const float* sp) { const f32x4 a = ((const GAS f32x4*)sp)[0], b = ((const GAS f32x4*)sp)[1], c = ((const GAS f32x4*)sp)[2], d = ((const GAS f32x4*)sp)[3];
    const f32x4 s = (a + b) + (c + d); return __builtin_amdgcn_rsqf(((s.x + s.y) + (s.z + s.w)) * (1.0f / D) + EPS); }
__device__ __forceinline__ void rope4(f32x4& v0, f32x4& v1, const f32x2* cs) {
    const f32x4 a = ((const GAS f32x4*)cs)[0], b = ((const GAS f32x4*)cs)[1]; float x1, x2;
    x1 = v0[0]; x2 = v0[1]; v0[0] = x1 * a.x - x2 * a.y; v0[1] = x2 * a.x + x1 * a.y;
    x1 = v0[2]; x2 = v0[3]; v0[2] = x1 * a.z - x2 * a.w; v0[3] = x2 * a.z + x1 * a.w;
    x1 = v1[0]; x2 = v1[1]; v1[0] = x1 * b.x - x2 * b.y; v1[1] = x2 * b.x + x1 * b.y;
    x1 = v1[2]; x2 = v1[3]; v1[2] = x1 * b.z - x2 * b.w; v1[3] = x2 * b.z + x1 * b.w;
}
#define EPI_HEAD const int row0 = u.pm * BM + wr * 64 + fr, ct0 = wc * 32 + 8 * fq, pn = u.pn; (void)pn; const LAS float* rstab = (const LAS float*)(lds + RS_TAB_OFF) + wr * 64 + fr; (void)rstab;
#define EPI_ARGS const f32x4 (&acc)[2][2][4][2], const Unit& u, int wr, int wc, int fr, int fq, LAS unsigned char* lds
#define EPI_FOR_ROWS _Pragma("unroll") for (int ai = 0; ai < 2; ++ai) _Pragma("unroll") for (int m = 0; m < 4; ++m)
#define EPI_FOR_BJ _Pragma("unroll") for (int bj = 0; bj < 2; ++bj)
#define EPI_RS(ai, m) rstab[(ai) * HALF + (m) * 16]

struct EpiProj3 {
    static constexpr bool PRE = true;
    bf16* P; bf16* KR; float* FZ; float* SSC; const float* SSP; const f32x2* CS64; const f32x2* CS32;
    __device__ __forceinline__ void pre(const Unit& u, LAS unsigned char* lds, int tid) const { if (tid < 256) ((LAS float*)(lds + RS_TAB_OFF))[tid] = rstd16f(SSP + (size_t)(u.pm * BM + tid) * 16); }
    __device__ __forceinline__ void operator()(EPI_ARGS) const {
        EPI_HEAD
        const bool sig = (pn >= 11 && pn < 23), misc = (pn == 23), lat = (pn == 9 || pn == 10);
        if (sig) {
            EPI_FOR_ROWS { const int row = row0 + ai * HALF + m * 16; const float rsn = EPI_RS(ai, m) * (-LOG2E); const float k255 = 1.0f / 255.0f;
                EPI_FOR_BJ { const int col = pn * BM + bj * HALF + ct0; u32x2 q = {0u, 0u};
#pragma unroll
                    for (int e = 0; e < 4; ++e) {
                        q.x = __builtin_amdgcn_cvt_pk_u8_f32(__builtin_amdgcn_rcpf(__builtin_fmaf(__builtin_amdgcn_exp2f(acc[ai][bj][m][0][e] * rsn), k255, k255)), e, q.x);
                        q.y = __builtin_amdgcn_cvt_pk_u8_f32(__builtin_amdgcn_rcpf(__builtin_fmaf(__builtin_amdgcn_exp2f(acc[ai][bj][m][1][e] * rsn), k255, k255)), e, q.y); }
                    *(GAS u32x2*)((GAS unsigned char*)P + (size_t)row * (NPROJ * 2) + 2 * C_G + (col - C_G)) = q; } }
            return;
        }
        EPI_FOR_ROWS { const int row = row0 + ai * HALF + m * 16; const float rs = EPI_RS(ai, m); float ssq = 0.f;
            EPI_FOR_BJ { const int tc = bj * HALF + ct0, col = pn * BM + tc; f32x4 v0 = acc[ai][bj][m][0] * rs, v1 = acc[ai][bj][m][1] * rs;
                const int seg = col >> 6; const bool rope = (seg >= 18 && seg < 30), krt = (misc && bj == 0 && wc == 0);
                if (rope) rope4(v0, v1, CS64 + (size_t)row * 32 + ((col & 63) >> 1));
                if (krt) rope4(v0, v1, CS32 + (size_t)row * 16 + 4 * fq);
                if (lat) ssq += sq8(v0, v1);
                const u32x4 w = pack8(v0, v1);
                *(GAS u32x4*)(P + (size_t)row * NPROJ + col) = w;
                if (krt) *(GAS u32x4*)(KR + (size_t)row * 32 + 8 * fq) = w;
                if (misc && bj == 0 && wc == 1 && fq == 0) { float* fp = FZ + (size_t)row * 8; *(f32x4*)fp = v0; *(GAS f32x4*)(fp + 4) = v1; }
            }
            if (lat) { ssq += __shfl_xor(ssq, 16); ssq += __shfl_xor(ssq, 32); if (fq == 0) ((GAS float*)SSC)[((size_t)(pn - 9) * M + row) * 4 + wc] = ssq; }
        }
    }
};
struct EpiGate {
    static constexpr bool PRE = true;
    bf16* P; const float* SSP; float wscale;
    __device__ __forceinline__ void pre(const Unit& u, LAS unsigned char* lds, int tid) const { if (tid < 256) ((LAS float*)(lds + RS_TAB_OFF))[tid] = rstd16f(SSP + (size_t)(u.pm * BM + tid) * 16); }
    __device__ __forceinline__ void operator()(EPI_ARGS) const {
        EPI_HEAD
        EPI_FOR_ROWS { const int row = row0 + ai * HALF + m * 16; const float rsn = EPI_RS(ai, m) * (-LOG2E) * wscale; const float k255 = 1.0f / 255.0f;
            EPI_FOR_BJ { const int gcol = pn * BM + bj * HALF + ct0; u32x2 q = {0u, 0u};
#pragma unroll
                for (int e = 0; e < 4; ++e) {
                    q.x = __builtin_amdgcn_cvt_pk_u8_f32(__builtin_amdgcn_rcpf(__builtin_fmaf(__builtin_amdgcn_exp2f(acc[ai][bj][m][0][e] * rsn), k255, k255)), e, q.x);
                    q.y = __builtin_amdgcn_cvt_pk_u8_f32(__builtin_amdgcn_rcpf(__builtin_fmaf(__builtin_amdgcn_exp2f(acc[ai][bj][m][1][e] * rsn), k255, k255)), e, q.y); }
                *(GAS u32x2*)((GAS unsigned char*)P + (size_t)row * (NPROJ * 2) + 2 * C_G + gcol) = q; } }
    }
};
struct EpiUp {
    static constexpr bool PRE = true;
    bf16* QC; bf16* KVC; const float* SSC; const f32x2* CS32;
    __device__ __forceinline__ void pre(const Unit& u, LAS unsigned char* lds, int tid) const {
        if (tid < 256) { const f32x4 sp = *(const GAS f32x4*)(SSC + ((size_t)(u.pn >> 1) * M + u.pm * BM + tid) * 4);
            ((LAS float*)(lds + RS_TAB_OFF))[tid] = __builtin_amdgcn_rsqf(((sp.x + sp.y) + (sp.z + sp.w)) * (1.0f / 256.0f) + EPS); } }
    __device__ __forceinline__ void operator()(EPI_ARGS) const {
        EPI_HEAD
        bf16* const dbase = ((pn < 2) ? QC : KVC) + (pn & 1) * 256;
        EPI_FOR_ROWS { const int row = row0 + ai * HALF + m * 16; const float rs = EPI_RS(ai, m);
            EPI_FOR_BJ { const int tc = bj * HALF + ct0; f32x4 v0 = acc[ai][bj][m][0] * rs, v1 = acc[ai][bj][m][1] * rs;
                if (pn == 1 && bj == 0) rope4(v0, v1, CS32 + (size_t)row * 16 + 4 * fq);
                *(GAS u32x4*)(dbase + (size_t)row * 512 + tc) = pack8(v0, v1);
            } }
    }
};
struct EpiMerge {
    static constexpr bool PRE = false;
    bf16* O; const bf16* gate;
    __device__ __forceinline__ void pre(const Unit&, LAS unsigned char*, int) const {}
    __device__ __forceinline__ void operator()(EPI_ARGS) const {
        EPI_HEAD
#pragma unroll
        for (int ai = 0; ai < 2; ++ai) { u32x2 gin[4][2]; u32x4 oin[4][2];
#pragma unroll
            for (int m = 0; m < 4; ++m) EPI_FOR_BJ { const size_t row = (size_t)(row0 + ai * HALF + m * 16); const int col = pn * BM + bj * HALF + ct0;
                gin[m][bj] = *(const GAS u32x2*)((const GAS unsigned char*)gate + row * (NPROJ * 2) + u.tag * 1024 + col); oin[m][bj] = (u.tag != 0) ? *(const GAS u32x4*)(O + row * D + col) : (u32x4){0u, 0u, 0u, 0u}; }
#pragma unroll
            for (int m = 0; m < 4; ++m) EPI_FOR_BJ { const size_t row = (size_t)(row0 + ai * HALF + m * 16); const int col = pn * BM + bj * HALF + ct0;
                f32x4 g0, g1, o0, o1; unpack8(oin[m][bj], o0, o1); const unsigned ga = gin[m][bj].x, gb = gin[m][bj].y; const float k255 = 1.0f / 255.0f;
                g0 = (f32x4){(float)(ga & 255u), (float)((ga >> 8) & 255u), (float)((ga >> 16) & 255u), (float)(ga >> 24)} * k255; g1 = (f32x4){(float)(gb & 255u), (float)((gb >> 8) & 255u), (float)((gb >> 16) & 255u), (float)(gb >> 24)} * k255;
                *(GAS u32x4*)(O + row * D + col) = pack8(acc[ai][bj][m][0] * g0 + o0, acc[ai][bj][m][1] * g1 + o1); } }
    }
};
struct EpiMergeChain {
    static constexpr bool PRE = false, CHAIN = true;
    bf16* O; const bf16* gate;
    __device__ __forceinline__ void pre(const Unit&, LAS unsigned char*, int) const {}
    __device__ __forceinline__ bool keep(const Unit& u) const { return u.tag < 2; }
    static __device__ __forceinline__ void dec8(u32x2 w, bool clamp, f32x4& a, f32x4& b) {
        a = (f32x4){(float)(w.x & 255u), (float)((w.x >> 8) & 255u), (float)((w.x >> 16) & 255u), (float)(w.x >> 24)}; b = (f32x4){(float)(w.y & 255u), (float)((w.y >> 8) & 255u), (float)((w.y >> 16) & 255u), (float)(w.y >> 24)};
        if (clamp) {
#pragma unroll
            for (int e = 0; e < 4; ++e) { a[e] = __builtin_fmaxf(a[e], 1.0f); b[e] = __builtin_fmaxf(b[e], 1.0f); } } }
    __device__ __forceinline__ void chain(f32x4 (&acc)[2][2][4][2], const Unit& u, int wr, int wc, int fr, int fq, LAS unsigned char* lds) const {
        EPI_HEAD
        const int tg = u.tag; const bool last = tg == 2;
#pragma unroll
        for (int ai = 0; ai < 2; ++ai) { u32x2 gc[4][2], gn[4][2];
#pragma unroll
            for (int m = 0; m < 4; ++m) EPI_FOR_BJ { const size_t row = (size_t)(row0 + ai * HALF + m * 16); const int col = pn * BM + bj * HALF + ct0;
                const GAS unsigned char* gp = (const GAS unsigned char*)gate + row * (NPROJ * 2) + tg * 1024 + col;
                gc[m][bj] = *(const GAS u32x2*)gp; gn[m][bj] = last ? (u32x2){0u, 0u} : *(const GAS u32x2*)(gp + 1024); }
#pragma unroll
            for (int m = 0; m < 4; ++m) EPI_FOR_BJ { const size_t row = (size_t)(row0 + ai * HALF + m * 16); const int col = pn * BM + bj * HALF + ct0;
                f32x4 c0, c1, n0, n1; dec8(gc[m][bj], tg != 0, c0, c1);
                if (!last) { dec8(gn[m][bj], true, n0, n1);
#pragma unroll
                    for (int e = 0; e < 4; ++e) { acc[ai][bj][m][0][e] *= c0[e] * __builtin_amdgcn_rcpf(n0[e]); acc[ai][bj][m][1][e] *= c1[e] * __builtin_amdgcn_rcpf(n1[e]); } }
                if (last) { const float k255 = 1.0f / 255.0f; *(GAS u32x4*)(O + row * D + col) = pack8(acc[ai][bj][m][0] * (c0 * k255), acc[ai][bj][m][1] * (c1 * k255)); } } }
    }
};
template <bool Q8> struct EpiResidX {
    static constexpr bool PRE = false;
    const bf16* XBi; bf16* XBo; float* SSPo; unsigned char* XQ8; float ascale;
    __device__ __forceinline__ void pre(const Unit&, LAS unsigned char*, int) const {}
    __device__ __forceinline__ void operator()(EPI_ARGS) const {
        EPI_HEAD
#pragma unroll
        for (int ai = 0; ai < 2; ++ai) { u32x4 xin[4][2];
#pragma unroll
            for (int m = 0; m < 4; ++m) EPI_FOR_BJ xin[m][bj] = *(const GAS u32x4*)(XBi + (size_t)(row0 + ai * HALF + m * 16) * D + pn * BM + bj * HALF + ct0);
#pragma unroll
            for (int m = 0; m < 4; ++m) { const int row = row0 + ai * HALF + m * 16; float ss = 0.f;
                EPI_FOR_BJ { const int col = pn * BM + bj * HALF + ct0; f32x4 x0, x1; unpack8(xin[m][bj], x0, x1);
                    x0 = x0 + acc[ai][bj][m][0] * ascale; x1 = x1 + acc[ai][bj][m][1] * ascale;
                    *(GAS u32x4*)(XBo + (size_t)row * D + col) = pack8(x0, x1); ss += sq8(x0, x1);
                    if (Q8) { u32x2 q8; q8.x = pk4_fp8(x0[0], x0[1], x0[2], x0[3]); q8.y = pk4_fp8(x1[0], x1[1], x1[2], x1[3]); *(GAS u32x2*)(XQ8 + (size_t)row * D + col) = q8; } }
                ss += __shfl_xor(ss, 16); ss += __shfl_xor(ss, 32); if (fq == 0) ((GAS float*)SSPo)[(size_t)row * 16 + pn * 4 + wc] = ss; } }
    }
};
template <bool GATH, bool F8O = false> struct EpiSwiGLU2 {
    static constexpr bool PRE = !GATH;
    bf16* Hd; int ldh; const float* rsp;
    __device__ __forceinline__ void pre(const Unit& u, LAS unsigned char* lds, int tid) const {
        if (tid < 256) ((LAS float*)(lds + RS_TAB_OFF))[tid] = rstd16f(rsp + (size_t)(u.pm * BM + tid) * 16); }
    __device__ __forceinline__ void operator()(EPI_ARGS) const {
        EPI_HEAD
        const LAS float* rsu = (const LAS float*)(lds + RSU_TAB_OFF) + u.tag * 256 + wr * 64 + fr;
        EPI_FOR_ROWS { const int row = row0 + ai * HALF + m * 16; const float rs = GATH ? rsu[ai * HALF + m * 16] : EPI_RS(ai, m);
            EPI_FOR_BJ { const int col = pn * BM + bj * HALF + ct0; const f32x4 g = acc[ai][bj][m][0] * rs, up = acc[ai][bj][m][1] * rs; f32x4 h;
#pragma unroll
                for (int e = 0; e < 4; ++e) h[e] = g[e] * fast_sigmoid(g[e]) * up[e];
                if (F8O) *(GAS unsigned*)((GAS unsigned char*)Hd + (size_t)row * ldh + (col >> 1)) = pk4_fp8(h[0] * 8.f, h[1] * 8.f, h[2] * 8.f, h[3] * 8.f);
                else { u32x2 w; w.x = cvt_pk_bf16(h[0], h[1]); w.y = cvt_pk_bf16(h[2], h[3]); *(GAS u32x2*)(Hd + (size_t)row * ldh + (col >> 1)) = w; } } }
    }
};
struct EpiStore {
    static constexpr bool PRE = false;
    bf16* O; int ldc;
    __device__ __forceinline__ void pre(const Unit&, LAS unsigned char*, int) const {}
    __device__ __forceinline__ void operator()(EPI_ARGS) const {
        EPI_HEAD
        EPI_FOR_ROWS { const int row = row0 + ai * HALF + m * 16;
            EPI_FOR_BJ { const int col = pn * BM + bj * HALF + ct0; *(GAS u32x4*)(O + (size_t)row * ldc + col) = pack8(acc[ai][bj][m][0], acc[ai][bj][m][1]); } }
    }
};
struct EpiPle3 {
    static constexpr bool PRE = true;
    const bf16* XBi; bf16* XBo; bf16* PPS; const float* SSPi; float* SSPo; unsigned char* XQ8; float wscale;
    __device__ __forceinline__ void pre(const Unit& u, LAS unsigned char* lds, int tid) const { if (u.tag != 0 && tid < 256) ((LAS float*)(lds + RS_TAB_OFF))[tid] = rstd16f(SSPi + (size_t)(u.pm * BM + tid) * 16) * wscale; }
    __device__ __forceinline__ void operator()(EPI_ARGS) const {
        EPI_HEAD
        if (u.tag == 0) {
            EPI_FOR_ROWS { const int row = row0 + ai * HALF + m * 16;
                EPI_FOR_BJ { const int col = pn * BM + bj * HALF + ct0; *(GAS u32x4*)(PPS + (size_t)row * D + col) = pack8(acc[ai][bj][m][0], acc[ai][bj][m][1]); } }
        } else {
#pragma unroll
            for (int aq = 0; aq < 4; ++aq) { const int ai = aq >> 1, m0 = (aq & 1) * 2; u32x4 xin[4][2], pin[4][2];
#pragma unroll
                for (int m = m0; m < m0 + 2; ++m) EPI_FOR_BJ { const size_t off = (size_t)(row0 + ai * HALF + m * 16) * D + pn * BM + bj * HALF + ct0; xin[m][bj] = *(const GAS u32x4*)(XBi + off); pin[m][bj] = *(const GAS u32x4*)(PPS + off); }
#pragma unroll
                for (int m = m0; m < m0 + 2; ++m) { const int row = row0 + ai * HALF + m * 16; const float rs = EPI_RS(ai, m); float ss = 0.f;
                    EPI_FOR_BJ { const int col = pn * BM + bj * HALF + ct0; f32x4 p0, p1, x0, x1; unpack8(pin[m][bj], p0, p1); unpack8(xin[m][bj], x0, x1);
                        const f32x4 v0 = acc[ai][bj][m][0] * rs, v1 = acc[ai][bj][m][1] * rs;
#pragma unroll
                        for (int e = 0; e < 4; ++e) { x0[e] += fast_sigmoid(v0[e]) * p0[e]; x1[e] += fast_sigmoid(v1[e]) * p1[e]; }
                        *(GAS u32x4*)(XBo + (size_t)row * D + col) = pack8(x0, x1); ss += sq8(x0, x1);
                        { u32x2 q8; q8.x = pk4_fp8(x0[0], x0[1], x0[2], x0[3]); q8.y = pk4_fp8(x1[0], x1[1], x1[2], x1[3]); *(GAS u32x2*)(XQ8 + (size_t)row * D + col) = q8; } }
                    ss += __shfl_xor(ss, 16); ss += __shfl_xor(ss, 32); if (fq == 0) ((GAS float*)SSPo)[(size_t)row * 16 + pn * 4 + wc] = ss; } }
        }
    }
};
}

#define XB_TMO      128
#define XB_XCNT(j)  (256  + 64 * (j))
#define XB_XSUB(j)  (1280 + 64 * (j))
#define XB_XGEN(j)  (2304 + 64 * (j))
#define XB_TOP      3328
#define XB_TOPGEN   3392
#define XCD_BAR_WORDS 3456
#define XB_SPIN_CAP (1u << 18)
__device__ __forceinline__ unsigned xb_ld(unsigned* p)              { return __hip_atomic_load(p, __ATOMIC_RELAXED, __HIP_MEMORY_SCOPE_AGENT); }
__device__ __forceinline__ unsigned xb_add(unsigned* p, unsigned v) { return __hip_atomic_fetch_add(p, v, __ATOMIC_RELAXED, __HIP_MEMORY_SCOPE_AGENT); }
__device__ __forceinline__ unsigned xb_xcc_id() { return (unsigned)__builtin_amdgcn_s_getreg((3 << 11) | 20) & 0xFu; }
#define XB_SPIN(cond, bar) do { unsigned _sp = 0; while (cond) { __builtin_amdgcn_s_sleep(1); \
    if ((++_sp & 255u) == 0u) { if (xb_ld(&(bar)[XB_TMO])) break; if (_sp > XB_SPIN_CAP) { atomicAdd(&(bar)[XB_TMO], 1u); break; } } } } while (0)
struct XcdBarrier { unsigned* bar; unsigned x; volatile LAS unsigned* st; };
__device__ __forceinline__ XcdBarrier xcd_barrier_post(unsigned* bar, volatile LAS unsigned* st) {
    XcdBarrier b; b.bar = bar; b.x = xb_xcc_id(); b.st = st;
    if (threadIdx.x == 0) (void)xb_add(&bar[XB_XCNT(b.x)], 1u);
    return b;
}
__device__ __forceinline__ void xcd_barrier_complete(unsigned* bar, unsigned x, unsigned& nloc, unsigned& nx) {
    const unsigned G = gridDim.x * gridDim.y * gridDim.z;
    unsigned sum, cnt, mine, sp = 0u;
    for (;;) {
        sum = 0u; cnt = 0u; mine = 0u;
#pragma unroll
        for (unsigned j = 0; j < 16; ++j) { const unsigned c = xb_ld(&bar[XB_XCNT(j)]); sum += c; cnt += (c > 0u) ? 1u : 0u; mine = (j == x) ? c : mine; }
        if (sum == G) break;
        __builtin_amdgcn_s_sleep(1);
        if ((++sp & 255u) == 0u) { if (xb_ld(&bar[XB_TMO])) break; if (sp > XB_SPIN_CAP) { atomicAdd(&bar[XB_TMO], 1u); break; } }
    }
    nloc = mine > 0u ? mine : 1u; nx = cnt > 0u ? cnt : 1u;
}
__device__ __forceinline__ void xcd_barrier(const XcdBarrier& b, bool leader) {
    asm volatile("s_waitcnt vmcnt(0)" ::: "memory");
    __syncthreads();
    if (leader) {
        unsigned* bar = b.bar;
        __builtin_amdgcn_s_waitcnt(0);
        unsigned nloc = b.st[0], nx = b.st[1];
        if (nloc == 0u) { xcd_barrier_complete(bar, b.x, nloc, nx); b.st[0] = nloc; b.st[1] = nx; }
        const unsigned old = xb_add(&bar[XB_XSUB(b.x)], 1u);
        const unsigned gen = old / nloc;
        if (old + 1u == (gen + 1u) * nloc) {
            __builtin_amdgcn_fence(__ATOMIC_RELEASE, "agent");
            asm volatile("s_waitcnt vmcnt(0)" ::: "memory");
            const unsigned og = xb_add(&bar[XB_TOP], 1u);
            const unsigned tg = og / nx;
            if (og + 1u == (tg + 1u) * nx) xb_add(&bar[XB_TOPGEN], 1u);
            else XB_SPIN(xb_ld(&bar[XB_TOPGEN]) == tg, bar);
            __builtin_amdgcn_fence(__ATOMIC_ACQUIRE, "agent");
            xb_add(&bar[XB_XGEN(b.x)], 1u);
            asm volatile("s_waitcnt vmcnt(0)" ::: "memory");
        } else {
            XB_SPIN(xb_ld(&bar[XB_XGEN(b.x)]) == gen, bar);
            __builtin_amdgcn_fence(__ATOMIC_ACQUIRE, "agent");
            asm volatile("s_waitcnt vmcnt(0)" ::: "memory");
        }
    }
    __syncthreads();
}

constexpr int RING_BYTES = 131072;
constexpr int MISC_OFF = RING_BYTES;
constexpr int LDS_BYTES = 155648;
constexpr int NWAVES = 8, NTHR = 512;

struct Args { const float* in[26]; float* out; unsigned char* ws; int l_lo, l_hi, ph_lo, ph_hi, fused, pad; };
enum { I_X = 0, I_P, I_POS, I_MIXN, I_WIN, I_BF, I_QN, I_KVN, I_WUQ, I_WUKV, I_BRF, I_BRD, I_BRM, I_WOUT, I_FFNN, I_FG, I_FU, I_FD, I_WR, I_EG, I_EU, I_ED, I_PLEN, I_WPG, I_WPP, I_FINN };
constexpr int PH_FINAL = 16;
constexpr unsigned DBL_MASK = 0u;

__device__ __forceinline__ int map_row(int c, int mode, int sub) {
    if (mode == 1) return (c >> 2) * 8 + sub + (c & 3);
    if (mode == 2) { const int d = c & 63; return (c & ~63) + (d < 32 ? 2 * d : 2 * (d - 32) + 1); }
    if (mode == 3) { const int d = c & 31; return (c & ~31) + (d < 16 ? 2 * d : 2 * (d - 16) + 1); }
    return c;
}
__device__ __forceinline__ void conv_job(LAS float* scr, const float* src, int lds_, int K, int col0, int ncols, bf16* dst, int ldd, int row0, int mode, int sub,
                                         const float* gain, float scale, int wg, int nwg) {
    const int tid = threadIdx.x;
    const int nct = (ncols + 63) >> 6, nkt = K >> 6, ntiles = nct * nkt;
    for (int t = wg; t < ntiles; t += nwg) {
        const int kt = t / nct, ct = t - kt * nct, k0 = kt * 64, c0 = ct * 64;
#pragma unroll
        for (int j = 0; j < 8; ++j) { const int kk = (tid >> 6) + 8 * j, cc = tid & 63; float v = 0.f;
            if (c0 + cc < ncols) v = src[(size_t)(k0 + kk) * lds_ + col0 + c0 + cc];
            if (gain) v *= gain[k0 + kk];
            scr[kk * 65 + cc] = v * scale; }
        __syncthreads();
        { const int cc = tid >> 3, kc = (tid & 7) * 8;
          if (c0 + cc < ncols) { const int c = c0 + cc; const int dr = row0 + map_row(c, mode, sub);
              u32x4 o; o.x = cvt_pk_bf16(scr[(kc + 0) * 65 + cc], scr[(kc + 1) * 65 + cc]); o.y = cvt_pk_bf16(scr[(kc + 2) * 65 + cc], scr[(kc + 3) * 65 + cc]);
              o.z = cvt_pk_bf16(scr[(kc + 4) * 65 + cc], scr[(kc + 5) * 65 + cc]); o.w = cvt_pk_bf16(scr[(kc + 6) * 65 + cc], scr[(kc + 7) * 65 + cc]);
              *(u32x4*)(dst + (size_t)dr * ldd + k0 + kc) = o; } }
        __syncthreads();
    }
}
__device__ __forceinline__ void conv_items(LAS float* scr, const float* src, int lds_, int K, int col0, int ncols, bf16* dst, int ldd, int row0, int mode, int sub,
                                           const float* gain, float scale, int start, int nw, int lane) {
    const int nct = (ncols + 31) >> 5, nkt = K >> 6, nitems = ((nct + 3) >> 2) * nkt * 4;
    for (int it = start; it < nitems; it += nw) {
        const int r_ = it >> 2, kt = r_ % nkt, ct = (r_ / nkt) * 4 + (it & 3), k0 = kt * 64, c0 = ct * 32;
        if (ct >= nct) continue;
        const int cp = 2 * (lane & 15), kr = lane >> 4; const bool okc = (c0 + cp) < ncols; const float* sp = src + (size_t)(k0 + kr) * lds_ + col0 + c0 + cp;
        f32x2 v[16];
#pragma unroll
        for (int i = 0; i < 16; ++i) v[i] = okc ? __builtin_nontemporal_load((const f32x2*)(sp + (size_t)(4 * i) * lds_)) : (f32x2){0.f, 0.f};
#pragma unroll
        for (int i = 0; i < 16; ++i) { scr[(4 * i + kr) * 33 + cp] = v[i].x; scr[(4 * i + kr) * 33 + cp + 1] = v[i].y; }
        asm volatile("s_waitcnt lgkmcnt(0)" ::: "memory");
        const int c = lane & 7;
        f32x4 g0 = (f32x4){scale, scale, scale, scale}, g1 = g0;
        if (gain) { g0 = *(const f32x4*)(gain + k0 + 8 * c) * scale; g1 = *(const f32x4*)(gain + k0 + 8 * c + 4) * scale; }
#pragma unroll
        for (int j = 0; j < 4; ++j) { const int n = (lane >> 3) + 8 * j; const LAS float* s = scr + (8 * c) * 33 + n;
            u32x4 o; o.x = cvt_pk_bf16(s[0 * 33] * g0.x, s[1 * 33] * g0.y); o.y = cvt_pk_bf16(s[2 * 33] * g0.z, s[3 * 33] * g0.w);
            o.z = cvt_pk_bf16(s[4 * 33] * g1.x, s[5 * 33] * g1.y); o.w = cvt_pk_bf16(s[6 * 33] * g1.z, s[7 * 33] * g1.w);
            if (mode == 4) {
                u32x2 o8; o8.x = pk4_fp8(s[0 * 33] * g0.x * 32.f, s[1 * 33] * g0.y * 32.f, s[2 * 33] * g0.z * 32.f, s[3 * 33] * g0.w * 32.f); o8.y = pk4_fp8(s[4 * 33] * g1.x * 32.f, s[5 * 33] * g1.y * 32.f, s[6 * 33] * g1.z * 32.f, s[7 * 33] * g1.w * 32.f);
                if (c0 + n < ncols) *(u32x2*)((unsigned char*)(dst + (size_t)row0 * ldd) + (size_t)(c0 + n) * ldd + k0 + 8 * c) = o8; }
            else if (c0 + n < ncols) *(u32x4*)(dst + (size_t)(row0 + map_row(c0 + n, mode, sub)) * ldd + k0 + 8 * c) = o; }
        asm volatile("s_waitcnt lgkmcnt(0)" ::: "memory");
    }
}
__device__ __forceinline__ void zero_rows(bf16* dst, int ldd, int row0, int nrows, int K, int gtid, int ngt) {
    const int per = K >> 3, n = nrows * per;
    for (int i = gtid; i < n; i += ngt) { const int r = i / per, k = (i - r * per) * 8; *(u32x4*)(dst + (size_t)(row0 + r) * ldd + k) = (u32x4){0u, 0u, 0u, 0u}; }
}

__device__ __forceinline__ float row_rstd(const f32x4 (&v)[4]) {
    float s = 0.f;
#pragma unroll
    for (int j = 0; j < 4; ++j) s += (v[j].x * v[j].x + v[j].y * v[j].y) + (v[j].z * v[j].z + v[j].w * v[j].w);
    return 1.0f / sqrtf(wave_sum(s) * (1.0f / D) + EPS);
}
__device__ __forceinline__ void store_row_bf16(bf16* orow, const f32x4 (&v)[4], float s, int lane) {
    u32x2* o8 = (u32x2*)orow + lane;
#pragma unroll
    for (int j = 0; j < 4; ++j) { u32x2 w; w.x = cvt_pk_bf16(v[j].x * s, v[j].y * s); w.y = cvt_pk_bf16(v[j].z * s, v[j].w * s); o8[64 * j] = w; }
}

__device__ __forceinline__ void load_row_bf16(const bf16* row, f32x4 (&v)[4], int lane) {
    const u32x2* p = (const u32x2*)row + lane;
#pragma unroll
    for (int j = 0; j < 4; ++j) { const u32x2 w = p[64 * j]; v[j] = (f32x4){bf2f(w.x & 0xffffu), bf2f(w.x >> 16), bf2f(w.y & 0xffffu), bf2f(w.y >> 16)}; }
}
namespace at {
typedef float f32x16 __attribute__((ext_vector_type(16)));
typedef short s16x4 __attribute__((ext_vector_type(4)));
typedef __bf16 bf16x2_t __attribute__((ext_vector_type(2)));
constexpr int VSLOT = 8192;
constexpr int L_K = 0, L_V = 49152, L_DL = L_V + 49152, L_WS = L_DL + 8192, L_END = L_WS + 8 * 256;
constexpr int BIGW = 1 << 24;
__device__ __forceinline__ int crow(int r, int hi) { return (r & 3) + 8 * (r >> 2) + 4 * hi; }
__device__ __forceinline__ void glds16(const void* gsrc, unsigned lds_dst) { unsigned keep;
    asm volatile("s_mov_b32 %0, m0\n\ts_mov_b32 m0, %2\n\ts_nop 0\n\tglobal_load_lds_dwordx4 %1, off\n\ts_mov_b32 m0, %0" : "=&s"(keep) : "v"(gsrc), "s"(lds_dst) : "memory"); }
__device__ __forceinline__ unsigned cvtpk(float lo, float hi) { f32x2 v = {lo, hi}; bf16x2_t b = __builtin_convertvector(v, bf16x2_t); return __builtin_bit_cast(unsigned, b); }
struct VFrag { s16x4 lo[4], hi[4]; };
template <int H> __device__ __forceinline__ void vload(VFrag& f, int vb) {
#pragma unroll
    for (int i = 0; i < 4; ++i) {
        asm volatile("ds_read_b64_tr_b16 %0,%1 offset:%c2" : "=&v"(f.lo[i]) : "v"(vb), "i"(H * 4096 + i * 1024) : "memory");
        asm volatile("ds_read_b64_tr_b16 %0,%1 offset:%c2" : "=&v"(f.hi[i]) : "v"(vb), "i"(H * 4096 + i * 1024 + 512) : "memory"); }
}
__device__ __forceinline__ void vwait(VFrag& f) {
    asm volatile("s_waitcnt lgkmcnt(0)" : "+v"(f.lo[0]), "+v"(f.lo[1]), "+v"(f.lo[2]), "+v"(f.lo[3]), "+v"(f.hi[0]), "+v"(f.hi[1]), "+v"(f.hi[2]), "+v"(f.hi[3]) :: "memory");
}
__device__ __forceinline__ f32x16 pvmma(f32x16 o, const VFrag& f, bf16x8 pa0, bf16x8 pa1, bf16x8 pa2, bf16x8 pa3) {
#define AT_PK(i) (bf16x8){f.lo[i][0], f.lo[i][1], f.lo[i][2], f.lo[i][3], f.hi[i][0], f.hi[i][1], f.hi[i][2], f.hi[i][3]}
    o = __builtin_amdgcn_mfma_f32_32x32x16_bf16(pa0, AT_PK(0), o, 0, 0, 0); o = __builtin_amdgcn_mfma_f32_32x32x16_bf16(pa1, AT_PK(1), o, 0, 0, 0);
    o = __builtin_amdgcn_mfma_f32_32x32x16_bf16(pa2, AT_PK(2), o, 0, 0, 0); o = __builtin_amdgcn_mfma_f32_32x32x16_bf16(pa3, AT_PK(3), o, 0, 0, 0);
#undef AT_PK
    return o;
}
struct Geo { int mode, b, r, rho, u; };
__device__ __forceinline__ int g_kt0(const Geo& g) { const int k = 4 * g.u - 2; return k > 0 ? k : 0; }
__device__ __forceinline__ int g_nt(const Geo& g) { return g.mode == 0 ? 4 * (g.u + 1) : (g.mode == 1 ? 4 * g.u + 4 - g_kt0(g) : 4); }
__device__ __forceinline__ int g_str(const Geo& g) { return g.mode == 0 ? 1 : (g.mode == 1 ? g.r : 16); }
__device__ __forceinline__ int g_qrow0(const Geo& g, int w) { return g.mode == 0 ? g.b * T + 256 * g.u + 32 * w : (g.mode == 1 ? g.b * T + g.rho + g.r * (256 * g.u + 32 * w) : g.b * T + 2 * g.rho + (w >> 2) + 512 * (w & 3)); }
__device__ __forceinline__ int g_qpos0(const Geo& g, int w) { return g.mode == 2 ? 1024 * (w >> 2) + 32 * (w & 3) : 256 * g.u + 32 * w; }
__device__ __forceinline__ int g_kpos0(const Geo& g, int t) { return g.mode == 0 ? 64 * t : (g.mode == 1 ? 64 * (g_kt0(g) + t) : 1024 * (t >> 1) + 64 * (t & 1)); }
__device__ __forceinline__ int g_krow0(const Geo& g, int t) { return g.mode == 0 ? g.b * T + 64 * t : (g.mode == 1 ? g.b * T + g.rho + g.r * 64 * (g_kt0(g) + t) : g.b * T + 2 * g.rho + (t >> 1) + 1024 * (t & 1)); }
struct Tens { const bf16* q0; const bf16* q1; int qp; const bf16* k0; int kp; const bf16* k1; const bf16* v; int vp; const float* dl; bf16* o; int op; float* lse; };

template <bool MLA, bool BIAS> __device__ __forceinline__ void attn_unit(LAS unsigned char* lds, const Tens& P, const Geo& g, int lane, int wid) {
    constexpr int ND0 = MLA ? 6 : 4; constexpr int KSLOT = MLA ? 12288 : 8192; constexpr bool NEGM = !MLA && !BIAS;
    const int r32 = lane & 31, hi = lane >> 5;
    const unsigned lds0 = (unsigned)(size_t)lds;
    LAS float* wsf = (LAS float*)(lds + L_WS) + wid * 64;
    const LAS float* dls = (const LAS float*)(lds + L_DL);
    const int NT = g_nt(g), str = g_str(g), W = (g.mode == 0) ? BIGW : 128;
    const int qrow0 = g_qrow0(g, wid), qpos0 = g_qpos0(g, wid);
#define AT_ISSUE(t, slot) do { const int kr0_ = g_krow0(g, (t)); \
        glds16(P.k0 + (size_t)(kr0_ + str * lane) * P.kp + 8 * wid, (unsigned)__builtin_amdgcn_readfirstlane(lds0 + L_K + (slot) * KSLOT + wid * 1024)); \
        if (MLA) glds16(P.k1 + (size_t)(kr0_ + str * lane) * 32 + 8 * (wid & 3), (unsigned)__builtin_amdgcn_readfirstlane(lds0 + L_K + (slot) * KSLOT + (8 + (wid & 3)) * 1024)); \
        glds16(P.v + (size_t)(kr0_ + str * (16 * (wid & 3) + (lane >> 2))) * P.vp + (wid >> 2) * 32 + (lane & 3) * 8, (unsigned)__builtin_amdgcn_readfirstlane(lds0 + L_V + (slot) * VSLOT + wid * 1024)); } while (0)
    const bool resident = !MLA && !BIAS && (g.mode != 0);
#define AT_SLOT(t) (resident ? (t) : ((t) & 3))
    if (resident) { for (int t = 0; t < NT; ++t) AT_ISSUE(t, t); } else { AT_ISSUE(0, 0); AT_ISSUE(1, 1); }
    bf16x8 qr[ND0];
    { const size_t qrow = (size_t)(qrow0 + str * r32);
#pragma unroll
      for (int d0 = 0; d0 < 4; ++d0) qr[d0] = *(const GAS bf16x8*)(P.q0 + qrow * P.qp + d0 * 16 + hi * 8);
      if (MLA) {
#pragma unroll
          for (int d0 = 4; d0 < ND0; ++d0) qr[d0] = *(const GAS bf16x8*)(P.q1 + qrow * P.qp + (d0 - 4) * 16 + hi * 8); } }
    if (P.dl) { const f32x4 dv = *((const GAS f32x4*)P.dl + (wid * 64 + lane)); *(LAS f32x4*)(lds + L_DL + (wid * 64 + lane) * 16) = dv; }
    float m = 0.f, l = 0.f; f32x16 o[2]; o[0] = f32x16{}; o[1] = f32x16{}; f32x16 negm = f32x16{};
    const int vb0 = (int)(lds0 + L_V) + ((lane >> 4) & 1) * 32 + (lane & 3) * 8 + (4 * hi + ((lane & 15) >> 2)) * 64;
#define AT_QK(t, P0, P1, USE, MREF) do { MREF = m; const int kpos0_ = g_kpos0(g, (t)); const int dmin_ = qpos0 - (kpos0_ + 63), dmax_ = qpos0 + 31 - kpos0_; \
        USE = !(dmax_ < 0 || dmin_ > W); \
        if (USE) { \
            const LAS unsigned char* kb_ = lds + L_K + AT_SLOT(t) * KSLOT + hi * 1024 + r32 * 16; bf16x8 kf_[4], kh_[4]; \
            _Pragma("unroll") for (int d0 = 0; d0 < 2; ++d0) { kf_[2 * d0] = *(const LAS bf16x8*)(kb_ + d0 * 2048); kf_[2 * d0 + 1] = *(const LAS bf16x8*)(kb_ + d0 * 2048 + 512); } \
            if (BIAS) { _Pragma("unroll") for (int g4 = 0; g4 < 4; ++g4) { const f32x4 a_ = *(const LAS f32x4*)(dls + kpos0_ + 8 * g4 + 4 * hi), c_ = *(const LAS f32x4*)(dls + kpos0_ + 32 + 8 * g4 + 4 * hi); \
                P0[4 * g4] = a_.x; P0[4 * g4 + 1] = a_.y; P0[4 * g4 + 2] = a_.z; P0[4 * g4 + 3] = a_.w; P1[4 * g4] = c_.x; P1[4 * g4 + 1] = c_.y; P1[4 * g4 + 2] = c_.z; P1[4 * g4 + 3] = c_.w; } } \
            __builtin_amdgcn_sched_barrier(0); \
            _Pragma("unroll") for (int d0 = 2; d0 < 4; ++d0) { kh_[2 * (d0 - 2)] = *(const LAS bf16x8*)(kb_ + d0 * 2048); kh_[2 * (d0 - 2) + 1] = *(const LAS bf16x8*)(kb_ + d0 * 2048 + 512); } \
            if (BIAS) { P0 = __builtin_amdgcn_mfma_f32_32x32x16_bf16(kf_[0], qr[0], P0, 0, 0, 0); P1 = __builtin_amdgcn_mfma_f32_32x32x16_bf16(kf_[1], qr[0], P1, 0, 0, 0); } \
            else if (NEGM) { P0 = __builtin_amdgcn_mfma_f32_32x32x16_bf16(kf_[0], qr[0], negm, 0, 0, 0); P1 = __builtin_amdgcn_mfma_f32_32x32x16_bf16(kf_[1], qr[0], negm, 0, 0, 0); } \
            else { P0 = __builtin_amdgcn_mfma_f32_32x32x16_bf16(kf_[0], qr[0], f32x16{}, 0, 0, 0); P1 = __builtin_amdgcn_mfma_f32_32x32x16_bf16(kf_[1], qr[0], f32x16{}, 0, 0, 0); } \
            P0 = __builtin_amdgcn_mfma_f32_32x32x16_bf16(kf_[2], qr[1], P0, 0, 0, 0); P1 = __builtin_amdgcn_mfma_f32_32x32x16_bf16(kf_[3], qr[1], P1, 0, 0, 0); \
            __builtin_amdgcn_sched_barrier(0); \
            P0 = __builtin_amdgcn_mfma_f32_32x32x16_bf16(kh_[0], qr[2], P0, 0, 0, 0); P1 = __builtin_amdgcn_mfma_f32_32x32x16_bf16(kh_[1], qr[2], P1, 0, 0, 0); \
            P0 = __builtin_amdgcn_mfma_f32_32x32x16_bf16(kh_[2], qr[3], P0, 0, 0, 0); P1 = __builtin_amdgcn_mfma_f32_32x32x16_bf16(kh_[3], qr[3], P1, 0, 0, 0); \
            if (MLA) { bf16x8 kg_[4];     \
                _Pragma("unroll") for (int d0 = 4; d0 < ND0; ++d0) { kg_[2 * (d0 - 4)] = *(const LAS bf16x8*)(kb_ + d0 * 2048); kg_[2 * (d0 - 4) + 1] = *(const LAS bf16x8*)(kb_ + d0 * 2048 + 512); } \
                _Pragma("unroll") for (int d0 = 4; d0 < ND0; ++d0) { \
                    P0 = __builtin_amdgcn_mfma_f32_32x32x16_bf16(kg_[2 * (d0 - 4)], qr[d0], P0, 0, 0, 0); P1 = __builtin_amdgcn_mfma_f32_32x32x16_bf16(kg_[2 * (d0 - 4) + 1], qr[d0], P1, 0, 0, 0); } } \
        } } while (0)
#define AT_MAX3(a, b, c) __builtin_fmaxf(__builtin_fmaxf((a), (b)), (c))
#define AT_STEP(t, PC0, PC1, UC, MC, PN0, PN1, UN, MN) do { \
        UN = false; \
        if ((t) + 1 < NT) AT_QK((t) + 1, PN0, PN1, UN, MN); \
        __builtin_amdgcn_sched_barrier(0); \
        if (UC) { \
            const int kpos0_ = g_kpos0(g, (t)); const int dmin_ = qpos0 - (kpos0_ + 63), dmax_ = qpos0 + 31 - kpos0_; \
            if (dmin_ < 0 || dmax_ > W) { const int dq_ = qpos0 + r32 - kpos0_ - 4 * hi; \
                _Pragma("unroll") for (int r = 0; r < 16; ++r) { const int d_ = dq_ - ((r & 3) + 8 * (r >> 2)); if (d_ < 0 || d_ > W) PC0[r] = -INFINITY; if (d_ - 32 < 0 || d_ - 32 > W) PC1[r] = -INFINITY; } } \
            float ra_ = AT_MAX3(PC0[0], PC0[1], PC1[0]), rb_ = AT_MAX3(PC0[2], PC0[3], PC1[1]); ra_ = AT_MAX3(ra_, PC1[2], PC1[3]); \
            _Pragma("unroll") for (int r = 4; r < 16; r += 4) { ra_ = AT_MAX3(ra_, PC0[r], PC0[r + 1]); rb_ = AT_MAX3(rb_, PC0[r + 2], PC0[r + 3]); ra_ = AT_MAX3(ra_, PC1[r], PC1[r + 1]); rb_ = AT_MAX3(rb_, PC1[r + 2], PC1[r + 3]); } \
            float rm_ = __builtin_fmaxf(ra_, rb_); \
            { auto rr_ = __builtin_amdgcn_permlane32_swap(__float_as_uint(rm_), __float_as_uint(rm_), false, false); rm_ = __builtin_fmaxf(__uint_as_float(rr_[0]), __uint_as_float(rr_[1])); } \
              \
            if (!NEGM) rm_ -= m; else rm_ -= (m - MC); \
            VFrag vf_; vload<0>(vf_, vb0 + AT_SLOT(t) * VSLOT);      \
            if (__builtin_expect(__any(rm_ > 8.0f), 0)) { const float dl_ = __builtin_fmaxf(rm_, 0.f); m += dl_; const float alpha_ = __builtin_amdgcn_exp2f(-dl_); l *= alpha_; \
                int lz_ = lane; asm volatile("" : "+v"(lz_));     \
                LAS float* wz_ = (LAS float*)(lds + L_WS) + wid * 64; if ((lz_ >> 5) == 0) wz_[lz_ & 31] = alpha_; \
                _Pragma("unroll") for (int r = 0; r < 16; ++r) { const float f_ = wz_[crow(r, lz_ >> 5)]; o[0][r] *= f_; o[1][r] *= f_; } \
                if (NEGM) { _Pragma("unroll") for (int r = 0; r < 16; ++r) negm[r] = -m; } } \
            const float sub_ = !NEGM ? m : (m - MC); float sacc_ = 0.f; \
            if (!NEGM || __any(sub_ != 0.f)) { _Pragma("unroll") for (int r = 0; r < 16; ++r) { PC0[r] = __builtin_amdgcn_exp2f(PC0[r] - sub_); PC1[r] = __builtin_amdgcn_exp2f(PC1[r] - sub_); sacc_ += PC0[r] + PC1[r]; } } \
            else { _Pragma("unroll") for (int r = 0; r < 16; ++r) { PC0[r] = __builtin_amdgcn_exp2f(PC0[r]); PC1[r] = __builtin_amdgcn_exp2f(PC1[r]); sacc_ += PC0[r] + PC1[r]; } } \
            l += sacc_; \
            const u32x4 w0_ = (u32x4){cvtpk(PC0[0], PC0[1]), cvtpk(PC0[2], PC0[3]), cvtpk(PC0[4], PC0[5]), cvtpk(PC0[6], PC0[7])}; \
            const u32x4 w1_ = (u32x4){cvtpk(PC0[8], PC0[9]), cvtpk(PC0[10], PC0[11]), cvtpk(PC0[12], PC0[13]), cvtpk(PC0[14], PC0[15])}; \
            const u32x4 w2_ = (u32x4){cvtpk(PC1[0], PC1[1]), cvtpk(PC1[2], PC1[3]), cvtpk(PC1[4], PC1[5]), cvtpk(PC1[6], PC1[7])}; \
            const u32x4 w3_ = (u32x4){cvtpk(PC1[8], PC1[9]), cvtpk(PC1[10], PC1[11]), cvtpk(PC1[12], PC1[13]), cvtpk(PC1[14], PC1[15])}; \
            vwait(vf_); o[0] = pvmma(o[0], vf_, __builtin_bit_cast(bf16x8, w0_), __builtin_bit_cast(bf16x8, w1_), __builtin_bit_cast(bf16x8, w2_), __builtin_bit_cast(bf16x8, w3_)); \
            __builtin_amdgcn_sched_barrier(0); vload<1>(vf_, vb0 + AT_SLOT(t) * VSLOT); \
            vwait(vf_); o[1] = pvmma(o[1], vf_, __builtin_bit_cast(bf16x8, w0_), __builtin_bit_cast(bf16x8, w1_), __builtin_bit_cast(bf16x8, w2_), __builtin_bit_cast(bf16x8, w3_)); \
        } \
        if (!resident) { asm volatile("s_waitcnt vmcnt(0) lgkmcnt(0)\n\ts_barrier" ::: "memory"); \
            if ((t) + 3 < NT) AT_ISSUE((t) + 3, ((t) + 3) & 3); } } while (0)
    f32x16 pa0, pa1, pb0, pb1; bool ua = false, ub = false; float mra = 0.f, mrb = 0.f;
    asm volatile("s_waitcnt vmcnt(0) lgkmcnt(0)\n\ts_barrier" ::: "memory");
    if (!resident) AT_ISSUE(2, 2);
    AT_QK(0, pa0, pa1, ua, mra);
    for (int t = 0; t < NT; t += 2) {
        AT_STEP(t, pa0, pa1, ua, mra, pb0, pb1, ub, mrb);
        AT_STEP(t + 1, pb0, pb1, ub, mrb, pa0, pa1, ua, mra);
    }
#undef AT_QK
#undef AT_STEP
#undef AT_MAX3
#undef AT_ISSUE
#undef AT_SLOT
    { auto rr = __builtin_amdgcn_permlane32_swap(__float_as_uint(l), __float_as_uint(l), false, false); l = __uint_as_float(rr[0]) + __uint_as_float(rr[1]); }
    if (hi == 0) wsf[32 + r32] = l;
    if (P.lse && hi == 0) ((GAS float*)P.lse)[(size_t)(qrow0 + str * r32) * 8] = m + log2f(l);
#pragma unroll
    for (int r = 0; r < 16; ++r) { const float rl = __builtin_amdgcn_rcpf(wsf[32 + crow(r, hi)]); GAS bf16* orow = (GAS bf16*)(P.o + (size_t)(qrow0 + str * crow(r, hi)) * P.op + r32);
        orow[0] = (bf16)(cvtpk(o[0][r] * rl, 0.f) & 0xffffu); orow[32] = (bf16)(cvtpk(o[1][r] * rl, 0.f) & 0xffffu); }
    asm volatile("s_waitcnt lgkmcnt(0)\n\ts_barrier" ::: "memory");
}
}

namespace fx {
using at::f32x16; using at::s16x4; using at::crow; using at::glds16; using at::cvtpk;
typedef short v4i16_t __attribute__((ext_vector_type(4)));
constexpr int NSLOT = 3, SLOTB = 8192, LDS_K = 0, LDS_V = NSLOT * SLOTB, LDS_WS = 2 * NSLOT * SLOTB, LDS_OST = LDS_WS + 8 * 256, LDS_DL = LDS_OST + 8 * 4096, LDS_END = LDS_DL + 8192;
typedef const LAS unsigned char* lptr;
__device__ __forceinline__ void cmask(f32x16& p0, f32x16& p1, int jb, int qrel, int hi) {
    const float NEG = -INFINITY; const int kb = 64 * jb + 4 * hi;
#pragma unroll
    for (int r = 0; r < 16; ++r) { const int kv = kb + (r & 3) + 8 * (r >> 2); if (kv > qrel) p0[r] = NEG; if (kv + 32 > qrel) p1[r] = NEG; }
}
__device__ __forceinline__ void kload8(bf16x8* kf, lptr kp) {
    kf[0] = *(const LAS bf16x8*)(kp);        kf[1] = *(const LAS bf16x8*)(kp + 512);  kf[2] = *(const LAS bf16x8*)(kp + 2048); kf[3] = *(const LAS bf16x8*)(kp + 2560);
    kf[4] = *(const LAS bf16x8*)(kp + 4096); kf[5] = *(const LAS bf16x8*)(kp + 4608); kf[6] = *(const LAS bf16x8*)(kp + 6144); kf[7] = *(const LAS bf16x8*)(kp + 6656);
}
__device__ __forceinline__ void kload2(bf16x8* kf, lptr kp, int j) { kf[2 * j] = *(const LAS bf16x8*)(kp + j * 2048); kf[2 * j + 1] = *(const LAS bf16x8*)(kp + j * 2048 + 512); }
__device__ __forceinline__ s16x4 vtr(lptr p) { return __builtin_bit_cast(s16x4, __builtin_amdgcn_ds_read_tr16_b64_v4i16((LAS v4i16_t*)p)); }
__device__ __forceinline__ bf16x8 mk_qx(float m, int hi) {
    const unsigned h = cvtpk(m, 0.f) & 0xffffu; const unsigned l = cvtpk(m - __uint_as_float(h << 16), 0.f) & 0xffffu;
    u32x4 w = (u32x4){0x3F803F80u, (h ^ 0x8000u) | ((l ^ 0x8000u) << 16), 0u, 0u}; if (hi) w = (u32x4){0u, 0u, 0u, 0u};
    return __builtin_bit_cast(bf16x8, w);
}
__device__ __forceinline__ void mk_kx(bf16x8& k0, bf16x8& k1, float d0, float d1, int hi) {
    const unsigned u = cvtpk(d0, d1); const unsigned v = cvtpk(d0 - __uint_as_float(u << 16), d1 - __uint_as_float(u & 0xffff0000u));
    u32x4 a = (u32x4){(u & 0xffffu) | (v << 16), 0x3F803F80u, 0u, 0u}, b = (u32x4){(u >> 16) | (v & 0xffff0000u), 0x3F803F80u, 0u, 0u};
    if (hi) { a = (u32x4){0u, 0u, 0u, 0u}; b = a; }
    k0 = __builtin_bit_cast(bf16x8, a); k1 = __builtin_bit_cast(bf16x8, b);
}
#define FX_MX3(a, b, c) __builtin_fmaxf(__builtin_fmaxf((a), (b)), (c))
#define FX_SBAR() __builtin_amdgcn_sched_barrier(0)
#define FX_WAIT_BAR(N) asm volatile("s_waitcnt vmcnt(" #N ") lgkmcnt(0)\n\ts_barrier" ::: "memory")
#define FX_MFMA(a, b, c) __builtin_amdgcn_mfma_f32_32x32x16_bf16(a, b, c, 0, 0, 0)
template <int THRL, int KP, int OP> __device__ __forceinline__ void fox_unit(LAS unsigned char* shm, const bf16* Qh, const bf16* Kh, const bf16* Vh, const float* dl, bf16* Oh, int qb, int lane_, int wid_) {
    int lane = lane_, wid = wid_; asm volatile("" : "+v"(lane), "+s"(wid));
    const int r32 = lane & 31, hi = lane >> 5; const int q0 = qb * 256;
    const bf16* Qw = Qh + (size_t)(q0 + wid * 32) * KP;
    const unsigned lds0 = (unsigned)(size_t)shm;
    LAS float* wsf = (LAS float*)(shm + LDS_WS) + wid * 64;
    int j0;
    { const float dq = ((const GAS float*)dl)[q0], de = ((const GAS float*)dl)[64 * (lane & 31) + 63];
      const unsigned far = (unsigned)__ballot(dq - de > 56.0f);
      j0 = far == 0xffffffffu ? 32 : __builtin_ctz(~far); j0 &= ~1; const int jmax = (q0 + 256) / 64 - 4; j0 = j0 < jmax ? j0 : jmax; j0 = __builtin_amdgcn_readfirstlane(j0); }
    const bf16* ksrc = Kh + (size_t)(64 * j0 + lane) * KP + wid * 8;
    const bf16* vsrc = Vh + (size_t)(64 * j0 + 16 * (wid & 3) + (lane >> 2)) * KP + (wid >> 2) * 32 + (lane & 3) * 8;
    const unsigned kdst = lds0 + LDS_K + wid * 1024, vdst = lds0 + LDS_V + wid * 1024;
#define FX_DMA_K(t, slot) glds16(ksrc + (size_t)(t) * 64 * KP, (unsigned)__builtin_amdgcn_readfirstlane(kdst + (slot)))
#define FX_DMA_V(t, slot) glds16(vsrc + (size_t)(t) * 64 * KP, (unsigned)__builtin_amdgcn_readfirstlane(vdst + (slot)))
    const int vb0 = (int)(lds0 + LDS_V) + ((lane >> 4) & 1) * 32 + (lane & 3) * 8 + (4 * hi + ((lane & 15) >> 2)) * 64;
    bf16x8 kf[8];
    const lptr kp0 = shm + LDS_K + hi * 1024 + r32 * 16; const lptr vp0 = shm + LDS_V + ((lane >> 4) & 1) * 32 + (lane & 3) * 8 + (4 * hi + ((lane & 15) >> 2)) * 64;
    const LAS float* dlt = (const LAS float*)(shm + LDS_DL) + 64 * j0 + r32;
    const int NT = (q0 + 256) / 64 - j0;
    FX_DMA_K(0, 0); FX_DMA_V(0, 0); FX_DMA_K(1, SLOTB);
    { const f32x4 dv = *((const GAS f32x4*)dl + (wid * 64 + lane)); *(LAS f32x4*)(shm + LDS_DL + (wid * 64 + lane) * 16) = dv; }
    bf16x8 qr[4];
#pragma unroll
    for (int d0 = 0; d0 < 4; ++d0) qr[d0] = *(const GAS bf16x8*)(Qw + (size_t)r32 * KP + d0 * 16 + hi * 8);
    float mhat = 0.f, l_reg = 0.f; f32x16 o[2]; o[0] = f32x16{}; o[1] = f32x16{};
    bf16x8 qx = mk_qx(0.f, hi);
    const int qrel = wid * 32 + r32;
#define FX_CMASK(P0, P1, t) do { const int jb_ = (t) - (NT - 4); if (jb_ >= 0) cmask(P0, P1, jb_, qrel, hi); } while (0)
    bool resc = false;
#define FX_RESC() do { if (resc) { asm volatile("s_waitcnt lgkmcnt(0)" ::: "memory"); \
        _Pragma("unroll") for (int d_ = 0; d_ < 2; ++d_) _Pragma("unroll") for (int r = 0; r < 16; ++r) o[d_][r] *= wsf[crow(r, hi)]; } } while (0)
    f32x16 pA0, pA1, pB0, pB1;
    int sl_prev = 0, sl_cur = 0, sl_next = SLOTB;
#define FX_ROT() do { sl_prev = sl_cur; sl_cur = sl_next; sl_next = (sl_next == (NSLOT - 1) * SLOTB) ? 0 : sl_next + SLOTB; } while (0)
    FX_DMA_K(2, 2 * SLOTB);
    FX_WAIT_BAR(3);
    { kload8(kf, kp0); bf16x8 kx0, kx1; mk_kx(kx0, kx1, dlt[0], dlt[32], hi);
      pA0 = FX_MFMA(kf[0], qr[0], f32x16{}); pA1 = FX_MFMA(kf[1], qr[0], f32x16{});
#pragma unroll
      for (int d0 = 1; d0 < 4; ++d0) { pA0 = FX_MFMA(kf[2 * d0], qr[d0], pA0); pA1 = FX_MFMA(kf[2 * d0 + 1], qr[d0], pA1); }
      pA0 = FX_MFMA(kx0, qx, pA0); pA1 = FX_MFMA(kx1, qx, pA1); }
    FX_CMASK(pA0, pA1, 0);
    { float a = FX_MX3(pA0[0], pA0[1], pA1[0]), b = FX_MX3(pA0[2], pA0[3], pA1[1]); a = FX_MX3(a, pA1[2], pA1[3]);
#pragma unroll
      for (int r = 4; r < 16; r += 4) { a = FX_MX3(a, pA0[r], pA0[r + 1]); b = FX_MX3(b, pA0[r + 2], pA0[r + 3]); a = FX_MX3(a, pA1[r], pA1[r + 1]); b = FX_MX3(b, pA1[r + 2], pA1[r + 3]); }
      float rm = __builtin_fmaxf(a, b); { auto rr = __builtin_amdgcn_permlane32_swap(__float_as_uint(rm), __float_as_uint(rm), false, false); rm = __builtin_fmaxf(__uint_as_float(rr[0]), __uint_as_float(rr[1])); }
      mhat = rm; qx = mk_qx(mhat, hi);
#pragma unroll
      for (int r = 0; r < 16; ++r) { pA0[r] = __builtin_amdgcn_exp2f(pA0[r] - rm); pA1[r] = __builtin_amdgcn_exp2f(pA1[r] - rm); } }
    FX_WAIT_BAR(0);
    FX_DMA_K(3, 0); FX_DMA_V(1, SLOTB);
    FX_ROT();
    kload8(kf, kp0 + sl_cur);
    FX_WAIT_BAR(2);
    s16x4 vlo[8], vhi[8]; u32x4 pw0, pw1, pw2, pw3;
#define FX_PKW(P, B) cvtpk(P[B], P[B + 1])
#define FX_PAF(k) __builtin_bit_cast(bf16x8, pw##k)
#define FX_VFR(i) (bf16x8){vlo[i][0], vlo[i][1], vlo[i][2], vlo[i][3], vhi[i][0], vhi[i][1], vhi[i][2], vhi[i][3]}
#define FX_PIN(x) asm volatile("" : "+v"(x))
#define FX_GAPA(MF, A0, A1, A2, A3, W0, W1, PW) do { MF; sacc += A0; sacc += A1; sacc += A2; sacc += A3; FX_PIN(sacc); W0; W1; FX_PIN(PW); FX_SBAR(); } while (0)
#define FX_EX(v) __builtin_amdgcn_exp2f(v)
#define FX_GAPB(MF, X, B) do { MF; X[B] = FX_EX(X[B]); X[B + 1] = FX_EX(X[B + 1]); X[B + 2] = FX_EX(X[B + 2]); X[B + 3] = FX_EX(X[B + 3]); FX_PIN(X); FX_SBAR(); } while (0)
#define FX_VRD(i) do { vlo[i] = vtr(vp_ + (((i) >> 2) * 4096 + ((i) & 3) * 1024)); vhi[i] = vtr(vp_ + (((i) >> 2) * 4096 + ((i) & 3) * 1024 + 512)); } while (0)
#define FX_KRD(G, j) do { if (G) { kload2(kf, kp0 + sl_next, j); FX_SBAR(); } } while (0)
#define FX_STEP(C0, C1, P0, P1, t, GK, GV, GL) do { FX_SBAR(); \
        const lptr vp_ = vp0 + sl_prev; const float d0_ = dlt[64 * (t)], d1_ = dlt[64 * (t) + 32]; \
        FX_VRD(0); FX_SBAR(); float sacc = (P0[0] + P0[1]); \
        FX_GAPA(C0 = FX_MFMA(kf[0], qr[0], f32x16{}), P0[2], P0[3], P0[4], P0[5],     pw0[0] = FX_PKW(P0, 0), pw0[1] = FX_PKW(P0, 2), pw0); \
        FX_VRD(4); FX_SBAR(); FX_GAPA(C1 = FX_MFMA(kf[1], qr[0], f32x16{}), P0[6], P0[7], P0[8], P0[9],     pw0[2] = FX_PKW(P0, 4), pw0[3] = FX_PKW(P0, 6), pw0); \
        FX_VRD(1); FX_SBAR(); FX_GAPA(C0 = FX_MFMA(kf[2], qr[1], C0),   P0[10], P0[11], P0[12], P0[13], pw1[0] = FX_PKW(P0, 8), pw1[1] = FX_PKW(P0, 10), pw1); \
        FX_VRD(5); FX_SBAR(); FX_GAPA(C1 = FX_MFMA(kf[3], qr[1], C1),   P0[14], P0[15], P1[0], P1[1],   pw1[2] = FX_PKW(P0, 12), pw1[3] = FX_PKW(P0, 14), pw1); \
        FX_VRD(2); FX_SBAR(); FX_GAPA(C0 = FX_MFMA(kf[4], qr[2], C0),   P1[2], P1[3], P1[4], P1[5],     pw2[0] = FX_PKW(P1, 0), pw2[1] = FX_PKW(P1, 2), pw2); \
        FX_VRD(6); FX_SBAR(); FX_GAPA(C1 = FX_MFMA(kf[5], qr[2], C1),   P1[6], P1[7], P1[8], P1[9],     pw2[2] = FX_PKW(P1, 4), pw2[3] = FX_PKW(P1, 6), pw2); \
        FX_VRD(3); FX_SBAR(); FX_GAPA(C0 = FX_MFMA(kf[6], qr[3], C0),   P1[10], P1[11], P1[12], P1[13], pw3[0] = FX_PKW(P1, 8), pw3[1] = FX_PKW(P1, 10), pw3); \
        FX_VRD(7); FX_SBAR(); FX_GAPA(C1 = FX_MFMA(kf[7], qr[3], C1),   P1[14], P1[15], 0.f, 0.f,       pw3[2] = FX_PKW(P1, 12), pw3[3] = FX_PKW(P1, 14), pw3); \
        l_reg += sacc; \
        { bf16x8 kx0_, kx1_; mk_kx(kx0_, kx1_, d0_, d1_, hi); FX_PIN(kx0_); FX_PIN(kx1_); FX_SBAR(); C0 = FX_MFMA(kx0_, qx, C0); C1 = FX_MFMA(kx1_, qx, C1); FX_SBAR(); }     \
        if (GK) { FX_DMA_K((t) + 3, sl_cur); } if (GV) { FX_DMA_V((t) + 1, sl_next); } \
        FX_CMASK(C0, C1, t); \
        { float a = FX_MX3(C0[0], C0[1], C1[0]), b = FX_MX3(C0[2], C0[3], C1[1]); a = FX_MX3(a, C1[2], C1[3]); \
          _Pragma("unroll") for (int r = 4; r < 16; r += 4) { a = FX_MX3(a, C0[r], C0[r + 1]); b = FX_MX3(b, C0[r + 2], C0[r + 3]); a = FX_MX3(a, C1[r], C1[r + 1]); b = FX_MX3(b, C1[r + 2], C1[r + 3]); } \
          float rm = __builtin_fmaxf(a, b); { auto rr = __builtin_amdgcn_permlane32_swap(__float_as_uint(rm), __float_as_uint(rm), false, false); rm = __builtin_fmaxf(__uint_as_float(rr[0]), __uint_as_float(rr[1])); } \
          resc = false; \
          if (__builtin_expect(__any(rm > (float)THRL), 0)) { const float dl_ = __builtin_fmaxf(rm, 0.f); mhat += dl_; \
              _Pragma("unroll") for (int r = 0; r < 16; ++r) { C0[r] -= dl_; C1[r] -= dl_; } \
              qx = mk_qx(mhat, hi); \
              const float f = __builtin_amdgcn_exp2f(-dl_); l_reg *= f; if (hi == 0) wsf[r32] = f; resc = true; } } \
        FX_SBAR(); \
        FX_GAPB(o[0] = FX_MFMA(FX_PAF(0), FX_VFR(0), o[0]), C0, 0); \
        FX_GAPB(o[1] = FX_MFMA(FX_PAF(0), FX_VFR(4), o[1]), C0, 4); \
        FX_KRD(GL, 0); FX_GAPB(o[0] = FX_MFMA(FX_PAF(1), FX_VFR(1), o[0]), C0, 8); \
        FX_KRD(GL, 1); FX_GAPB(o[1] = FX_MFMA(FX_PAF(1), FX_VFR(5), o[1]), C0, 12); \
        FX_KRD(GL, 2); FX_GAPB(o[0] = FX_MFMA(FX_PAF(2), FX_VFR(2), o[0]), C1, 0); \
        FX_KRD(GL, 3); FX_GAPB(o[1] = FX_MFMA(FX_PAF(2), FX_VFR(6), o[1]), C1, 4); \
        FX_GAPB(o[0] = FX_MFMA(FX_PAF(3), FX_VFR(3), o[0]), C1, 8); \
        FX_GAPB(o[1] = FX_MFMA(FX_PAF(3), FX_VFR(7), o[1]), C1, 12); \
    } while (0)
    int t = 1;
#undef FX_CMASK
#define FX_CMASK(P0, P1, t) do {} while (0)
    for (; t + 5 < NT; t += 2) {
        FX_STEP(pB0, pB1, pA0, pA1, t, true, true, true);     FX_WAIT_BAR(2); FX_RESC(); FX_ROT();
        FX_STEP(pA0, pA1, pB0, pB1, t + 1, true, true, true); FX_WAIT_BAR(2); FX_RESC(); FX_ROT();
    }
#undef FX_CMASK
#define FX_CMASK(P0, P1, t) do { const int jb_ = (t) - (NT - 4); if (jb_ >= 0) cmask(P0, P1, jb_, qrel, hi); } while (0)
#define FX_ENDW(tt) do { if ((tt) + 3 < NT) { FX_WAIT_BAR(2); } else if ((tt) + 2 < NT) { FX_WAIT_BAR(1); } else { FX_WAIT_BAR(0); } } while (0)
    for (; t + 1 < NT; t += 2) {
        FX_STEP(pB0, pB1, pA0, pA1, t, (t + 3 < NT), (t + 1 < NT), (t + 1 < NT));         FX_ENDW(t);     FX_RESC(); FX_ROT();
        FX_STEP(pA0, pA1, pB0, pB1, t + 1, (t + 4 < NT), (t + 2 < NT), (t + 2 < NT));     FX_ENDW(t + 1); FX_RESC(); FX_ROT();
    }
    FX_STEP(pB0, pB1, pA0, pA1, NT - 1, false, false, false); FX_RESC();
    { float sacc = pB0[0] + pB0[1];
#pragma unroll
      for (int r = 2; r < 16; ++r) sacc += pB0[r];
#pragma unroll
      for (int r = 0; r < 16; ++r) sacc += pB1[r];
      l_reg += sacc;
      pw0 = (u32x4){FX_PKW(pB0, 0), FX_PKW(pB0, 2), FX_PKW(pB0, 4), FX_PKW(pB0, 6)}; pw1 = (u32x4){FX_PKW(pB0, 8), FX_PKW(pB0, 10), FX_PKW(pB0, 12), FX_PKW(pB0, 14)};
      pw2 = (u32x4){FX_PKW(pB1, 0), FX_PKW(pB1, 2), FX_PKW(pB1, 4), FX_PKW(pB1, 6)}; pw3 = (u32x4){FX_PKW(pB1, 8), FX_PKW(pB1, 10), FX_PKW(pB1, 12), FX_PKW(pB1, 14)};
      FX_SBAR();
      at::VFrag vf_; at::vload<0>(vf_, vb0 + sl_cur); at::vwait(vf_); o[0] = at::pvmma(o[0], vf_, FX_PAF(0), FX_PAF(1), FX_PAF(2), FX_PAF(3));
      FX_SBAR(); at::vload<1>(vf_, vb0 + sl_cur); at::vwait(vf_); o[1] = at::pvmma(o[1], vf_, FX_PAF(0), FX_PAF(1), FX_PAF(2), FX_PAF(3)); }
    { auto rr = __builtin_amdgcn_permlane32_swap(__float_as_uint(l_reg), __float_as_uint(l_reg), false, false); l_reg = __uint_as_float(rr[0]) + __uint_as_float(rr[1]); }
    if (hi == 0) wsf[32 + r32] = l_reg; asm volatile("s_waitcnt lgkmcnt(0)" ::: "memory");
    { LAS bf16* stg = (LAS bf16*)(shm + LDS_OST) + wid * 2048;
#pragma unroll
      for (int r = 0; r < 16; ++r) { const float rl = __builtin_amdgcn_rcpf(wsf[32 + crow(r, hi)]); const int orow = crow(r, hi);
          stg[orow * 64 + r32] = (bf16)(cvtpk(o[0][r] * rl, 0.f) & 0xffffu); stg[orow * 64 + 32 + r32] = (bf16)(cvtpk(o[1][r] * rl, 0.f) & 0xffffu); }
      asm volatile("s_waitcnt lgkmcnt(0)" ::: "memory");
      bf16* Ow = Oh + (size_t)(q0 + wid * 32) * OP;
#pragma unroll
      for (int i = 0; i < 4; ++i) { const int row = i * 8 + (lane >> 3), ch = lane & 7; const u32x4 v = *(const LAS u32x4*)(stg + row * 64 + ch * 8); *(GAS u32x4*)(Ow + (size_t)row * OP + ch * 8) = v; } }
    asm volatile("s_waitcnt lgkmcnt(0)\n\ts_barrier" ::: "memory");
#undef FX_DMA_K
#undef FX_DMA_V
#undef FX_CMASK
#undef FX_RESC
#undef FX_ROT
#undef FX_PKW
#undef FX_PAF
#undef FX_VFR
#undef FX_PIN
#undef FX_GAPA
#undef FX_GAPB
#undef FX_EX
#undef FX_VRD
#undef FX_KRD
#undef FX_STEP
#undef FX_ENDW
}
#undef FX_SBAR
#undef FX_MX3
#undef FX_WAIT_BAR
#undef FX_MFMA
}

template <unsigned MASK> __global__ void __launch_bounds__(NTHR, 2) mk_fwd(Args args) {
    extern __shared__ __attribute__((aligned(16))) unsigned char lds_raw[];
    LAS unsigned char* lds = (LAS unsigned char*)lds_raw;
    volatile LAS unsigned* MISC = (volatile LAS unsigned*)(lds + MISC_OFF);
    const int tid0 = threadIdx.x; const int wave0 = __builtin_amdgcn_readfirstlane(tid0 >> 6);
    const int G = gridDim.x, bx0 = blockIdx.x;
    const int NGW = G * NWAVES, NGT = G * NTHR;
    unsigned char* ws0 = args.ws;
    unsigned* ctl = (unsigned*)(ws0 + WS_CTL);
    for (int u = tid0; u < (LDS_BYTES - MISC_OFF) / 4; u += NTHR) ((LAS unsigned*)(lds + MISC_OFF))[u] = 0u;
    __syncthreads();
    XcdBarrier bar; bar.bar = ctl + CW_BAR; bar.x = 0; bar.st = nullptr;
    if (args.fused) bar = xcd_barrier_post(ctl + CW_BAR, MISC + 8);
#define SEAM() do { if (args.fused) { XcdBarrier b_ = bar; asm volatile("" : "+s"(b_.bar)); xcd_barrier(b_, tid == 0); } } while (0)
    const int lo = args.ph_lo, hi = args.ph_hi;
#define IN(k) (((MASK >> (k)) & 1u) && lo <= (k) && (k) < hi)
#define REPEAT(k) for (int rep_ = 0; rep_ < 1 + (int)((DBL_MASK >> (k)) & 1u); ++rep_)

#define PHASE_BEGIN \
    unsigned char* ws = ws0; asm volatile("" : "+s"(ws)); int bx = bx0; asm volatile("" : "+s"(bx)); float* X = args.out; asm volatile("" : "+s"(X)); \
    ws = (unsigned char*)(GAS unsigned char*)ws; X = (float*)(GAS float*)X;     \
    int lane; asm volatile("v_mbcnt_lo_u32_b32 %0, -1, 0\n\tv_mbcnt_hi_u32_b32 %0, -1, %0" : "=v"(lane)); int wave = wave0; asm volatile("" : "+s"(wave)); const int tid = wave * 64 + lane; (void)tid; \
    const int gw = bx * NWAVES + wave, gtid = bx * NTHR + tid; (void)gw; (void)gtid; \
    bf16* HB = (bf16*)(ws + WS_HB); bf16* PROJ = (bf16*)(ws + WS_PROJ); float* MISCF = (float*)(ws + WS_MISCF); \
    bf16* QC = (bf16*)(ws + WS_QC); bf16* KVC = (bf16*)(ws + WS_KVC); bf16* KR = (bf16*)(ws + WS_KR); float* DL = (float*)(ws + WS_DL); \
    float* RSTD = (float*)(ws + WS_RSTD); bf16* OALL = (bf16*)(ws + WS_OALL); bf16* MERGED = (bf16*)(ws + WS_MERGED); \
    f32x2* CS64 = (f32x2*)(ws + WS_CS64); f32x2* CS32 = (f32x2*)(ws + WS_CS32); \
    bf16* HID = (bf16*)(ws + WS_HID); bf16* XG = (bf16*)(ws + WS_XG); bf16* PB = (bf16*)(ws + WS_PB); bf16* PP = (bf16*)(ws + WS_PP); \
    float* FZ = (float*)(ws + WS_FZ); float* SSC = (float*)(ws + WS_SSC); (void)FZ; (void)SSC; \
    float* SSP_E = (float*)(ws + WS_SSP); float* SSP_G = SSP_E + (size_t)M * 16; float* SSP_H = SSP_G + (size_t)M * 16; float* RSG = (float*)(ws + WS_RSG); bf16* XB = HB; bf16* XBN = (bf16*)(ws + WS_XBN); (void)SSP_E; (void)SSP_G; (void)SSP_H; (void)RSG; (void)XB; (void)XBN; \
    unsigned* ROUTE = (unsigned*)(ws + WS_ROUTE); const int* POS = (const int*)args.in[I_POS]; \
    (void)HB; (void)PROJ; (void)MISCF; (void)QC; (void)KVC; (void)KR; (void)DL; (void)RSTD; (void)OALL; (void)MERGED; (void)CS64; (void)CS32; (void)HID; (void)XG; (void)PB; (void)PP; (void)ROUTE; (void)POS; (void)X;
#define MOE_CUM_ASSIGN { int c_ = 0; _Pragma("unroll") for (int e = 0; e < 8; ++e) { MO.cum[e] = c_; c_ += (int)((__builtin_amdgcn_readfirstlane(__hip_atomic_load(cnt + e, __ATOMIC_RELAXED, __HIP_MEMORY_SCOPE_AGENT)) + 255u) >> 8); } MO.cum[8] = c_; MO.G = G; MO.c = bx; }
#define MOE_CUM \
    pg8::MoeOrder MO; { int c_ = 0; _Pragma("unroll") for (int e = 0; e < 8; ++e) { MO.cum[e] = c_; c_ += (int)((__builtin_amdgcn_readfirstlane(__hip_atomic_load(cnt + e, __ATOMIC_RELAXED, __HIP_MEMORY_SCOPE_AGENT)) + 255u) >> 8); } MO.cum[8] = c_; MO.G = G; MO.c = bx; }

    if (IN(0) && args.l_lo == 0) REPEAT(0) {
        PHASE_BEGIN
        LAS float* scr = (LAS float*)lds + wave * (64 * 33);
        int jid = 0;
#define CONV(src, lds_, K, col0, ncols, dst, ldd, row0, mode, sub, gain, scale) do { conv_items(scr, src, lds_, K, col0, ncols, dst, ldd, row0, mode, sub, gain, scale, (gw + jid * 397) % NGW, NGW, lane); ++jid; } while (0)
        for (int L = 0; L < DEPTH; ++L) {
            const float* win = args.in[I_WIN] + (size_t)L * D * IN_W; const float* gm = args.in[I_MIXN] + L * D;
            bf16* wt = (bf16*)(ws + WS_WIN) + (size_t)L * NPROJ * D;
            CONV(win, IN_W, D, S_FQ, 384, wt, D, C_FQ, 0, 0, gm, QS);
            CONV(win, IN_W, D, S_FK, 768, wt, D, C_FK, 0, 0, gm, 1.f);
            CONV(win, IN_W, D, S_DQ, 384, wt, D, C_DQ, 2, 0, gm, QS);
            CONV(win, IN_W, D, S_DK, 384, wt, D, C_DK, 2, 0, gm, 1.f);
            CONV(win, IN_W, D, S_DV, 384, wt, D, C_DV, 0, 0, gm, 1.f);
            CONV(win, IN_W, D, S_CQ, 512, wt, D, C_CQ, 0, 0, gm, 1.f);
            CONV(win, IN_W, D, S_G, 3072, wt, D, C_G, 4, 0, gm, 1.f);
            CONV(win, IN_W, D, S_KR, 32, wt, D, C_MISC, 3, 0, gm, 1.f);
            CONV(win, IN_W, D, S_FZ, 6, wt, D, C_MISC + 32, 0, 0, gm, 1.f);
            zero_rows(wt, D, C_MISC + 38, NPROJ - (C_MISC + 38), D, gtid, NGT);
            const float* wuq = args.in[I_WUQ] + (size_t)L * 256 * 384; const float* gq = args.in[I_QN] + L * 256;
            const float* wukv = args.in[I_WUKV] + (size_t)L * 256 * 512; const float* gkv = args.in[I_KVN] + L * 256;
            bf16* wup = (bf16*)(ws + WS_WUQ) + (size_t)L * 1024 * 256;
            for (int h = 0; h < 4; ++h) {
                CONV(wuq, 384, 256, h * 96, 64, wup, 256, h * 64, 0, 0, gq, MS);
                CONV(wuq, 384, 256, h * 96 + 64, 32, wup, 256, 256 + h * 32, 3, 0, gq, MS);
                CONV(wukv, 512, 256, h * 128, 64, wup, 256, 512 + h * 64, 0, 0, gkv, 1.f);
                CONV(wukv, 512, 256, h * 128 + 64, 64, wup, 256, 768 + h * 64, 0, 0, gkv, 1.f);
            }
            zero_rows(wup, 256, 384, 128, 256, gtid, NGT);
            bf16* wbr = (bf16*)(ws + WS_WBR) + (size_t)L * D * D;
            CONV(args.in[I_BRF] + (size_t)L * 384 * D, D, 384, 0, D, wbr, D, 0, 0, 0, nullptr, 1.f);
            CONV(args.in[I_BRD] + (size_t)L * 384 * D, D, 384, 0, D, wbr + 384, D, 0, 0, 0, nullptr, 1.f);
            CONV(args.in[I_BRM] + (size_t)L * 256 * D, D, 256, 0, D, wbr + 768, D, 0, 0, 0, nullptr, 1.f);
            CONV(args.in[I_WOUT] + (size_t)L * D * D, D, D, 0, D, (bf16*)(ws + WS_WOUT) + (size_t)L * D * D, D, 0, 0, 0, nullptr, 1.f);
            const float* gf = args.in[I_FFNN] + L * D; const int j = L >> 1;
            if ((L & 1) == 0) {
                bf16* wgu = (bf16*)(ws + WS_WGU) + (size_t)j * 2 * DFF * D;
                CONV(args.in[I_FG] + (size_t)j * D * DFF, DFF, D, 0, DFF, wgu, D, 0, 1, 0, gf, 1.f);
                CONV(args.in[I_FU] + (size_t)j * D * DFF, DFF, D, 0, DFF, wgu, D, 0, 1, 4, gf, 1.f);
                CONV(args.in[I_FD] + (size_t)j * DFF * D, D, DFF, 0, D, (bf16*)(ws + WS_WDN) + (size_t)j * D * DFF, DFF, 0, 4, 0, nullptr, 1.f);
            } else if (L == 1) {
                for (int e = 0; e < NEXP; ++e) {
                    bf16* wgu = (bf16*)(ws + WS_WEGU) + (size_t)e * 2 * DFE * D;
                    CONV(args.in[I_EG] + (size_t)(j * NEXP + e) * D * DFE, DFE, D, 0, DFE, wgu, D, 0, 1, 0, gf, 1.f);
                    CONV(args.in[I_EU] + (size_t)(j * NEXP + e) * D * DFE, DFE, D, 0, DFE, wgu, D, 0, 1, 4, gf, 1.f);
                    CONV(args.in[I_ED] + (size_t)(j * NEXP + e) * DFE * D, D, DFE, 0, D, (bf16*)(ws + WS_WEDN) + (size_t)e * D * DFE, DFE, 0, 0, 0, nullptr, 1.f);
                }
            }
            CONV(args.in[I_WPG] + (size_t)L * D * D, D, D, 0, D, (bf16*)(ws + WS_WPG) + (size_t)L * D * D, D, 0, 4, 0, args.in[I_PLEN] + L * D, 1.f);
            CONV(args.in[I_WPP] + (size_t)L * 256 * D, D, 256, 0, D, (bf16*)(ws + WS_WPP) + (size_t)L * D * D, D, 0, 0, 0, nullptr, 1.f);
        }
        for (int r = gw; r < M; r += NGW) { const f32x4* xs = (const f32x4*)(args.in[I_X] + (size_t)r * D) + lane; f32x4 v[4]; float s_ = 0.f;
#pragma unroll
            for (int j = 0; j < 4; ++j) { v[j] = xs[64 * j]; s_ += (v[j].x * v[j].x + v[j].y * v[j].y) + (v[j].z * v[j].z + v[j].w * v[j].w); }
            store_row_bf16(XBN + (size_t)r * D, v, 1.0f, lane); const float ss = wave_sum(s_);
            { unsigned* o4 = (unsigned*)((unsigned char*)MERGED + (size_t)r * D) + lane;
#pragma unroll
              for (int j = 0; j < 4; ++j) o4[64 * j] = pk4_fp8(v[j].x, v[j].y, v[j].z, v[j].w); }
            if (lane < 16) SSP_H[(size_t)r * 16 + lane] = (lane == 0) ? ss : 0.f; }
        { const f32x4* ps = (const f32x4*)args.in[I_P]; bf16* PBALL = (bf16*)(ws + WS_PBALL);
          for (int i = gtid; i < DEPTH * M * 64; i += NGT) { const int Lp = i / (M * 64), rem = i - Lp * (M * 64), row = rem >> 6, q = rem & 63; const f32x4 a = ps[i];
              u32x2 w; w.x = cvt_pk_bf16(a.x, a.y); w.y = cvt_pk_bf16(a.z, a.w); *(u32x2*)(PBALL + (size_t)row * D + Lp * 256 + 4 * q) = w; } }
        for (int i = gtid; i < M * 32; i += NGT) { const int row = i >> 5, j = i & 31; const float invf = powf(10000.0f, -(float)j / 32.0f); const float ang = (float)POS[row] * invf; float s, c; sincosf(ang, &s, &c); CS64[i] = (f32x2){c, s}; }
        for (int i = gtid; i < M * 16; i += NGT) { const int row = i >> 4, j = i & 15; const float invf = powf(10000.0f, -(float)j / 16.0f); const float ang = (float)POS[row] * invf; float s, c; sincosf(ang, &s, &c); CS32[i] = (f32x2){c, s}; }
        SEAM();
    }

    for (int L = args.l_lo; L < args.l_hi; ++L) {
        const int jl = L >> 1; const bool moe = (L & 1) != 0;
        unsigned* cnt = ctl + CW_CNT + 64 * jl;
        if (IN(2)) REPEAT(2) {
            PHASE_BEGIN
            { pg8::Gemm g{XBN, (const bf16*)(ws + WS_WIN) + (size_t)L * NPROJ * D, D, D}; pg8::SubsetOrder<false> S; S.init(M, 12 * 256, D, G, bx, D, D); S.first = 0; S.alt = 23;
              pg8::EpiProj3 E{PROJ, KR, FZ, SSC, SSP_H, CS64, CS32}; pg8::gemm_phase(lds, g, S, E, tid); }
            { pg8::Gemm g{MERGED, (const bf16*)(ws + WS_WIN) + (size_t)L * NPROJ * D + (size_t)C_G * D, D / 2, D / 2}; pg8::SubsetOrder<true> S; S.init(M, 12 * 256, D / 2, G, bx, D / 2, D / 2); S.first = 0; S.alt = -1;
              pg8::EpiGate EG{PROJ, SSP_H, 1.0f / 32.0f}; pg8::gemm_phase(lds, g, S, EG, tid); }
            SEAM();
        }
        if (IN(4)) REPEAT(4) {
            PHASE_BEGIN
            { pg8::Gemm g{PROJ + C_CQ, (const bf16*)(ws + WS_WUQ) + (size_t)L * 1024 * 256, NPROJ, 256}; pg8::UpOrder S{G, bx};
              pg8::EpiUp E{QC, KVC, SSC, CS32}; pg8::gemm_phase(lds, g, S, E, tid); }
            if (bx < 48) {
                LAS float* sc = (LAS float*)lds; const int b = bx / 6, h = bx % 6; const float bias = args.in[I_BF][L * 6 + h];
                float v[4], run = 0.f;
#pragma unroll
                for (int j = 0; j < 4; ++j) { const float z = FZ[(size_t)(b * T + tid * 4 + j) * 8 + h] + bias; const float ls = fminf(z, 0.f) - log1pf(expf(-fabsf(z))); run += ls; v[j] = run; }
                sc[tid] = run; __syncthreads();
                for (int o = 1; o < NTHR; o <<= 1) { float add = (tid >= o) ? sc[tid - o] : 0.f; __syncthreads(); sc[tid] += add; __syncthreads(); }
                const float base = (tid > 0) ? sc[tid - 1] : 0.f;
#pragma unroll
                for (int j = 0; j < 4; ++j) DL[(size_t)bx * T + tid * 4 + j] = -LOG2E * (base + v[j]);
                __syncthreads();
            }
            SEAM();
        }
        if (IN(6)) REPEAT(6) {
            PHASE_BEGIN
            bf16* DILO = HB;
            float* LSE = (float*)(ws + WS_HB + 24 * MiB);
            const bool perb = (G & 7) == 0; const int xq = bx & 7;
            unsigned* queue = ctl + CW_Q + 64 * L + (perb ? 8 * xq : 0);
            const int NU = perb ? 80 + 3 * 48 : 640 + 3 * 384;
            for (;;) {
                if (tid == 0) MISC[16] = __hip_atomic_fetch_add(queue, 1u, __ATOMIC_RELAXED, __HIP_MEMORY_SCOPE_AGENT);
                asm volatile("s_waitcnt vmcnt(0) lgkmcnt(0)\n\ts_barrier" ::: "memory");
                const int idx = (int)MISC[16];
                asm volatile("s_waitcnt lgkmcnt(0)\n\ts_barrier" ::: "memory");
                if (idx >= NU) break;
                int ln = lane, wv = wave; asm volatile("" : "+v"(ln), "+s"(wv));
                int kind, b, h, qb = 0, br = 0, sub = 0;
                if (perb) { b = xq;
                    if (idx < 80) { qb = 7 - idx / 10; const int jl = idx % 10; kind = (jl < 4) ? 0 : 1; h = (jl < 4) ? jl : jl - 4; }
                    else { const int d = idx - 80; br = d / 48; const int jj = d % 48; kind = 2; h = jj >> 3; sub = jj & 7; }
                } else {
                    if (idx < 640) { qb = 7 - idx / 80; const int j = idx % 80; kind = (j < 32) ? 0 : 1; b = (j < 32) ? (j >> 2) : (j - 32) / 6; h = (j < 32) ? (j & 3) : (j - 32) % 6; }
                    else { const int j = idx - 640; br = j / 384; const int jj = j % 384; kind = 2; b = (jj >> 3) / 6; h = (jj >> 3) % 6; sub = jj & 7; }
                }
                at::Geo g; at::Tens P; g.b = b;
                if (kind == 0) { g.mode = 0; g.r = 1; g.rho = 0; g.u = qb;
                    P.q0 = QC + h * 64; P.q1 = QC + 256 + h * 32; P.qp = 512; P.k0 = KVC + h * 64; P.kp = 512; P.k1 = KR; P.v = KVC + 256 + h * 64; P.vp = 512; P.dl = nullptr;
                    P.o = OALL + 768 + h * 64; P.op = D; P.lse = nullptr;
                    at::attn_unit<true, false>(lds, P, g, ln, wv);
                } else if (kind == 1) {
                    fx::fox_unit<8, NPROJ, D>(lds, PROJ + (size_t)b * T * NPROJ + C_FQ + h * 64, PROJ + (size_t)b * T * NPROJ + C_FK + h * 64, PROJ + (size_t)b * T * NPROJ + C_FV + h * 64,
                                              DL + (size_t)(b * 6 + h) * T, OALL + (size_t)b * T * D + h * 64, qb, ln, wv);
                } else {
                    if (br == 0) { g.mode = 1; g.r = 1; g.rho = 0; g.u = sub; }
                    else if (br == 1) { g.mode = 1; g.r = 4; g.u = sub & 1; g.rho = (sub >> 1) & 3; }
                    else { g.mode = 2; g.r = 16; g.u = 0; g.rho = sub; }
                    P.q0 = PROJ + C_DQ + h * 64; P.q1 = nullptr; P.qp = NPROJ; P.k0 = PROJ + C_DK + h * 64; P.kp = NPROJ; P.k1 = nullptr; P.v = PROJ + C_DV + h * 64; P.vp = NPROJ; P.dl = nullptr;
                    if (br == 0) { P.o = OALL + 384 + h * 64; P.op = D; } else { P.o = DILO + (size_t)(br - 1) * M * 384 + h * 64; P.op = 384; }
                    P.lse = LSE + (size_t)br * M * 8 + h;
                    at::attn_unit<false, false>(lds, P, g, ln, wv);
                }
            }
            SEAM();
        }
        if (IN(7)) REPEAT(7) {
            PHASE_BEGIN
            { const bf16* DILO = HB; const float* LSE = (const float*)(ws + WS_HB + 24 * MiB);
              for (int i = gtid; i < M * 48; i += NGT) { const int row = i / 48, c8 = i - row * 48, h = c8 >> 3;
                  const float l0 = LSE[(size_t)row * 8 + h], l1 = LSE[(size_t)(M + row) * 8 + h], l2 = LSE[(size_t)(2 * M + row) * 8 + h];
                  const float mx = fmaxf(l0, fmaxf(l1, l2)); float w0 = exp2f(l0 - mx), w1 = exp2f(l1 - mx), w2 = exp2f(l2 - mx); const float inv = 1.0f / (w0 + w1 + w2); w0 *= inv; w1 *= inv; w2 *= inv;
                  u32x4* op = (u32x4*)(OALL + (size_t)row * D + 384 + c8 * 8);
                  f32x4 a0, a1, b0, b1, c0, c1; pg8::unpack8(*op, a0, a1); pg8::unpack8(*(const u32x4*)(DILO + (size_t)row * 384 + c8 * 8), b0, b1); pg8::unpack8(*(const u32x4*)(DILO + (size_t)(M + row) * 384 + c8 * 8), c0, c1);
                  *op = pg8::pack8(a0 * w0 + b0 * w1 + c0 * w2, a1 * w0 + b1 * w1 + c1 * w2); }
              SEAM(); }
            { pg8::Gemm g{OALL, (const bf16*)(ws + WS_WBR) + (size_t)L * D * D, D, D}; pg8::MergeOrder S{G, bx};
              pg8::EpiMergeChain E{MERGED, PROJ + C_G}; pg8::gemm_phase(lds, g, S, E, tid); }
            SEAM();
        }
        if (IN(8)) REPEAT(8) {
            PHASE_BEGIN
            pg8::Gemm g{MERGED, (const bf16*)(ws + WS_WOUT) + (size_t)L * D * D, D, D}; pg8::StaticOrder S; S.init(M, D, D, G, bx, D, D);
            pg8::EpiResidX<false> E{XBN, XB, SSP_E, nullptr, 1.0f}; pg8::gemm_phase(lds, g, S, E, tid);
            SEAM();
        }
        if (IN(9) && moe) REPEAT(9) {
            PHASE_BEGIN
            const float* gf = args.in[I_FFNN] + L * D; const float* wr = args.in[I_WR] + (size_t)jl * D * NEXP;
            LAS unsigned* lcnt = (LAS unsigned*)lds;
            LAS unsigned* info = (LAS unsigned*)lds + 16;
            f32x4 wq[4][4][2];
#pragma unroll
            for (int j = 0; j < 4; ++j) { const f32x4 gv = *((const f32x4*)gf + lane + 64 * j);
#pragma unroll
                for (int q = 0; q < 4; ++q) { const int k = 4 * lane + 256 * j + q; wq[j][q][0] = *(const f32x4*)(wr + (size_t)k * 8) * gv[q]; wq[j][q][1] = *(const f32x4*)(wr + (size_t)k * 8 + 4) * gv[q]; } }
            for (int blk = bx; blk < M / 64; blk += G) {
                if (tid < 16) lcnt[tid] = 0u;
                __syncthreads();
                u32x2 raw[8][4];
#pragma unroll
                for (int i = 0; i < 8; ++i) { const u32x2* p = (const u32x2*)(XB + (size_t)(blk * 64 + wave * 8 + i) * D) + lane;
#pragma unroll
                    for (int j = 0; j < 4; ++j) raw[i][j] = p[64 * j]; }
#pragma unroll
                for (int i = 0; i < 8; ++i) { const int lr = wave * 8 + i;
                    f32x4 v[4];
#pragma unroll
                    for (int j = 0; j < 4; ++j) v[j] = (f32x4){bf2f(raw[i][j].x & 0xffffu), bf2f(raw[i][j].x >> 16), bf2f(raw[i][j].y & 0xffffu), bf2f(raw[i][j].y >> 16)};
                    const float rs = row_rstd(v);
                    f32x4 la = (f32x4){0.f, 0.f, 0.f, 0.f}, lb = la;
#pragma unroll
                    for (int j = 0; j < 4; ++j)
#pragma unroll
                        for (int q = 0; q < 4; ++q) { la += wq[j][q][0] * v[j][q]; lb += wq[j][q][1] * v[j][q]; }
                    float lg[8] = {la.x * rs, la.y * rs, la.z * rs, la.w * rs, lb.x * rs, lb.y * rs, lb.z * rs, lb.w * rs};
#pragma unroll
                    for (int e = 0; e < 8; ++e) lg[e] = wave_sum(lg[e]);
                    int e0 = 0; float l0 = lg[0];
#pragma unroll
                    for (int e = 1; e < 8; ++e) if (lg[e] > l0) { l0 = lg[e]; e0 = e; }
                    int e1 = -1; float l1 = -INFINITY;
#pragma unroll
                    for (int e = 0; e < 8; ++e) if (e != e0 && lg[e] > l1) { l1 = lg[e]; e1 = e; }
                    const float w1v = 1.0f / (1.0f + expf(l0 - l1)), w0v = 1.0f - w1v;
                    if (lane == 0) { const unsigned r0 = atomicAdd((unsigned*)(lcnt + e0), 1u), r1 = atomicAdd((unsigned*)(lcnt + e1), 1u);
                        LAS unsigned* io = info + lr * 8; io[0] = e0; io[1] = r0; io[2] = __float_as_uint(w0v); io[3] = e1; io[4] = r1; io[5] = __float_as_uint(w1v); io[6] = __float_as_uint(rs); }
                }
                __syncthreads();
                if (tid < 8) lcnt[8 + tid] = __hip_atomic_fetch_add(cnt + tid, lcnt[tid], __ATOMIC_RELAXED, __HIP_MEMORY_SCOPE_AGENT);
                __syncthreads();
                if (tid < 64) { const LAS unsigned* io = info + tid * 8; unsigned* ro = ROUTE + (size_t)(blk * 64 + tid) * 8;
                    const unsigned e0 = io[0], e1 = io[3]; const unsigned s0 = lcnt[8 + e0] + io[1], s1 = lcnt[8 + e1] + io[4]; ro[0] = e0; ro[1] = s0; ro[2] = io[2]; ro[3] = e1; ro[4] = s1; ro[5] = io[5];
                    int* TOKS = (int*)(ws + WS_TOKS); TOKS[(size_t)e0 * M + s0] = blk * 64 + tid; TOKS[(size_t)e1 * M + s1] = blk * 64 + tid;
                    float* RSL = (float*)(ws + WS_RSL); const float rsv = __uint_as_float(io[6]); RSL[(size_t)e0 * M + s0] = rsv; RSL[(size_t)e1 * M + s1] = rsv; }
                __syncthreads();
            }
            if (L == 3) { LAS float* scr = (LAS float*)lds + wave * (64 * 33); int jid = 0;
                for (int e = 0; e < NEXP; ++e) { bf16* wgu = (bf16*)(ws + WS_WEGU) + (size_t)e * 2 * DFE * D;
                    CONV(args.in[I_EG] + (size_t)(NEXP + e) * D * DFE, DFE, D, 0, DFE, wgu, D, 0, 1, 0, gf, 1.f);
                    CONV(args.in[I_EU] + (size_t)(NEXP + e) * D * DFE, DFE, D, 0, DFE, wgu, D, 0, 1, 4, gf, 1.f);
                    CONV(args.in[I_ED] + (size_t)(NEXP + e) * DFE * D, D, DFE, 0, D, (bf16*)(ws + WS_WEDN) + (size_t)e * D * DFE, DFE, 0, 0, 0, nullptr, 1.f); } }
            SEAM();
        }
        if (IN(10) && !moe) REPEAT(10) {
            PHASE_BEGIN
            pg8::Gemm g{XB, (const bf16*)(ws + WS_WGU) + (size_t)jl * 2 * DFF * D, D, D}; pg8::StaticOrder S; S.init(M, 2 * DFF, D, G, bx, D, D);
            pg8::EpiSwiGLU2<false, true> E{HID, DFF, SSP_E}; pg8::gemm_phase(lds, g, S, E, tid);
            SEAM();
        }
        if (IN(11)) REPEAT(11) {
            PHASE_BEGIN
            if (!moe) {
                pg8::Gemm g{HID, (const bf16*)(ws + WS_WDN) + (size_t)jl * D * DFF, DFF / 2, DFF / 2}; pg8::SubsetOrder<true> S; S.init(M, D, DFF / 2, G, bx, DFF / 2, DFF / 2); S.first = 0; S.alt = -1;
                pg8::EpiResidX<true> E{XB, XB, SSP_G, (unsigned char*)OALL, 1.0f / 256.0f}; pg8::gemm_phase(lds, g, S, E, tid);
            } else {
                pg8::MoeGatherOrder MO; MOE_CUM_ASSIGN
                pg8::Gemm g{XB, (const bf16*)(ws + WS_WEGU), D, D};
                MO.nt = (D) / 64; MO.npn = 2 * DFE / 256; MO.ta = 256L * D * 2; MO.tb = 256L * D * 2; MO.eb = 2L * DFE * D * 2;
                { LAS int* tt = (LAS int*)(lds + pg8::TOK_TAB_OFF); const int* TOKS = (const int*)(ws + WS_TOKS); const float* RSL = (const float*)(ws + WS_RSL);
                  for (int i = 0; i < 8; ++i) { int tile, pnu; if (!MO.unit_tile(i, tile, pnu)) break;
                      int e = 0, c0 = 0;
#pragma unroll
                      for (int k = 1; k < 8; ++k) if (tile >= MO.cum[k]) { e = k; c0 = MO.cum[k]; }
                      const int r0 = (tile - c0) * 256, n = (int)__builtin_amdgcn_readfirstlane(__hip_atomic_load(cnt + e, __ATOMIC_RELAXED, __HIP_MEMORY_SCOPE_AGENT)) - r0;
                      if (tid < 256) { const size_t li = (size_t)e * M + r0 + (tid < n ? tid : 0); tt[i * 256 + tid] = TOKS[li]; ((LAS float*)(lds + pg8::RSU_TAB_OFF))[i * 256 + tid] = RSL[li]; } }
                  __syncthreads(); }
                pg8::EpiSwiGLU2<true> E{HID, DFE, nullptr}; pg8::gemm_phase(lds, g, MO, E, tid);
            }
            SEAM();
        }
        if (IN(12) && moe) REPEAT(12) {
            PHASE_BEGIN
            MOE_CUM
            pg8::Gemm g{HID, (const bf16*)(ws + WS_WEDN), DFE, DFE};
            MO.nt = (DFE) / 64; MO.npn = D / 256; MO.ta = 256L * DFE * 2; MO.tb = 256L * DFE * 2; MO.eb = (long)D * DFE * 2;
            pg8::EpiStore E{XG, D}; pg8::gemm_phase(lds, g, MO, E, tid);
            SEAM();
        }
        if (IN(13) && moe) REPEAT(13) {
            PHASE_BEGIN
            { pg8::MoeOrder MO; MOE_CUM_ASSIGN
            for (int r = gw; r < M; r += NGW) { f32x4 v[4]; load_row_bf16(XB + (size_t)r * D, v, lane);
                const unsigned* ro = ROUTE + (size_t)r * 8; int o0 = 0, o1 = 0; const int e0 = (int)ro[0], e1 = (int)ro[3];
#pragma unroll
                for (int e = 0; e < 8; ++e) { if (e == e0) o0 = MO.cum[e]; if (e == e1) o1 = MO.cum[e]; }
                const float w0 = __uint_as_float(ro[2]), w1 = __uint_as_float(ro[5]);
                const u32x2* y0 = (const u32x2*)(XG + ((size_t)o0 * 256 + ro[1]) * D) + lane; const u32x2* y1 = (const u32x2*)(XG + ((size_t)o1 * 256 + ro[4]) * D) + lane; float s_ = 0.f;
#pragma unroll
                for (int j = 0; j < 4; ++j) { const u32x2 a = y0[64 * j], b2 = y1[64 * j];
                    v[j].x += w0 * bf2f(a.x & 0xffffu) + w1 * bf2f(b2.x & 0xffffu); v[j].y += w0 * bf2f(a.x >> 16) + w1 * bf2f(b2.x >> 16);
                    v[j].z += w0 * bf2f(a.y & 0xffffu) + w1 * bf2f(b2.y & 0xffffu); v[j].w += w0 * bf2f(a.y >> 16) + w1 * bf2f(b2.y >> 16);
                    s_ += (v[j].x * v[j].x + v[j].y * v[j].y) + (v[j].z * v[j].z + v[j].w * v[j].w); }
                store_row_bf16(XB + (size_t)r * D, v, 1.0f, lane); const float ss = wave_sum(s_);
                { unsigned* o4 = (unsigned*)((unsigned char*)OALL + (size_t)r * D) + lane;
#pragma unroll
                  for (int j = 0; j < 4; ++j) o4[64 * j] = pk4_fp8(v[j].x, v[j].y, v[j].z, v[j].w); }
                if (lane < 16) SSP_G[(size_t)r * 16 + lane] = (lane == 0) ? ss : 0.f; } }
            SEAM();
        }
        if (IN(15)) REPEAT(15) {
            PHASE_BEGIN
            { pg8::Gemm g{(const bf16*)ws, (const bf16*)ws, D, D};
              pg8::PleSubOrder<false> S{G, bx, 0, 4, (long)(WS_PBALL + (size_t)L * 512), (long)(WS_WPP + (size_t)L * D * D * 2), 256L * D * 2, 256L * D * 2};
              pg8::EpiStore E{PP, D}; pg8::gemm_phase(lds, g, S, E, tid); }
            { pg8::Gemm g{(const bf16*)ws, (const bf16*)ws, D / 2, D / 2};
              pg8::PleSubOrder<true> S{G, bx, 1, 8, (long)WS_OALL, (long)(WS_WPG + (size_t)L * D * D * 2), 256L * D, 256L * D};
              pg8::EpiPle3 E{XB, XBN, PP, SSP_G, SSP_H, (unsigned char*)MERGED, 1.0f / 32.0f}; pg8::gemm_phase(lds, g, S, E, tid); }
            SEAM();
        }
    }
    if (IN(PH_FINAL) && args.l_hi == DEPTH) {
        PHASE_BEGIN
        const float* gn = args.in[I_FINN];
        for (int r = gw; r < M; r += NGW) { f32x4* xr = (f32x4*)(X + (size_t)r * D) + lane; const float rs = rstd16(SSP_H + (size_t)r * 16); f32x4 v[4]; load_row_bf16(XBN + (size_t)r * D, v, lane);
#pragma unroll
            for (int j = 0; j < 4; ++j) { const f32x4 gv = *((const f32x4*)gn + lane + 64 * j); xr[64 * j] = v[j] * rs * gv; } }
    }
#undef IN
#undef SEAM
}

#ifndef MK_PER_PHASE
#define MK_PER_PHASE 0
#endif
typedef void (*kern_t)(Args);
#if MK_PER_PHASE
template <int K> struct KTab { static void fill(kern_t* t) { t[K] = mk_fwd<(1u << K)>; KTab<K - 1>::fill(t); } };
template <> struct KTab<-1> { static void fill(kern_t*) {} };
#endif
extern "C" void kernel_launch(void* const* d_in, const int* in_sizes, int n_in, void* d_out, int out_size, void* d_ws, size_t ws_size, hipStream_t stream) {
    static int grid = 0; static kern_t tab[PH_FINAL + 1];
    if (grid == 0) {
        if (n_in != 26 || out_size != M * D || ws_size < WS_END) { fprintf(stderr, "kernel_launch: unexpected shapes / workspace (n_in %d out %d ws %zu need %zu)\n", n_in, out_size, ws_size, (size_t)WS_END); grid = -1; return; }
        int dev = 0, cus = 0;
        if (hipGetDevice(&dev) != hipSuccess || hipDeviceGetAttribute(&cus, hipDeviceAttributeMultiprocessorCount, dev) != hipSuccess) { grid = -1; return; }
#if MK_PER_PHASE
        KTab<PH_FINAL>::fill(tab);
#else
        for (int k = 0; k <= PH_FINAL; ++k) tab[k] = mk_fwd<0x1FFFFu>;
#endif
        for (int k = 0; k <= PH_FINAL; ++k)
            if (hipFuncSetAttribute((const void*)tab[k], hipFuncAttributeMaxDynamicSharedMemorySize, LDS_BYTES) != hipSuccess) { grid = -1; return; }
        int per_cu = 0;
        if (hipOccupancyMaxActiveBlocksPerMultiprocessor(&per_cu, (const void*)tab[0], NTHR, LDS_BYTES) != hipSuccess || per_cu < 1) { fprintf(stderr, "kernel_launch: occupancy query reports %d workgroups per CU\n", per_cu); grid = -1; (void)hipGetLastError(); return; }
        (void)hipGetLastError();
        grid = cus;
    }
    if (grid < 0) return;
    (void)hipMemsetAsync((char*)d_ws + WS_CTL, 0, CTL_BYTES, stream);
    Args a{};
    for (int i = 0; i < 26; ++i) a.in[i] = (const float*)d_in[i];
    a.out = (float*)d_out; a.ws = (unsigned char*)d_ws; a.pad = 0;
#if MK_PER_PHASE
    a.fused = 0;
    a.l_lo = 0; a.l_hi = 0; a.ph_lo = 0; a.ph_hi = 1;
    hipLaunchKernelGGL(tab[0], dim3(grid), dim3(NTHR), LDS_BYTES, stream, a);
    for (int L = 0; L < DEPTH; ++L)
        for (int ph = 1; ph <= 15; ++ph) {
            if (ph == 12 && !(L & 1)) continue;
            a.l_lo = L; a.l_hi = L + 1; a.ph_lo = ph; a.ph_hi = ph + 1;
            hipLaunchKernelGGL(tab[ph], dim3(grid), dim3(NTHR), LDS_BYTES, stream, a);
        }
    a.l_lo = DEPTH; a.l_hi = DEPTH; a.ph_lo = PH_FINAL; a.ph_hi = PH_FINAL + 1;
    hipLaunchKernelGGL(tab[PH_FINAL], dim3(grid), dim3(NTHR), LDS_BYTES, stream, a);
#else
    a.fused = 1; a.l_lo = 0; a.l_hi = DEPTH; a.ph_lo = 0; a.ph_hi = PH_FINAL + 1;
    hipLaunchKernelGGL(tab[0], dim3(grid), dim3(NTHR), LDS_BYTES, stream, a);
#endif
}
```

```cpp
#include <hip/hip_runtime.h>
#include <cstdio>
#include <cstdint>
#include <cmath>

#define GAS __attribute__((address_space(1)))
#define LAS __attribute__((address_space(3)))
typedef unsigned short bf16;
typedef unsigned u32x4 __attribute__((ext_vector_type(4)));
typedef unsigned u32x2 __attribute__((ext_vector_type(2)));
typedef float f32x4 __attribute__((ext_vector_type(4)));
typedef float f32x2 __attribute__((ext_vector_type(2)));
typedef short bf16x8 __attribute__((ext_vector_type(8)));
typedef int v4i_t __attribute__((ext_vector_type(4)));
typedef int v8i_t __attribute__((ext_vector_type(8)));

constexpr int BATCH = 8, T = 2048, D = 1024, DEPTH = 4, M = BATCH * T;
constexpr int NPROJ = 6144;
constexpr int C_FQ = 0, C_FK = 384, C_FV = 768, C_DQ = 1152, C_DK = 1536, C_DV = 1920, C_CQ = 2304, C_CKV = 2560, C_G = 2816, C_MISC = 5888;
constexpr int S_FQ = 0, S_FK = 384, S_FV = 768, S_FZ = 1152, S_DQ = 1158, S_DK = 1542, S_DV = 1926, S_CQ = 2310, S_CKV = 2566, S_KR = 2822, S_G = 2854, IN_W = 5926;
constexpr int DFF = 2816, DFE = 1408, NEXP = 8;
constexpr float LOG2E = 1.4426950408889634f;
constexpr float QS = 0.125f * LOG2E;
constexpr float MS = 0.10206207261596577f * LOG2E;
constexpr float EPS = 1e-6f;
constexpr int MOE_ROWS = 2 * M + NEXP * 256;

constexpr size_t MiB = 1u << 20;
constexpr size_t WS_CTL = 0, CTL_BYTES = 1 * MiB;
constexpr size_t WS_WIN = 1 * MiB;
constexpr size_t WS_WUQ = WS_WIN + 48 * MiB;
constexpr size_t WS_WUKV = WS_WUQ + 1 * MiB;
constexpr size_t WS_WBR = WS_WUKV + 1 * MiB;
constexpr size_t WS_WOUT = WS_WBR + 8 * MiB;
constexpr size_t WS_WGU = WS_WOUT + 8 * MiB;
constexpr size_t WS_WDN = WS_WGU + 22 * MiB;
constexpr size_t WS_WEGU = WS_WDN + 11 * MiB;
constexpr size_t WS_WEDN = WS_WEGU + 44 * MiB;
constexpr size_t WS_WPG = WS_WEDN + 22 * MiB;
constexpr size_t WS_WPP = WS_WPG + 8 * MiB;
constexpr size_t WS_HB = WS_WPP + 8 * MiB;
constexpr size_t WS_PROJ = WS_HB + 32 * MiB;
constexpr size_t WS_HID = WS_PROJ;
constexpr size_t WS_XG = WS_PROJ + 96 * MiB;
constexpr size_t WS_PB = WS_PROJ + 32 * MiB;
constexpr size_t WS_PP = WS_PROJ;
constexpr size_t WS_MISCF = WS_PROJ + 192 * MiB;
constexpr size_t WS_QC = WS_MISCF + 4 * MiB;
constexpr size_t WS_KVC = WS_QC + 16 * MiB;
constexpr size_t WS_KR = WS_KVC + 16 * MiB;
constexpr size_t WS_DL = WS_KR + 1 * MiB;
constexpr size_t WS_RSTD = WS_DL + 1 * MiB;
constexpr size_t WS_OALL = WS_RSTD + 1 * MiB;
constexpr size_t WS_MERGED = WS_OALL + 32 * MiB;
constexpr size_t WS_CS64 = WS_MERGED + 32 * MiB;
constexpr size_t WS_CS32 = WS_CS64 + 4 * MiB;
constexpr size_t WS_ROUTE = WS_CS32 + 2 * MiB;
constexpr size_t WS_TOKS = WS_ROUTE + 1 * MiB;
constexpr size_t WS_SSP = WS_TOKS + 1 * MiB;
constexpr size_t WS_RSG = WS_SSP + 3 * MiB;
constexpr size_t WS_RSL = WS_RSG;
constexpr size_t WS_FZ = WS_RSG + 1 * MiB;
constexpr size_t WS_SSC = WS_FZ + 1 * MiB;
constexpr size_t WS_XBN = WS_SSC + 1 * MiB;
constexpr size_t WS_PBALL = WS_XBN + 32 * MiB;
constexpr size_t WS_END = WS_PBALL + 32 * MiB;
constexpr int CW_BAR = 4096;
constexpr int CW_Q = 2048;
constexpr int CW_CNT = 1024;

__device__ __forceinline__ float bf2f(unsigned b) { return __uint_as_float(b << 16); }
typedef __bf16 bf16x2_b __attribute__((ext_vector_type(2)));
__device__ __forceinline__ unsigned cvt_pk_bf16(float lo, float hi) { const f32x2 v = {lo, hi}; const bf16x2_b b = __builtin_convertvector(v, bf16x2_b); return __builtin_bit_cast(unsigned, b); }
__device__ __forceinline__ unsigned pk4_fp8(float a, float b, float c, float d) {
    a = __builtin_amdgcn_fmed3f(a, -448.f, 448.f); b = __builtin_amdgcn_fmed3f(b, -448.f, 448.f); c = __builtin_amdgcn_fmed3f(c, -448.f, 448.f); d = __builtin_amdgcn_fmed3f(d, -448.f, 448.f);
    int p = __builtin_amdgcn_cvt_pk_fp8_f32(a, b, 0, false); p = __builtin_amdgcn_cvt_pk_fp8_f32(c, d, p, true); return (unsigned)p; }
__device__ __forceinline__ float fast_sigmoid(float x) { return __builtin_amdgcn_rcpf(1.0f + __builtin_amdgcn_exp2f(-LOG2E * x)); }
__device__ __forceinline__ float wave_sum(float v) {
#pragma unroll
    for (int o = 1; o < 64; o <<= 1) v += __shfl_xor(v, o);
    return v;
}
__device__ __forceinline__ float wave_max(float v) {
#pragma unroll
    for (int o = 1; o < 64; o <<= 1) v = fmaxf(v, __shfl_xor(v, o));
    return v;
}

__device__ __forceinline__ float rstd16(const float* sp) { const f32x4 a = ((const f32x4*)sp)[0], b = ((const f32x4*)sp)[1], c = ((const f32x4*)sp)[2], d = ((const f32x4*)sp)[3];
    const f32x4 s = (a + b) + (c + d); return 1.0f / sqrtf(((s.x + s.y) + (s.z + s.w)) * (1.0f / D) + EPS); }
namespace pg8 {
constexpr int BM = 256, BK = 64, HALF = 128, HTB = HALF * BK * 2, STAGE_BYTES = 8 * HTB, NXCD = 8, WGM = 8;
__host__ __device__ __forceinline__ int lds_byte(int r, int c) { const int st = (r >> 4) * 2 + (c >> 5), rr = r & 15, cc = c & 31, ob = rr * 64 + cc * 2; return st * 1024 + (ob ^ (((ob >> 9) & 1) << 5)); }
__host__ __device__ __forceinline__ void stage_rc(int b, int& R, int& C) { const int st = b / 1024, sb = b % 1024, swz = sb ^ (((sb >> 9) & 1) << 5); R = (st >> 1) * 16 + swz / 64; C = (st & 1) * 32 + (swz % 64) / 2; }
__host__ __device__ __forceinline__ int perm32(int rho) { const int n = rho >> 4, i = rho & 15; return 8 * (i >> 2) + 4 * n + (i & 3); }

struct Unit { int pm, pn, nt, tag; long aoff, boff; };
struct Gemm { const bf16* A; const bf16* Bt; int lda, ldb; };

__device__ __forceinline__ void tile_map(int wgid, int nM, int nN, int& pm, int& pn) {
    const int nwg = nM * nN; { const int q = nwg / NXCD, r = nwg % NXCD, xcd = wgid % NXCD, off = wgid / NXCD; wgid = (xcd < r ? xcd * (q + 1) : r * (q + 1) + (xcd - r) * q) + off; }
    const int nig = WGM * nN, gid = wgid / nig, fm = gid * WGM, gsz = (nM - fm) < WGM ? (nM - fm) : WGM;
    pm = fm + ((wgid % nig) % gsz); pn = (wgid % nig) / gsz;
}
struct StaticOrder {
    static constexpr bool GATHER = false, FP8 = false;
    int nM, nN, nwg, G, c, nt; long ta, tb;
    __device__ void init(int Mr, int N, int K, int G_, int c_, int lda, int ldb) { nM = Mr / BM; nN = N / BM; nwg = nM * nN; G = G_; c = c_; nt = K / BK; ta = 256L * lda * 2; tb = 256L * ldb * 2; }
    __device__ __forceinline__ bool next(int i, Unit& u) const {
        const long L = (long)i * G + c; if (L >= nwg) return false;
        tile_map((int)L, nM, nN, u.pm, u.pn); u.nt = nt; u.tag = 0; u.aoff = u.pm * ta; u.boff = u.pn * tb; return true;
    }
};
template <bool F8> struct SubsetOrder : StaticOrder {
    static constexpr bool FP8 = F8;
    int first, alt;
    __device__ __forceinline__ bool next(int i, Unit& u) const { if (!StaticOrder::next(i, u)) return false; u.pn = (alt >= 0 && u.pn == nN - 1) ? alt : first + u.pn; u.boff = u.pn * tb; return true; }
};
struct UpOrder {
    static constexpr bool GATHER = false, FP8 = false;
    int G, c;
    __device__ bool next(int i, Unit& u) const {
        const int L = i * G + c; if (L >= 256) return false;
        u.pm = L >> 2; u.pn = L & 3; u.nt = 4; u.tag = 0; u.aoff = u.pm * (256L * NPROJ * 2) + ((u.pn >= 2) ? 512 : 0); u.boff = u.pn * (256L * 256 * 2); return true;
    }
};
struct MergeOrder {
    static constexpr bool GATHER = false, FP8 = false;
    int G, c;
    __device__ bool next(int i, Unit& u) const {
        const int j = i / 3, sub = i - 3 * j; const int L = j * G + c; if (L >= 256) return false;
        tile_map(L, 64, 4, u.pm, u.pn); u.tag = sub; u.nt = (sub == 2) ? 4 : 6; const long ko = (sub == 0) ? 0 : (sub == 1 ? 768 : 1536);
        u.aoff = u.pm * (256L * D * 2) + ko; u.boff = u.pn * (256L * D * 2) + ko; return true;
    }
};
struct PleOrder {
    static constexpr bool GATHER = false, FP8 = false;
    int G, c; long a0, a1, b0, b1;
    __device__ bool next(int i, Unit& u) const {
        const int j = i >> 1, sub = i & 1; const int L = j * G + c; if (L >= 256) return false;
        tile_map(L, 64, 4, u.pm, u.pn); u.tag = sub; u.nt = sub ? 16 : 4;
        u.aoff = (sub ? a1 : a0) + u.pm * (256L * D * 2); u.boff = (sub ? b1 : b0) + u.pn * (256L * D * 2); return true;
    }
};
template <bool F8> struct PleSubOrder {
    static constexpr bool GATHER = false, FP8 = F8;
    int G, c, sub, nt; long a, b, ta, tb;
    __device__ __forceinline__ bool next(int i, Unit& u) const {
        const int L = i * G + c; if (L >= 256) return false;
        tile_map(L, 64, 4, u.pm, u.pn); u.tag = sub; u.nt = nt; u.aoff = a + u.pm * ta; u.boff = b + u.pn * tb; return true;
    }
};
struct MoeOrder {
    static constexpr bool GATHER = false, FP8 = false;
    int cum[9]; int npn, nt, G, c; long ta, tb, eb;
    __device__ __forceinline__ bool unit_tile(int i, int& tile, int& pn) const {
        if ((G & 7) == 0) { const int x = c & 7, idx = i * (G >> 3) + (c >> 3), ntx = (cum[8] - x + 7) >> 3; if (idx >= ntx * npn) return false; tile = x + 8 * (idx / npn); pn = idx % npn; return true; }
        const long L = (long)i * G + c; if (L >= (long)cum[8] * npn) return false;
        tile = (int)(L / npn); pn = (int)(L % npn); return true;
    }
    __device__ __forceinline__ bool next(int i, Unit& u) const {
        int tile, pn; if (!unit_tile(i, tile, pn)) return false;
        int e = 0;
#pragma unroll
        for (int k = 1; k < 8; ++k) e += (tile >= cum[k]) ? 1 : 0;
        u.pm = tile; u.pn = pn; u.nt = nt; u.tag = 0; u.aoff = tile * ta; u.boff = e * eb + pn * tb; return true;
    }
};

struct MoeGatherOrder : MoeOrder {
    static constexpr bool GATHER = true;
    __device__ __forceinline__ bool next(int i, Unit& u) const { if (!MoeOrder::next(i, u)) return false; u.aoff = 0; u.tag = i; return true; }
};
constexpr int TOK_TAB_OFF = 131072 + 8192;
constexpr int RSU_TAB_OFF = 131072 + 16384;

template <class T, class = void> struct epi_chain { static constexpr bool value = false; };
template <class T> struct epi_chain<T, decltype((void)T::CHAIN)> { static constexpr bool value = T::CHAIN; };
template <class Epi> __device__ __forceinline__ bool epi_keep(const Epi& E, const Unit& u) { if constexpr (epi_chain<Epi>::value) return E.keep(u); else return false; }
template <class Epi, class Sched>
__device__ __forceinline__ void gemm_phase(LAS unsigned char* lds, const Gemm g, const Sched& S, const Epi& E, int tid_) {
    int tid = tid_; asm volatile("" : "+v"(tid));
    const int wid = __builtin_amdgcn_readfirstlane(tid >> 6), lane = tid & 63, wr = wid >> 2, wc = wid & 3, fr = lane & 15, fq = lane >> 4;
    unsigned voffA[2], voffB[2];
#pragma unroll
    for (int i = 0; i < 2; ++i) { int R, C; stage_rc(tid * 16 + i * 8192, R, C); const int Rb = (R & ~31) + perm32(R & 31);
        voffA[i] = (unsigned)(R * g.lda + C) * 2u; voffB[i] = (unsigned)(Rb * g.ldb + C) * 2u; }
    const size_t kstep = (size_t)(BK * 2);
    const size_t hstepA = (size_t)HALF * g.lda * 2, hstepB = (size_t)HALF * g.ldb * 2;
    const unsigned ldsw = (unsigned)wid * 1024u;
    const int aoff = lds_byte(wr * 64 + fr, fq * 8), boff = lds_byte(wc * 32 + fr, fq * 8);
#define PG8_SA(b, h) (((b) * 2 + (h)) * HTB)
#define PG8_SB(b, h) ((4 + (b) * 2 + (h)) * HTB)
#define PG8_STAGE(bufoff, gbase, voff) do { _Pragma("unroll") for (int _i = 0; _i < 2; ++_i) \
        __builtin_amdgcn_global_load_lds((const unsigned*)((const char*)(gbase) + (voff)[_i]), (LAS unsigned*)(lds + (bufoff) + ldsw + _i * 8192), 16, 0, 0); } while (0)
#define PG8_STA(b, h, kb, nx) do { if constexpr (Sched::GATHER) { const LAS int* tt_ = (const LAS int*)(lds + TOK_TAB_OFF) + (ui + (((nx) && has_next) ? 1 : 0)) * 256 + (h) * HALF; unsigned v_[2]; \
            _Pragma("unroll") for (int i_ = 0; i_ < 2; ++i_) { int R_, C_; stage_rc(tid * 16 + i_ * 8192, R_, C_); v_[i_] = (unsigned)(tt_[R_] * g.lda + C_) * 2u; } PG8_STAGE(PG8_SA(b, h), (kb), v_); } \
        else PG8_STAGE(PG8_SA(b, h), (kb) + (h) * hstepA, voffA); } while (0)
#define PG8_LDA(dst, b, h) do { _Pragma("unroll") for (int m = 0; m < 4; ++m) { if constexpr (Sched::FP8) { dst##8[m].lo = *(const LAS v4i_t*)(lds + PG8_SA(b, h) + aoff + m * 2048); dst##8[m].hi = *(const LAS v4i_t*)(lds + PG8_SA(b, h) + aoff + m * 2048 + 1024); } \
        else { _Pragma("unroll") for (int k = 0; k < 2; ++k) dst[m][k] = *(const LAS bf16x8*)(lds + PG8_SA(b, h) + aoff + m * 2048 + k * 1024); } } } while (0)
#define PG8_LDB(dst, b, h) do { _Pragma("unroll") for (int n = 0; n < 2; ++n) { if constexpr (Sched::FP8) { dst##8[n].lo = *(const LAS v4i_t*)(lds + PG8_SB(b, h) + boff + n * 2048); dst##8[n].hi = *(const LAS v4i_t*)(lds + PG8_SB(b, h) + boff + n * 2048 + 1024); } \
        else { _Pragma("unroll") for (int k = 0; k < 2; ++k) dst[n][k] = *(const LAS bf16x8*)(lds + PG8_SB(b, h) + boff + n * 2048 + k * 1024); } } } while (0)
#define PG8_MMA(ai, bj, At, Bt) do { __builtin_amdgcn_s_setprio(1); _Pragma("unroll") for (int m = 0; m < 4; ++m) _Pragma("unroll") for (int n = 0; n < 2; ++n) { \
        if constexpr (Sched::FP8) asm volatile("v_mfma_f32_16x16x128_f8f6f4 %0, %1, %2, %0" : "+v"(acc[ai][bj][m][n]) : "v"(Bt##8[n]), "v"(At##8[m]));     \
        else { _Pragma("unroll") for (int k = 0; k < 2; ++k) acc[ai][bj][m][n] = __builtin_amdgcn_mfma_f32_16x16x32_bf16(Bt[n][k], At[m][k], acc[ai][bj][m][n], 0, 0, 0); } } \
        __builtin_amdgcn_s_setprio(0); } while (0)
#define PG8_WAIT_V(n) asm volatile("s_waitcnt vmcnt(" #n ")" ::: "memory")
#define PG8_WAIT_L(n) asm volatile("s_waitcnt lgkmcnt(" #n ")" ::: "memory")
#define PG8_BAR __builtin_amdgcn_s_barrier()
#define PG8_SCHED __builtin_amdgcn_sched_barrier(0)
    Unit cur, nxt; int ui = 0; bool has_next = false;
    if (!S.next(0, cur)) return;
    f32x4 acc[2][2][4][2];
#pragma unroll
    for (int a = 0; a < 2; ++a)
#pragma unroll
        for (int b = 0; b < 2; ++b)
#pragma unroll
            for (int m = 0; m < 4; ++m)
#pragma unroll
                for (int n = 0; n < 2; ++n) acc[a][b][m][n] = (f32x4){0.f, 0.f, 0.f, 0.f};
    bf16x8 At[4][2], B0[2][2], B1[2][2];
    v8i_t At8[4], B08[2], B18[2];
    const char* cA = (const char*)g.A + cur.aoff; const char* cB = (const char*)g.Bt + cur.boff;
    PG8_STAGE(PG8_SB(0, 0), cB, voffB); PG8_STAGE(PG8_SB(0, 1), cB + hstepB, voffB); PG8_STA(0, 0, cA, false); PG8_STA(0, 1, cA, false);
    if (wr == 1) PG8_BAR;
    PG8_WAIT_V(2); PG8_BAR;
    PG8_STAGE(PG8_SB(1, 0), cB + kstep, voffB); PG8_STA(1, 0, cA + kstep, false); PG8_STAGE(PG8_SB(1, 1), cB + hstepB + kstep, voffB);
    PG8_WAIT_V(6); PG8_BAR;
    for (;;) {
        has_next = S.next(ui + 1, nxt);
        const char* nA = has_next ? (const char*)g.A + nxt.aoff : cA; const char* nB = has_next ? (const char*)g.Bt + nxt.boff : cB;
        int nt = cur.nt; asm volatile("" : "+s"(nt));
        for (int t = 0; t < nt; t += 2) {
            const bool last = (t == nt - 2);
            const char* a1 = cA + (size_t)(t + 1) * kstep;
            const char* a2 = last ? nA : cA + (size_t)(t + 2) * kstep; const char* b2 = last ? nB : cB + (size_t)(t + 2) * kstep;
            const char* a3 = a2 + kstep; const char* b3 = b2 + kstep;
            PG8_LDB(B0, 0, 0); PG8_LDB(B1, 0, 1); PG8_SCHED; PG8_LDA(At, 0, 0); PG8_STA(1, 1, a1, false);
            PG8_WAIT_V(8); PG8_WAIT_L(0); PG8_BAR; PG8_MMA(0, 0, At, B0); PG8_MMA(0, 1, At, B1); PG8_BAR; PG8_SCHED;
            PG8_LDA(At, 0, 1); PG8_STAGE(PG8_SB(0, 0), b2, voffB); PG8_STAGE(PG8_SB(0, 1), b2 + hstepB, voffB); PG8_STA(0, 0, a2, last);
            PG8_WAIT_V(8); PG8_WAIT_L(0); PG8_BAR; PG8_MMA(1, 0, At, B0); PG8_MMA(1, 1, At, B1); PG8_BAR; PG8_SCHED;
            PG8_LDB(B0, 1, 0); PG8_LDB(B1, 1, 1); PG8_SCHED; PG8_LDA(At, 1, 0); PG8_STA(0, 1, a2, last);
            PG8_WAIT_V(8); PG8_WAIT_L(0); PG8_BAR; PG8_MMA(0, 0, At, B0); PG8_MMA(0, 1, At, B1); PG8_BAR; PG8_SCHED;
            PG8_LDA(At, 1, 1); PG8_STAGE(PG8_SB(1, 0), b3, voffB); PG8_STAGE(PG8_SB(1, 1), b3 + hstepB, voffB); PG8_STA(1, 0, a3, last);
            PG8_WAIT_V(8); PG8_WAIT_L(0); PG8_BAR; PG8_MMA(1, 0, At, B0); PG8_MMA(1, 1, At, B1); PG8_BAR; PG8_SCHED;
        }
        if constexpr (Sched::FP8) asm volatile("s_nop 15\n\ts_nop 7" ::: "memory");
        if (wr == 0) PG8_BAR;
        if constexpr (Epi::PRE) { E.pre(cur, lds, tid); asm volatile("s_waitcnt lgkmcnt(0)" ::: "memory"); PG8_BAR; }
        if constexpr (epi_chain<Epi>::value) E.chain(acc, cur, wr, wc, fr, fq, lds); else E(acc, cur, wr, wc, fr, fq, lds);
        if (!has_next) break;
        if (!epi_keep(E, cur))
#pragma unroll
        for (int a = 0; a < 2; ++a)
#pragma unroll
            for (int b = 0; b < 2; ++b)
#pragma unroll
                for (int m = 0; m < 4; ++m)
#pragma unroll
                    for (int n = 0; n < 2; ++n) acc[a][b][m][n] = (f32x4){0.f, 0.f, 0.f, 0.f};
        cur = nxt; cA = nA; cB = nB; ++ui;
        if (wr == 1) PG8_BAR;
    }
    PG8_WAIT_V(0);
    PG8_BAR;
#undef PG8_SA
#undef PG8_SB
#undef PG8_STAGE
#undef PG8_LDA
#undef PG8_STA
#undef PG8_LDB
#undef PG8_MMA
#undef PG8_WAIT_V
#undef PG8_WAIT_L
#undef PG8_BAR
#undef PG8_SCHED
}

constexpr int RS_TAB_OFF = 131072 + 4096;
__device__ __forceinline__ u32x4 pack8(f32x4 v0, f32x4 v1) { u32x4 w; w.x = cvt_pk_bf16(v0[0], v0[1]); w.y = cvt_pk_bf16(v0[2], v0[3]); w.z = cvt_pk_bf16(v1[0], v1[1]); w.w = cvt_pk_bf16(v1[2], v1[3]); return w; }
__device__ __forceinline__ void unpack8(u32x4 w, f32x4& a, f32x4& b) {
    a = (f32x4){bf2f(w.x & 0xffffu), bf2f(w.x >> 16), bf2f(w.y & 0xffffu), bf2f(w.y >> 16)};
    b = (f32x4){bf2f(w.z & 0xffffu), bf2f(w.z >> 16), bf2f(w.w & 0xffffu), bf2f(w.w >> 16)}; }
__device__ __forceinline__ float sq8(f32x4 a, f32x4 b) { return ((a.x * a.x + a.y * a.y) + (a.z * a.z + a.w * a.w)) + ((b.x * b.x + b.y * b.y) + (b.z * b.z + b.w * b.w)); }
__device__ __forceinline__ float rstd16f(const float* sp) { const f32x4 a = ((const GAS f32x4*)sp)[0], b = ((const GAS f32x4*)sp)[1], c = ((const GAS f32x4*)sp)[2], d = ((const GAS f32x4*)sp)[3];
    const f32x4 s = (a + b) + (c + d); return __builtin_amdgcn_rsqf(((s.x + s.y) + (s.z + s.w)) * (1.0f / D) + EPS); }
__device__ __forceinline__ void rope4(f32x4& v0, f32x4& v1, const f32x2* cs) {
    const f32x4 a = ((const GAS f32x4*)cs)[0], b = ((const GAS f32x4*)cs)[1]; float x1, x2;
    x1 = v0[0]; x2 = v0[1]; v0[0] = x1 * a.x - x2 * a.y; v0[1] = x2 * a.x + x1 * a.y;
    x1 = v0[2]; x2 = v0[3]; v0[2] = x1 * a.z - x2 * a.w; v0[3] = x2 * a.z + x1 * a.w;
    x1 = v1[0]; x2 = v1[1]; v1[0] = x1 * b.x - x2 * b.y; v1[1] = x2 * b.x + x1 * b.y;
    x1 = v1[2]; x2 = v1[3]; v1[2] = x1 * b.z - x2 * b.w; v1[3] = x2 * b.z + x1 * b.w;
}
#define EPI_HEAD const int row0 = u.pm * BM + wr * 64 + fr, ct0 = wc * 32 + 8 * fq, pn = u.pn; (void)pn; const LAS float* rstab = (const LAS float*)(lds + RS_TAB_OFF) + wr * 64 + fr; (void)rstab;
#define EPI_ARGS const f32x4 (&acc)[2][2][4][2], const Unit& u, int wr, int wc, int fr, int fq, LAS unsigned char* lds
#define EPI_FOR_ROWS _Pragma("unroll") for (int ai = 0; ai < 2; ++ai) _Pragma("unroll") for (int m = 0; m < 4; ++m)
#define EPI_FOR_BJ _Pragma("unroll") for (int bj = 0; bj < 2; ++bj)
#define EPI_RS(ai, m) rstab[(ai) * HALF + (m) * 16]

struct EpiProj3 {
    static constexpr bool PRE = true;
    bf16* P; bf16* KR; float* FZ; float* SSC; const float* SSP; const f32x2* CS64; const f32x2* CS32;
    __device__ __forceinline__ void pre(const Unit& u, LAS unsigned char* lds, int tid) const { if (tid < 256) ((LAS float*)(lds + RS_TAB_OFF))[tid] = rstd16f(SSP + (size_t)(u.pm * BM + tid) * 16); }
    __device__ __forceinline__ void operator()(EPI_ARGS) const {
        EPI_HEAD
        const bool sig = (pn >= 11 && pn < 23), misc = (pn == 23), lat = (pn == 9 || pn == 10);
        if (sig) {
            EPI_FOR_ROWS { const int row = row0 + ai * HALF + m * 16; const float rsn = EPI_RS(ai, m) * (-LOG2E); const float k255 = 1.0f / 255.0f;
                EPI_FOR_BJ { const int col = pn * BM + bj * HALF + ct0; u32x2 q = {0u, 0u};
#pragma unroll
                    for (int e = 0; e < 4; ++e) {
                        q.x = __builtin_amdgcn_cvt_pk_u8_f32(__builtin_amdgcn_rcpf(__builtin_fmaf(__builtin_amdgcn_exp2f(acc[ai][bj][m][0][e] * rsn), k255, k255)), e, q.x);
                        q.y = __builtin_amdgcn_cvt_pk_u8_f32(__builtin_amdgcn_rcpf(__builtin_fmaf(__builtin_amdgcn_exp2f(acc[ai][bj][m][1][e] * rsn), k255, k255)), e, q.y); }
                    *(GAS u32x2*)((GAS unsigned char*)P + (size_t)row * (NPROJ * 2) + 2 * C_G + (col - C_G)) = q; } }
            return;
        }
        EPI_FOR_ROWS { const int row = row0 + ai * HALF + m * 16; const float rs = EPI_RS(ai, m); float ssq = 0.f;
            EPI_FOR_BJ { const int tc = bj * HALF + ct0, col = pn * BM + tc; f32x4 v0 = acc[ai][bj][m][0] * rs, v1 = acc[ai][bj][m][1] * rs;
                const int seg = col >> 6; const bool rope = (seg >= 18 && seg < 30), krt = (misc && bj == 0 && wc == 0);
                if (rope) rope4(v0, v1, CS64 + (size_t)row * 32 + ((col & 63) >> 1));
                if (krt) rope4(v0, v1, CS32 + (size_t)row * 16 + 4 * fq);
                if (lat) ssq += sq8(v0, v1);
                const u32x4 w = pack8(v0, v1);
                *(GAS u32x4*)(P + (size_t)row * NPROJ + col) = w;
                if (krt) *(GAS u32x4*)(KR + (size_t)row * 32 + 8 * fq) = w;
                if (misc && bj == 0 && wc == 1 && fq == 0) { float* fp = FZ + (size_t)row * 8; *(f32x4*)fp = v0; *(GAS f32x4*)(fp + 4) = v1; }
            }
            if (lat) { ssq += __shfl_xor(ssq, 16); ssq += __shfl_xor(ssq, 32); if (fq == 0) ((GAS float*)SSC)[((size_t)(pn - 9) * M + row) * 4 + wc] = ssq; }
        }
    }
};
struct EpiGate {
    static constexpr bool PRE = true;
    bf16* P; const float* SSP; float wscale;
    __device__ __forceinline__ void pre(const Unit& u, LAS unsigned char* lds, int tid) const { if (tid < 256) ((LAS float*)(lds + RS_TAB_OFF))[tid] = rstd16f(SSP + (size_t)(u.pm * BM + tid) * 16); }
    __device__ __forceinline__ void operator()(EPI_ARGS) const {
        EPI_HEAD
        EPI_FOR_ROWS { const int row = row0 + ai * HALF + m * 16; const float rsn = EPI_RS(ai, m) * (-LOG2E) * wscale; const float k255 = 1.0f / 255.0f;
            EPI_FOR_BJ { const int gcol = pn * BM + bj * HALF + ct0; u32x2 q = {0u, 0u};
#pragma unroll
                for (int e = 0; e < 4; ++e) {
                    q.x = __builtin_amdgcn_cvt_pk_u8_f32(__builtin_amdgcn_rcpf(__builtin_fmaf(__builtin_amdgcn_exp2f(acc[ai][bj][m][0][e] * rsn), k255, k255)), e, q.x);
                    q.y = __builtin_amdgcn_cvt_pk_u8_f32(__builtin_amdgcn_rcpf(__builtin_fmaf(__builtin_amdgcn_exp2f(acc[ai][bj][m][1][e] * rsn), k255, k255)), e, q.y); }
                *(GAS u32x2*)((GAS unsigned char*)P + (size_t)row * (NPROJ * 2) + 2 * C_G + gcol) = q; } }
    }
};
struct EpiUp {
    static constexpr bool PRE = true;
    bf16* QC; bf16* KVC; const float* SSC; const f32x2* CS32;
    __device__ __forceinline__ void pre(const Unit& u, LAS unsigned char* lds, int tid) const {
        if (tid < 256) { const f32x4 sp = *(const GAS f32x4*)(SSC + ((size_t)(u.pn >> 1) * M + u.pm * BM + tid) * 4);
            ((LAS float*)(lds + RS_TAB_OFF))[tid] = __builtin_amdgcn_rsqf(((sp.x + sp.y) + (sp.z + sp.w)) * (1.0f / 256.0f) + EPS); } }
    __device__ __forceinline__ void operator()(EPI_ARGS) const {
        EPI_HEAD
        bf16* const dbase = ((pn < 2) ? QC : KVC) + (pn & 1) * 256;
        EPI_FOR_ROWS { const int row = row0 + ai * HALF + m * 16; const float rs = EPI_RS(ai, m);
            EPI_FOR_BJ { const int tc = bj * HALF + ct0; f32x4 v0 = acc[ai][bj][m][0] * rs, v1 = acc[ai][bj][m][1] * rs;
                if (pn == 1 && bj == 0) rope4(v0, v1, CS32 + (size_t)row * 16 + 4 * fq);
                *(GAS u32x4*)(dbase + (size_t)row * 512 + tc) = pack8(v0, v1);
            } }
    }
};
struct EpiMerge {
    static constexpr bool PRE = false;
    bf16* O; const bf16* gate;
    __device__ __forceinline__ void pre(const Unit&, LAS unsigned char*, int) const {}
    __device__ __forceinline__ void operator()(EPI_ARGS) const {
        EPI_HEAD
#pragma unroll
        for (int ai = 0; ai < 2; ++ai) { u32x2 gin[4][2]; u32x4 oin[4][2];
#pragma unroll
            for (int m = 0; m < 4; ++m) EPI_FOR_BJ { const size_t row = (size_t)(row0 + ai * HALF + m * 16); const int col = pn * BM + bj * HALF + ct0;
                gin[m][bj] = *(const GAS u32x2*)((const GAS unsigned char*)gate + row * (NPROJ * 2) + u.tag * 1024 + col); oin[m][bj] = (u.tag != 0) ? *(const GAS u32x4*)(O + row * D + col) : (u32x4){0u, 0u, 0u, 0u}; }
#pragma unroll
            for (int m = 0; m < 4; ++m) EPI_FOR_BJ { const size_t row = (size_t)(row0 + ai * HALF + m * 16); const int col = pn * BM + bj * HALF + ct0;
                f32x4 g0, g1, o0, o1; unpack8(oin[m][bj], o0, o1); const unsigned ga = gin[m][bj].x, gb = gin[m][bj].y; const float k255 = 1.0f / 255.0f;
                g0 = (f32x4){(float)(ga & 255u), (float)((ga >> 8) & 255u), (float)((ga >> 16) & 255u), (float)(ga >> 24)} * k255; g1 = (f32x4){(float)(gb & 255u), (float)((gb >> 8) & 255u), (float)((gb >> 16) & 255u), (float)(gb >> 24)} * k255;
                *(GAS u32x4*)(O + row * D + col) = pack8(acc[ai][bj][m][0] * g0 + o0, acc[ai][bj][m][1] * g1 + o1); } }
    }
};
struct EpiMergeChain {
    static constexpr bool PRE = false, CHAIN = true;
    bf16* O; const bf16* gate;
    __device__ __forceinline__ void pre(const Unit&, LAS unsigned char*, int) const {}
    __device__ __forceinline__ bool keep(const Unit& u) const { return u.tag < 2; }
    static __device__ __forceinline__ void dec8(u32x2 w, bool clamp, f32x4& a, f32x4& b) {
        a = (f32x4){(float)(w.x & 255u), (float)((w.x >> 8) & 255u), (float)((w.x >> 16) & 255u), (float)(w.x >> 24)}; b = (f32x4){(float)(w.y & 255u), (float)((w.y >> 8) & 255u), (float)((w.y >> 16) & 255u), (float)(w.y >> 24)};
        if (clamp) {
#pragma unroll
            for (int e = 0; e < 4; ++e) { a[e] = __builtin_fmaxf(a[e], 1.0f); b[e] = __builtin_fmaxf(b[e], 1.0f); } } }
    __device__ __forceinline__ void chain(f32x4 (&acc)[2][2][4][2], const Unit& u, int wr, int wc, int fr, int fq, LAS unsigned char* lds) const {
        EPI_HEAD
        const int tg = u.tag; const bool last = tg == 2;
#pragma unroll
        for (int ai = 0; ai < 2; ++ai) { u32x2 gc[4][2], gn[4][2];
#pragma unroll
            for (int m = 0; m < 4; ++m) EPI_FOR_BJ { const size_t row = (size_t)(row0 + ai * HALF + m * 16); const int col = pn * BM + bj * HALF + ct0;
                const GAS unsigned char* gp = (const GAS unsigned char*)gate + row * (NPROJ * 2) + tg * 1024 + col;
                gc[m][bj] = *(const GAS u32x2*)gp; gn[m][bj] = last ? (u32x2){0u, 0u} : *(const GAS u32x2*)(gp + 1024); }
#pragma unroll
            for (int m = 0; m < 4; ++m) EPI_FOR_BJ { const size_t row = (size_t)(row0 + ai * HALF + m * 16); const int col = pn * BM + bj * HALF + ct0;
                f32x4 c0, c1, n0, n1; dec8(gc[m][bj], tg != 0, c0, c1);
                if (!last) { dec8(gn[m][bj], true, n0, n1);
#pragma unroll
                    for (int e = 0; e < 4; ++e) { acc[ai][bj][m][0][e] *= c0[e] * __builtin_amdgcn_rcpf(n0[e]); acc[ai][bj][m][1][e] *= c1[e] * __builtin_amdgcn_rcpf(n1[e]); } }
                if (last) { const float k255 = 8.0f / 255.0f; const f32x4 v0 = acc[ai][bj][m][0] * (c0 * k255), v1 = acc[ai][bj][m][1] * (c1 * k255);
                    u32x2 q8; q8.x = pk4_fp8(v0[0], v0[1], v0[2], v0[3]); q8.y = pk4_fp8(v1[0], v1[1], v1[2], v1[3]); *(GAS u32x2*)((GAS unsigned char*)O + row * D + col) = q8; } } }
    }
};
template <bool Q8> struct EpiResidX {
    static constexpr bool PRE = false;
    const bf16* XBi; bf16* XBo; float* SSPo; unsigned char* XQ8; float ascale;
    __device__ __forceinline__ void pre(const Unit&, LAS unsigned char*, int) const {}
    __device__ __forceinline__ void operator()(EPI_ARGS) const {
        EPI_HEAD
#pragma unroll
        for (int ai = 0; ai < 2; ++ai) { u32x4 xin[4][2];
#pragma unroll
            for (int m = 0; m < 4; ++m) EPI_FOR_BJ xin[m][bj] = *(const GAS u32x4*)(XBi + (size_t)(row0 + ai * HALF + m * 16) * D + pn * BM + bj * HALF + ct0);
#pragma unroll
            for (int m = 0; m < 4; ++m) { const int row = row0 + ai * HALF + m * 16; float ss = 0.f;
                EPI_FOR_BJ { const int col = pn * BM + bj * HALF + ct0; f32x4 x0, x1; unpack8(xin[m][bj], x0, x1);
                    x0 = x0 + acc[ai][bj][m][0] * ascale; x1 = x1 + acc[ai][bj][m][1] * ascale;
                    *(GAS u32x4*)(XBo + (size_t)row * D + col) = pack8(x0, x1); ss += sq8(x0, x1);
                    if (Q8) { u32x2 q8; q8.x = pk4_fp8(x0[0], x0[1], x0[2], x0[3]); q8.y = pk4_fp8(x1[0], x1[1], x1[2], x1[3]); *(GAS u32x2*)(XQ8 + (size_t)row * D + col) = q8; } }
                ss += __shfl_xor(ss, 16); ss += __shfl_xor(ss, 32); if (fq == 0) ((GAS float*)SSPo)[(size_t)row * 16 + pn * 4 + wc] = ss; } }
    }
};
template <bool GATH, bool F8O = false> struct EpiSwiGLU2 {
    static constexpr bool PRE = !GATH;
    bf16* Hd; int ldh; const float* rsp;
    __device__ __forceinline__ void pre(const Unit& u, LAS unsigned char* lds, int tid) const {
        if (tid < 256) ((LAS float*)(lds + RS_TAB_OFF))[tid] = rstd16f(rsp + (size_t)(u.pm * BM + tid) * 16); }
    __device__ __forceinline__ void operator()(EPI_ARGS) const {
        EPI_HEAD
        const LAS float* rsu = (const LAS float*)(lds + RSU_TAB_OFF) + u.tag * 256 + wr * 64 + fr;
        EPI_FOR_ROWS { const int row = row0 + ai * HALF + m * 16; const float rs = GATH ? rsu[ai * HALF + m * 16] : EPI_RS(ai, m);
            EPI_FOR_BJ { const int col = pn * BM + bj * HALF + ct0; const f32x4 g = acc[ai][bj][m][0] * rs, up = acc[ai][bj][m][1] * rs; f32x4 h;
#pragma unroll
                for (int e = 0; e < 4; ++e) h[e] = g[e] * fast_sigmoid(g[e]) * up[e];
                if (F8O) *(GAS unsigned*)((GAS unsigned char*)Hd + (size_t)row * ldh + (col >> 1)) = pk4_fp8(h[0] * 8.f, h[1] * 8.f, h[2] * 8.f, h[3] * 8.f);
                else { u32x2 w; w.x = cvt_pk_bf16(h[0], h[1]); w.y = cvt_pk_bf16(h[2], h[3]); *(GAS u32x2*)(Hd + (size_t)row * ldh + (col >> 1)) = w; } } }
    }
};
struct EpiStore {
    static constexpr bool PRE = false;
    bf16* O; int ldc;
    __device__ __forceinline__ void pre(const Unit&, LAS unsigned char*, int) const {}
    __device__ __forceinline__ void operator()(EPI_ARGS) const {
        EPI_HEAD
        EPI_FOR_ROWS { const int row = row0 + ai * HALF + m * 16;
            EPI_FOR_BJ { const int col = pn * BM + bj * HALF + ct0; *(GAS u32x4*)(O + (size_t)row * ldc + col) = pack8(acc[ai][bj][m][0], acc[ai][bj][m][1]); } }
    }
};
struct EpiPle3 {
    static constexpr bool PRE = true;
    const bf16* XBi; bf16* XBo; bf16* PPS; const float* SSPi; float* SSPo; unsigned char* XQ8; float wscale;
    __device__ __forceinline__ void pre(const Unit& u, LAS unsigned char* lds, int tid) const { if (u.tag != 0 && tid < 256) ((LAS float*)(lds + RS_TAB_OFF))[tid] = rstd16f(SSPi + (size_t)(u.pm * BM + tid) * 16) * wscale; }
    __device__ __forceinline__ void operator()(EPI_ARGS) const {
        EPI_HEAD
        if (u.tag == 0) {
            EPI_FOR_ROWS { const int row = row0 + ai * HALF + m * 16;
                EPI_FOR_BJ { const int col = pn * BM + bj * HALF + ct0; *(GAS u32x4*)(PPS + (size_t)row * D + col) = pack8(acc[ai][bj][m][0], acc[ai][bj][m][1]); } }
        } else {
#pragma unroll
            for (int aq = 0; aq < 4; ++aq) { const int ai = aq >> 1, m0 = (aq & 1) * 2; u32x4 xin[4][2], pin[4][2];
#pragma unroll
                for (int m = m0; m < m0 + 2; ++m) EPI_FOR_BJ { const size_t off = (size_t)(row0 + ai * HALF + m * 16) * D + pn * BM + bj * HALF + ct0; xin[m][bj] = *(const GAS u32x4*)(XBi + off); pin[m][bj] = *(const GAS u32x4*)(PPS + off); }
#pragma unroll
                for (int m = m0; m < m0 + 2; ++m) { const int row = row0 + ai * HALF + m * 16; const float rs = EPI_RS(ai, m); float ss = 0.f;
                    EPI_FOR_BJ { const int col = pn * BM + bj * HALF + ct0; f32x4 p0, p1, x0, x1; unpack8(pin[m][bj], p0, p1); unpack8(xin[m][bj], x0, x1);
                        const f32x4 v0 = acc[ai][bj][m][0] * rs, v1 = acc[ai][bj][m][1] * rs;
#pragma unroll
                        for (int e = 0; e < 4; ++e) { x0[e] += fast_sigmoid(v0[e]) * p0[e]; x1[e] += fast_sigmoid(v1[e]) * p1[e]; }
                        *(GAS u32x4*)(XBo + (size_t)row * D + col) = pack8(x0, x1); ss += sq8(x0, x1);
                        { u32x2 q8; q8.x = pk4_fp8(x0[0], x0[1], x0[2], x0[3]); q8.y = pk4_fp8(x1[0], x1[1], x1[2], x1[3]); *(GAS u32x2*)(XQ8 + (size_t)row * D + col) = q8; } }
                    ss += __shfl_xor(ss, 16); ss += __shfl_xor(ss, 32); if (fq == 0) ((GAS float*)SSPo)[(size_t)row * 16 + pn * 4 + wc] = ss; } }
        }
    }
};
}

#define XB_TMO      128
#define XB_XCNT(j)  (256  + 64 * (j))
#define XB_XSUB(j)  (1280 + 64 * (j))
#define XB_XGEN(j)  (2304 + 64 * (j))
#define XB_TOP      3328
#define XB_TOPGEN   3392
#define XCD_BAR_WORDS 3456
#define XB_SPIN_CAP (1u << 18)
__device__ __forceinline__ unsigned xb_ld(unsigned* p)              { return __hip_atomic_load(p, __ATOMIC_RELAXED, __HIP_MEMORY_SCOPE_AGENT); }
__device__ __forceinline__ unsigned xb_add(unsigned* p, unsigned v) { return __hip_atomic_fetch_add(p, v, __ATOMIC_RELAXED, __HIP_MEMORY_SCOPE_AGENT); }
__device__ __forceinline__ unsigned xb_xcc_id() { return (unsigned)__builtin_amdgcn_s_getreg((3 << 11) | 20) & 0xFu; }
#define XB_SPIN(cond, bar) do { unsigned _sp = 0; while (cond) { __builtin_amdgcn_s_sleep(1); \
    if ((++_sp & 255u) == 0u) { if (xb_ld(&(bar)[XB_TMO])) break; if (_sp > XB_SPIN_CAP) { atomicAdd(&(bar)[XB_TMO], 1u); break; } } } } while (0)
struct XcdBarrier { unsigned* bar; unsigned x; volatile LAS unsigned* st; };
__device__ __forceinline__ XcdBarrier xcd_barrier_post(unsigned* bar, volatile LAS unsigned* st) {
    XcdBarrier b; b.bar = bar; b.x = xb_xcc_id(); b.st = st;
    if (threadIdx.x == 0) (void)xb_add(&bar[XB_XCNT(b.x)], 1u);
    return b;
}
__device__ __forceinline__ void xcd_barrier_complete(unsigned* bar, unsigned x, unsigned& nloc, unsigned& nx) {
    const unsigned G = gridDim.x * gridDim.y * gridDim.z;
    unsigned sum, cnt, mine, sp = 0u;
    for (;;) {
        sum = 0u; cnt = 0u; mine = 0u;
#pragma unroll
        for (unsigned j = 0; j < 16; ++j) { const unsigned c = xb_ld(&bar[XB_XCNT(j)]); sum += c; cnt += (c > 0u) ? 1u : 0u; mine = (j == x) ? c : mine; }
        if (sum == G) break;
        __builtin_amdgcn_s_sleep(1);
        if ((++sp & 255u) == 0u) { if (xb_ld(&bar[XB_TMO])) break; if (sp > XB_SPIN_CAP) { atomicAdd(&bar[XB_TMO], 1u); break; } }
    }
    nloc = mine > 0u ? mine : 1u; nx = cnt > 0u ? cnt : 1u;
}
__device__ __forceinline__ void xcd_barrier(const XcdBarrier& b, bool leader) {
    asm volatile("s_waitcnt vmcnt(0)" ::: "memory");
    __syncthreads();
    if (leader) {
        unsigned* bar = b.bar;
        __builtin_amdgcn_s_waitcnt(0);
        unsigned nloc = b.st[0], nx = b.st[1];
        if (nloc == 0u) { xcd_barrier_complete(bar, b.x, nloc, nx); b.st[0] = nloc; b.st[1] = nx; }
        const unsigned old = xb_add(&bar[XB_XSUB(b.x)], 1u);
        const unsigned gen = old / nloc;
        if (old + 1u == (gen + 1u) * nloc) {
            __builtin_amdgcn_fence(__ATOMIC_RELEASE, "agent");
            asm volatile("s_waitcnt vmcnt(0)" ::: "memory");
            const unsigned og = xb_add(&bar[XB_TOP], 1u);
            const unsigned tg = og / nx;
            if (og + 1u == (tg + 1u) * nx) xb_add(&bar[XB_TOPGEN], 1u);
            else XB_SPIN(xb_ld(&bar[XB_TOPGEN]) == tg, bar);
            __builtin_amdgcn_fence(__ATOMIC_ACQUIRE, "agent");
            xb_add(&bar[XB_XGEN(b.x)], 1u);
            asm volatile("s_waitcnt vmcnt(0)" ::: "memory");
        } else {
            XB_SPIN(xb_ld(&bar[XB_XGEN(b.x)]) == gen, bar);
            __builtin_amdgcn_fence(__ATOMIC_ACQUIRE, "agent");
            asm volatile("s_waitcnt vmcnt(0)" ::: "memory");
        }
    }
    __syncthreads();
}

__device__ __forceinline__ void xcd_barrier_arrive(const XcdBarrier& b, bool leader) {
    asm volatile("s_waitcnt vmcnt(0)" ::: "memory");
    __syncthreads();
    if (leader) {
        unsigned* bar = b.bar;
        __builtin_amdgcn_s_waitcnt(0);
        unsigned nloc = b.st[0], nx = b.st[1];
        if (nloc == 0u) { xcd_barrier_complete(bar, b.x, nloc, nx); b.st[0] = nloc; b.st[1] = nx; }
        const unsigned old = xb_add(&bar[XB_XSUB(b.x)], 1u);
        const unsigned gen = old / nloc;
        unsigned role = 0u, tg = 0u;
        if (old + 1u == (gen + 1u) * nloc) {
            __builtin_amdgcn_fence(__ATOMIC_RELEASE, "agent");
            asm volatile("s_waitcnt vmcnt(0)" ::: "memory");
            const unsigned og = xb_add(&bar[XB_TOP], 1u);
            tg = og / nx; role = 1u;
            if (og + 1u == (tg + 1u) * nx) { xb_add(&bar[XB_TOPGEN], 1u); role = 2u; }
        }
        b.st[2] = role; b.st[3] = gen; b.st[4] = tg;
    }
}
__device__ __forceinline__ void xcd_barrier_wait(const XcdBarrier& b, bool leader) {
    asm volatile("s_waitcnt vmcnt(0)" ::: "memory");
    __syncthreads();
    if (leader) {
        unsigned* bar = b.bar;
        const unsigned role = b.st[2], gen = b.st[3], tg = b.st[4];
        if (role != 0u) {
            if (role == 1u) XB_SPIN(xb_ld(&bar[XB_TOPGEN]) == tg, bar);
            __builtin_amdgcn_fence(__ATOMIC_ACQUIRE, "agent");
            xb_add(&bar[XB_XGEN(b.x)], 1u);
            asm volatile("s_waitcnt vmcnt(0)" ::: "memory");
        } else {
            XB_SPIN(xb_ld(&bar[XB_XGEN(b.x)]) == gen, bar);
            __builtin_amdgcn_fence(__ATOMIC_ACQUIRE, "agent");
            asm volatile("s_waitcnt vmcnt(0)" ::: "memory");
        }
    }
    __syncthreads();
}

constexpr int RING_BYTES = 131072;
constexpr int MISC_OFF = RING_BYTES;
constexpr int LDS_BYTES = 155648;
constexpr int NWAVES = 8, NTHR = 512;

struct Args { const float* in[26]; float* out; unsigned char* ws; int l_lo, l_hi, ph_lo, ph_hi, fused, pad; };
enum { I_X = 0, I_P, I_POS, I_MIXN, I_WIN, I_BF, I_QN, I_KVN, I_WUQ, I_WUKV, I_BRF, I_BRD, I_BRM, I_WOUT, I_FFNN, I_FG, I_FU, I_FD, I_WR, I_EG, I_EU, I_ED, I_PLEN, I_WPG, I_WPP, I_FINN };
constexpr int PH_FINAL = 16;
constexpr unsigned DBL_MASK = 0u;

__device__ __forceinline__ int map_row(int c, int mode, int sub) {
    if (mode == 1) return (c >> 2) * 8 + sub + (c & 3);
    if (mode == 2) { const int d = c & 63; return (c & ~63) + (d < 32 ? 2 * d : 2 * (d - 32) + 1); }
    if (mode == 3) { const int d = c & 31; return (c & ~31) + (d < 16 ? 2 * d : 2 * (d - 16) + 1); }
    return c;
}
__device__ __forceinline__ void conv_job(LAS float* scr, const float* src, int lds_, int K, int col0, int ncols, bf16* dst, int ldd, int row0, int mode, int sub,
                                         const float* gain, float scale, int wg, int nwg) {
    const int tid = threadIdx.x;
    const int nct = (ncols + 63) >> 6, nkt = K >> 6, ntiles = nct * nkt;
    for (int t = wg; t < ntiles; t += nwg) {
        const int kt = t / nct, ct = t - kt * nct, k0 = kt * 64, c0 = ct * 64;
#pragma unroll
        for (int j = 0; j < 8; ++j) { const int kk = (tid >> 6) + 8 * j, cc = tid & 63; float v = 0.f;
            if (c0 + cc < ncols) v = src[(size_t)(k0 + kk) * lds_ + col0 + c0 + cc];
            if (gain) v *= gain[k0 + kk];
            scr[kk * 65 + cc] = v * scale; }
        __syncthreads();
        { const int cc = tid >> 3, kc = (tid & 7) * 8;
          if (c0 + cc < ncols) { const int c = c0 + cc; const int dr = row0 + map_row(c, mode, sub);
              u32x4 o; o.x = cvt_pk_bf16(scr[(kc + 0) * 65 + cc], scr[(kc + 1) * 65 + cc]); o.y = cvt_pk_bf16(scr[(kc + 2) * 65 + cc], scr[(kc + 3) * 65 + cc]);
              o.z = cvt_pk_bf16(scr[(kc + 4) * 65 + cc], scr[(kc + 5) * 65 + cc]); o.w = cvt_pk_bf16(scr[(kc + 6) * 65 + cc], scr[(kc + 7) * 65 + cc]);
              *(u32x4*)(dst + (size_t)dr * ldd + k0 + kc) = o; } }
        __syncthreads();
    }
}
__device__ __forceinline__ void conv_items(LAS float* scr, const float* src, int lds_, int K, int col0, int ncols, bf16* dst, int ldd, int row0, int mode, int sub,
                                           const float* gain, float scale, int start, int nw, int lane) {
    const int nct = (ncols + 31) >> 5, nkt = K >> 6, nitems = ((nct + 3) >> 2) * nkt * 4;
    for (int it = start; it < nitems; it += nw) {
        const int r_ = it >> 2, kt = r_ % nkt, ct = (r_ / nkt) * 4 + (it & 3), k0 = kt * 64, c0 = ct * 32;
        if (ct >= nct) continue;
        const int cp = 2 * (lane & 15), kr = lane >> 4; const bool okc = (c0 + cp) < ncols; const float* sp = src + (size_t)(k0 + kr) * lds_ + col0 + c0 + cp;
        f32x2 v[16];
#pragma unroll
        for (int i = 0; i < 16; ++i) v[i] = okc ? __builtin_nontemporal_load((const f32x2*)(sp + (size_t)(4 * i) * lds_)) : (f32x2){0.f, 0.f};
#pragma unroll
        for (int i = 0; i < 16; ++i) { scr[(4 * i + kr) * 33 + cp] = v[i].x; scr[(4 * i + kr) * 33 + cp + 1] = v[i].y; }
        asm volatile("s_waitcnt lgkmcnt(0)" ::: "memory");
        const int c = lane & 7;
        f32x4 g0 = (f32x4){scale, scale, scale, scale}, g1 = g0;
        if (gain) { g0 = *(const f32x4*)(gain + k0 + 8 * c) * scale; g1 = *(const f32x4*)(gain + k0 + 8 * c + 4) * scale; }
#pragma unroll
        for (int j = 0; j < 4; ++j) { const int n = (lane >> 3) + 8 * j; const LAS float* s = scr + (8 * c) * 33 + n;
            u32x4 o; o.x = cvt_pk_bf16(s[0 * 33] * g0.x, s[1 * 33] * g0.y); o.y = cvt_pk_bf16(s[2 * 33] * g0.z, s[3 * 33] * g0.w);
            o.z = cvt_pk_bf16(s[4 * 33] * g1.x, s[5 * 33] * g1.y); o.w = cvt_pk_bf16(s[6 * 33] * g1.z, s[7 * 33] * g1.w);
            if (mode == 4) {
                u32x2 o8; o8.x = pk4_fp8(s[0 * 33] * g0.x * 32.f, s[1 * 33] * g0.y * 32.f, s[2 * 33] * g0.z * 32.f, s[3 * 33] * g0.w * 32.f); o8.y = pk4_fp8(s[4 * 33] * g1.x * 32.f, s[5 * 33] * g1.y * 32.f, s[6 * 33] * g1.z * 32.f, s[7 * 33] * g1.w * 32.f);
                if (c0 + n < ncols) *(u32x2*)((unsigned char*)(dst + (size_t)row0 * ldd) + (size_t)(c0 + n) * ldd + k0 + 8 * c) = o8; }
            else if (c0 + n < ncols) *(u32x4*)(dst + (size_t)(row0 + map_row(c0 + n, mode, sub)) * ldd + k0 + 8 * c) = o; }
        asm volatile("s_waitcnt lgkmcnt(0)" ::: "memory");
    }
}
__device__ __forceinline__ void zero_rows(bf16* dst, int ldd, int row0, int nrows, int K, int gtid, int ngt) {
    const int per = K >> 3, n = nrows * per;
    for (int i = gtid; i < n; i += ngt) { const int r = i / per, k = (i - r * per) * 8; *(u32x4*)(dst + (size_t)(row0 + r) * ldd + k) = (u32x4){0u, 0u, 0u, 0u}; }
}

__device__ __forceinline__ float row_rstd(const f32x4 (&v)[4]) {
    float s = 0.f;
#pragma unroll
    for (int j = 0; j < 4; ++j) s += (v[j].x * v[j].x + v[j].y * v[j].y) + (v[j].z * v[j].z + v[j].w * v[j].w);
    return 1.0f / sqrtf(wave_sum(s) * (1.0f / D) + EPS);
}
__device__ __forceinline__ void store_row_bf16(bf16* orow, const f32x4 (&v)[4], float s, int lane) {
    u32x2* o8 = (u32x2*)orow + lane;
#pragma unroll
    for (int j = 0; j < 4; ++j) { u32x2 w; w.x = cvt_pk_bf16(v[j].x * s, v[j].y * s); w.y = cvt_pk_bf16(v[j].z * s, v[j].w * s); o8[64 * j] = w; }
}

__device__ __forceinline__ void load_row_bf16(const bf16* row, f32x4 (&v)[4], int lane) {
    const u32x2* p = (const u32x2*)row + lane;
#pragma unroll
    for (int j = 0; j < 4; ++j) { const u32x2 w = p[64 * j]; v[j] = (f32x4){bf2f(w.x & 0xffffu), bf2f(w.x >> 16), bf2f(w.y & 0xffffu), bf2f(w.y >> 16)}; }
}
namespace at {
typedef float f32x16 __attribute__((ext_vector_type(16)));
typedef short s16x4 __attribute__((ext_vector_type(4)));
typedef __bf16 bf16x2_t __attribute__((ext_vector_type(2)));
constexpr int VSLOT = 8192;
constexpr int L_K = 0, L_V = 49152, L_DL = L_V + 49152, L_WS = L_DL + 8192, L_END = L_WS + 8 * 256;
constexpr int BIGW = 1 << 24;
__device__ __forceinline__ int crow(int r, int hi) { return (r & 3) + 8 * (r >> 2) + 4 * hi; }
__device__ __forceinline__ void glds16(const void* gsrc, unsigned lds_dst) { unsigned keep;
    asm volatile("s_mov_b32 %0, m0\n\ts_mov_b32 m0, %2\n\ts_nop 0\n\tglobal_load_lds_dwordx4 %1, off\n\ts_mov_b32 m0, %0" : "=&s"(keep) : "v"(gsrc), "s"(lds_dst) : "memory"); }
__device__ __forceinline__ unsigned cvtpk(float lo, float hi) { f32x2 v = {lo, hi}; bf16x2_t b = __builtin_convertvector(v, bf16x2_t); return __builtin_bit_cast(unsigned, b); }
struct VFrag { s16x4 lo[4], hi[4]; };
template <int H> __device__ __forceinline__ void vload(VFrag& f, int vb) {
#pragma unroll
    for (int i = 0; i < 4; ++i) {
        asm volatile("ds_read_b64_tr_b16 %0,%1 offset:%c2" : "=&v"(f.lo[i]) : "v"(vb), "i"(H * 4096 + i * 1024) : "memory");
        asm volatile("ds_read_b64_tr_b16 %0,%1 offset:%c2" : "=&v"(f.hi[i]) : "v"(vb), "i"(H * 4096 + i * 1024 + 512) : "memory"); }
}
__device__ __forceinline__ void vwait(VFrag& f) {
    asm volatile("s_waitcnt lgkmcnt(0)" : "+v"(f.lo[0]), "+v"(f.lo[1]), "+v"(f.lo[2]), "+v"(f.lo[3]), "+v"(f.hi[0]), "+v"(f.hi[1]), "+v"(f.hi[2]), "+v"(f.hi[3]) :: "memory");
}
__device__ __forceinline__ f32x16 pvmma(f32x16 o, const VFrag& f, bf16x8 pa0, bf16x8 pa1, bf16x8 pa2, bf16x8 pa3) {
#define AT_PK(i) (bf16x8){f.lo[i][0], f.lo[i][1], f.lo[i][2], f.lo[i][3], f.hi[i][0], f.hi[i][1], f.hi[i][2], f.hi[i][3]}
    o = __builtin_amdgcn_mfma_f32_32x32x16_bf16(pa0, AT_PK(0), o, 0, 0, 0); o = __builtin_amdgcn_mfma_f32_32x32x16_bf16(pa1, AT_PK(1), o, 0, 0, 0);
    o = __builtin_amdgcn_mfma_f32_32x32x16_bf16(pa2, AT_PK(2), o, 0, 0, 0); o = __builtin_amdgcn_mfma_f32_32x32x16_bf16(pa3, AT_PK(3), o, 0, 0, 0);
#undef AT_PK
    return o;
}
struct Geo { int mode, b, r, rho, u; };
__device__ __forceinline__ int g_kt0(const Geo& g) { const int k = 4 * g.u - 2; return k > 0 ? k : 0; }
__device__ __forceinline__ int g_nt(const Geo& g) { return g.mode == 0 ? 4 * (g.u + 1) : (g.mode == 1 ? 4 * g.u + 4 - g_kt0(g) : 4); }
__device__ __forceinline__ int g_str(const Geo& g) { return g.mode == 0 ? 1 : (g.mode == 1 ? g.r : 16); }
__device__ __forceinline__ int g_qrow0(const Geo& g, int w) { return g.mode == 0 ? g.b * T + 256 * g.u + 32 * w : (g.mode == 1 ? g.b * T + g.rho + g.r * (256 * g.u + 32 * w) : g.b * T + 2 * g.rho + (w >> 2) + 512 * (w & 3)); }
__device__ __forceinline__ int g_qpos0(const Geo& g, int w) { return g.mode == 2 ? 1024 * (w >> 2) + 32 * (w & 3) : 256 * g.u + 32 * w; }
__device__ __forceinline__ int g_kpos0(const Geo& g, int t) { return g.mode == 0 ? 64 * t : (g.mode == 1 ? 64 * (g_kt0(g) + t) : 1024 * (t >> 1) + 64 * (t & 1)); }
__device__ __forceinline__ int g_krow0(const Geo& g, int t) { return g.mode == 0 ? g.b * T + 64 * t : (g.mode == 1 ? g.b * T + g.rho + g.r * 64 * (g_kt0(g) + t) : g.b * T + 2 * g.rho + (t >> 1) + 1024 * (t & 1)); }
struct Tens { const bf16* q0; const bf16* q1; int qp; const bf16* k0; int kp; const bf16* k1; const bf16* v; int vp; const float* dl; bf16* o; int op; float* lse; };

template <bool MLA, bool BIAS> __device__ __forceinline__ void attn_unit(LAS unsigned char* lds, const Tens& P, const Geo& g, int lane, int wid) {
    constexpr int ND0 = MLA ? 6 : 4; constexpr int KSLOT = MLA ? 12288 : 8192; constexpr bool NEGM = !MLA && !BIAS;
    const int r32 = lane & 31, hi = lane >> 5;
    const unsigned lds0 = (unsigned)(size_t)lds;
    LAS float* wsf = (LAS float*)(lds + L_WS) + wid * 64;
    const LAS float* dls = (const LAS float*)(lds + L_DL);
    const int NT = g_nt(g), str = g_str(g), W = (g.mode == 0) ? BIGW : 128;
    const int qrow0 = g_qrow0(g, wid), qpos0 = g_qpos0(g, wid);
#define AT_ISSUE(t, slot) do { const int kr0_ = g_krow0(g, (t)); \
        glds16(P.k0 + (size_t)(kr0_ + str * lane) * P.kp + 8 * wid, (unsigned)__builtin_amdgcn_readfirstlane(lds0 + L_K + (slot) * KSLOT + wid * 1024)); \
        if (MLA) glds16(P.k1 + (size_t)(kr0_ + str * lane) * 32 + 8 * (wid & 3), (unsigned)__builtin_amdgcn_readfirstlane(lds0 + L_K + (slot) * KSLOT + (8 + (wid & 3)) * 1024)); \
        glds16(P.v + (size_t)(kr0_ + str * (16 * (wid & 3) + (lane >> 2))) * P.vp + (wid >> 2) * 32 + (lane & 3) * 8, (unsigned)__builtin_amdgcn_readfirstlane(lds0 + L_V + (slot) * VSLOT + wid * 1024)); } while (0)
    const bool resident = !MLA && !BIAS && (g.mode != 0);
#define AT_SLOT(t) (resident ? (t) : ((t) & 3))
    if (resident) { for (int t = 0; t < NT; ++t) AT_ISSUE(t, t); } else { AT_ISSUE(0, 0); AT_ISSUE(1, 1); }
    bf16x8 qr[ND0];
    { const size_t qrow = (size_t)(qrow0 + str * r32);
#pragma unroll
      for (int d0 = 0; d0 < 4; ++d0) qr[d0] = *(const GAS bf16x8*)(P.q0 + qrow * P.qp + d0 * 16 + hi * 8);
      if (MLA) {
#pragma unroll
          for (int d0 = 4; d0 < ND0; ++d0) qr[d0] = *(const GAS bf16x8*)(P.q1 + qrow * P.qp + (d0 - 4) * 16 + hi * 8); } }
    if (P.dl) { const f32x4 dv = *((const GAS f32x4*)P.dl + (wid * 64 + lane)); *(LAS f32x4*)(lds + L_DL + (wid * 64 + lane) * 16) = dv; }
    float m = 0.f, l = 0.f; f32x16 o[2]; o[0] = f32x16{}; o[1] = f32x16{}; f32x16 negm = f32x16{};
    const int vb0 = (int)(lds0 + L_V) + ((lane >> 4) & 1) * 32 + (lane & 3) * 8 + (4 * hi + ((lane & 15) >> 2)) * 64;
#define AT_QK(t, P0, P1, USE, MREF) do { MREF = m; const int kpos0_ = g_kpos0(g, (t)); const int dmin_ = qpos0 - (kpos0_ + 63), dmax_ = qpos0 + 31 - kpos0_; \
        USE = !(dmax_ < 0 || dmin_ > W); \
        if (USE) { \
            const LAS unsigned char* kb_ = lds + L_K + AT_SLOT(t) * KSLOT + hi * 1024 + r32 * 16; bf16x8 kf_[4], kh_[4]; \
            _Pragma("unroll") for (int d0 = 0; d0 < 2; ++d0) { kf_[2 * d0] = *(const LAS bf16x8*)(kb_ + d0 * 2048); kf_[2 * d0 + 1] = *(const LAS bf16x8*)(kb_ + d0 * 2048 + 512); } \
            if (BIAS) { _Pragma("unroll") for (int g4 = 0; g4 < 4; ++g4) { const f32x4 a_ = *(const LAS f32x4*)(dls + kpos0_ + 8 * g4 + 4 * hi), c_ = *(const LAS f32x4*)(dls + kpos0_ + 32 + 8 * g4 + 4 * hi); \
                P0[4 * g4] = a_.x; P0[4 * g4 + 1] = a_.y; P0[4 * g4 + 2] = a_.z; P0[4 * g4 + 3] = a_.w; P1[4 * g4] = c_.x; P1[4 * g4 + 1] = c_.y; P1[4 * g4 + 2] = c_.z; P1[4 * g4 + 3] = c_.w; } } \
            __builtin_amdgcn_sched_barrier(0); \
            _Pragma("unroll") for (int d0 = 2; d0 < 4; ++d0) { kh_[2 * (d0 - 2)] = *(const LAS bf16x8*)(kb_ + d0 * 2048); kh_[2 * (d0 - 2) + 1] = *(const LAS bf16x8*)(kb_ + d0 * 2048 + 512); } \
            if (BIAS) { P0 = __builtin_amdgcn_mfma_f32_32x32x16_bf16(kf_[0], qr[0], P0, 0, 0, 0); P1 = __builtin_amdgcn_mfma_f32_32x32x16_bf16(kf_[1], qr[0], P1, 0, 0, 0); } \
            else if (NEGM) { P0 = __builtin_amdgcn_mfma_f32_32x32x16_bf16(kf_[0], qr[0], negm, 0, 0, 0); P1 = __builtin_amdgcn_mfma_f32_32x32x16_bf16(kf_[1], qr[0], negm, 0, 0, 0); } \
            else { P0 = __builtin_amdgcn_mfma_f32_32x32x16_bf16(kf_[0], qr[0], f32x16{}, 0, 0, 0); P1 = __builtin_amdgcn_mfma_f32_32x32x16_bf16(kf_[1], qr[0], f32x16{}, 0, 0, 0); } \
            P0 = __builtin_amdgcn_mfma_f32_32x32x16_bf16(kf_[2], qr[1], P0, 0, 0, 0); P1 = __builtin_amdgcn_mfma_f32_32x32x16_bf16(kf_[3], qr[1], P1, 0, 0, 0); \
            __builtin_amdgcn_sched_barrier(0); \
            P0 = __builtin_amdgcn_mfma_f32_32x32x16_bf16(kh_[0], qr[2], P0, 0, 0, 0); P1 = __builtin_amdgcn_mfma_f32_32x32x16_bf16(kh_[1], qr[2], P1, 0, 0, 0); \
            P0 = __builtin_amdgcn_mfma_f32_32x32x16_bf16(kh_[2], qr[3], P0, 0, 0, 0); P1 = __builtin_amdgcn_mfma_f32_32x32x16_bf16(kh_[3], qr[3], P1, 0, 0, 0); \
            if (MLA) { bf16x8 kg_[4];     \
                _Pragma("unroll") for (int d0 = 4; d0 < ND0; ++d0) { kg_[2 * (d0 - 4)] = *(const LAS bf16x8*)(kb_ + d0 * 2048); kg_[2 * (d0 - 4) + 1] = *(const LAS bf16x8*)(kb_ + d0 * 2048 + 512); } \
                _Pragma("unroll") for (int d0 = 4; d0 < ND0; ++d0) { \
                    P0 = __builtin_amdgcn_mfma_f32_32x32x16_bf16(kg_[2 * (d0 - 4)], qr[d0], P0, 0, 0, 0); P1 = __builtin_amdgcn_mfma_f32_32x32x16_bf16(kg_[2 * (d0 - 4) + 1], qr[d0], P1, 0, 0, 0); } } \
        } } while (0)
#define AT_MAX3(a, b, c) __builtin_fmaxf(__builtin_fmaxf((a), (b)), (c))
#define AT_STEP(t, PC0, PC1, UC, MC, PN0, PN1, UN, MN) do { \
        UN = false; \
        if ((t) + 1 < NT) AT_QK((t) + 1, PN0, PN1, UN, MN); \
        __builtin_amdgcn_sched_barrier(0); \
        if (UC) { \
            const int kpos0_ = g_kpos0(g, (t)); const int dmin_ = qpos0 - (kpos0_ + 63), dmax_ = qpos0 + 31 - kpos0_; \
            if (dmin_ < 0 || dmax_ > W) { const int dq_ = qpos0 + r32 - kpos0_ - 4 * hi; \
                _Pragma("unroll") for (int r = 0; r < 16; ++r) { const int d_ = dq_ - ((r & 3) + 8 * (r >> 2)); if (d_ < 0 || d_ > W) PC0[r] = -INFINITY; if (d_ - 32 < 0 || d_ - 32 > W) PC1[r] = -INFINITY; } } \
            float ra_ = AT_MAX3(PC0[0], PC0[1], PC1[0]), rb_ = AT_MAX3(PC0[2], PC0[3], PC1[1]); ra_ = AT_MAX3(ra_, PC1[2], PC1[3]); \
            _Pragma("unroll") for (int r = 4; r < 16; r += 4) { ra_ = AT_MAX3(ra_, PC0[r], PC0[r + 1]); rb_ = AT_MAX3(rb_, PC0[r + 2], PC0[r + 3]); ra_ = AT_MAX3(ra_, PC1[r], PC1[r + 1]); rb_ = AT_MAX3(rb_, PC1[r + 2], PC1[r + 3]); } \
            float rm_ = __builtin_fmaxf(ra_, rb_); \
            { auto rr_ = __builtin_amdgcn_permlane32_swap(__float_as_uint(rm_), __float_as_uint(rm_), false, false); rm_ = __builtin_fmaxf(__uint_as_float(rr_[0]), __uint_as_float(rr_[1])); } \
              \
            if (!NEGM) rm_ -= m; else rm_ -= (m - MC); \
            VFrag vf_; vload<0>(vf_, vb0 + AT_SLOT(t) * VSLOT);      \
            if (__builtin_expect(__any(rm_ > 8.0f), 0)) { const float dl_ = __builtin_fmaxf(rm_, 0.f); m += dl_; const float alpha_ = __builtin_amdgcn_exp2f(-dl_); l *= alpha_; \
                int lz_ = lane; asm volatile("" : "+v"(lz_));     \
                LAS float* wz_ = (LAS float*)(lds + L_WS) + wid * 64; if ((lz_ >> 5) == 0) wz_[lz_ & 31] = alpha_; \
                _Pragma("unroll") for (int r = 0; r < 16; ++r) { const float f_ = wz_[crow(r, lz_ >> 5)]; o[0][r] *= f_; o[1][r] *= f_; } \
                if (NEGM) { _Pragma("unroll") for (int r = 0; r < 16; ++r) negm[r] = -m; } } \
            const float sub_ = !NEGM ? m : (m - MC); float sacc_ = 0.f; \
            if (!NEGM || __any(sub_ != 0.f)) { _Pragma("unroll") for (int r = 0; r < 16; ++r) { PC0[r] = __builtin_amdgcn_exp2f(PC0[r] - sub_); PC1[r] = __builtin_amdgcn_exp2f(PC1[r] - sub_); sacc_ += PC0[r] + PC1[r]; } } \
            else { _Pragma("unroll") for (int r = 0; r < 16; ++r) { PC0[r] = __builtin_amdgcn_exp2f(PC0[r]); PC1[r] = __builtin_amdgcn_exp2f(PC1[r]); sacc_ += PC0[r] + PC1[r]; } } \
            l += sacc_; \
            const u32x4 w0_ = (u32x4){cvtpk(PC0[0], PC0[1]), cvtpk(PC0[2], PC0[3]), cvtpk(PC0[4], PC0[5]), cvtpk(PC0[6], PC0[7])}; \
            const u32x4 w1_ = (u32x4){cvtpk(PC0[8], PC0[9]), cvtpk(PC0[10], PC0[11]), cvtpk(PC0[12], PC0[13]), cvtpk(PC0[14], PC0[15])}; \
            const u32x4 w2_ = (u32x4){cvtpk(PC1[0], PC1[1]), cvtpk(PC1[2], PC1[3]), cvtpk(PC1[4], PC1[5]), cvtpk(PC1[6], PC1[7])}; \
            const u32x4 w3_ = (u32x4){cvtpk(PC1[8], PC1[9]), cvtpk(PC1[10], PC1[11]), cvtpk(PC1[12], PC1[13]), cvtpk(PC1[14], PC1[15])}; \
            vwait(vf_); o[0] = pvmma(o[0], vf_, __builtin_bit_cast(bf16x8, w0_), __builtin_bit_cast(bf16x8, w1_), __builtin_bit_cast(bf16x8, w2_), __builtin_bit_cast(bf16x8, w3_)); \
            __builtin_amdgcn_sched_barrier(0); vload<1>(vf_, vb0 + AT_SLOT(t) * VSLOT); \
            vwait(vf_); o[1] = pvmma(o[1], vf_, __builtin_bit_cast(bf16x8, w0_), __builtin_bit_cast(bf16x8, w1_), __builtin_bit_cast(bf16x8, w2_), __builtin_bit_cast(bf16x8, w3_)); \
        } \
        if (!resident) { asm volatile("s_waitcnt vmcnt(0) lgkmcnt(0)\n\ts_barrier" ::: "memory"); \
            if ((t) + 3 < NT) AT_ISSUE((t) + 3, ((t) + 3) & 3); } } while (0)
    f32x16 pa0, pa1, pb0, pb1; bool ua = false, ub = false; float mra = 0.f, mrb = 0.f;
    asm volatile("s_waitcnt vmcnt(0) lgkmcnt(0)\n\ts_barrier" ::: "memory");
    if (!resident) AT_ISSUE(2, 2);
    AT_QK(0, pa0, pa1, ua, mra);
    for (int t = 0; t < NT; t += 2) {
        AT_STEP(t, pa0, pa1, ua, mra, pb0, pb1, ub, mrb);
        AT_STEP(t + 1, pb0, pb1, ub, mrb, pa0, pa1, ua, mra);
    }
#undef AT_QK
#undef AT_STEP
#undef AT_MAX3
#undef AT_ISSUE
#undef AT_SLOT
    { auto rr = __builtin_amdgcn_permlane32_swap(__float_as_uint(l), __float_as_uint(l), false, false); l = __uint_as_float(rr[0]) + __uint_as_float(rr[1]); }
    if (hi == 0) wsf[32 + r32] = l;
    if (P.lse && hi == 0) ((GAS float*)P.lse)[(size_t)(qrow0 + str * r32) * 8] = m + log2f(l);
#pragma unroll
    for (int r = 0; r < 16; ++r) { const float rl = __builtin_amdgcn_rcpf(wsf[32 + crow(r, hi)]); GAS bf16* orow = (GAS bf16*)(P.o + (size_t)(qrow0 + str * crow(r, hi)) * P.op + r32);
        orow[0] = (bf16)(cvtpk(o[0][r] * rl, 0.f) & 0xffffu); orow[32] = (bf16)(cvtpk(o[1][r] * rl, 0.f) & 0xffffu); }
    asm volatile("s_waitcnt lgkmcnt(0)\n\ts_barrier" ::: "memory");
}
}

namespace fx {
using at::f32x16; using at::s16x4; using at::crow; using at::glds16; using at::cvtpk;
typedef short v4i16_t __attribute__((ext_vector_type(4)));
constexpr int NSLOT = 3, SLOTB = 8192, LDS_K = 0, LDS_V = NSLOT * SLOTB, LDS_WS = 2 * NSLOT * SLOTB, LDS_OST = LDS_WS + 8 * 256, LDS_DL = LDS_OST + 8 * 4096, LDS_END = LDS_DL + 8192;
typedef const LAS unsigned char* lptr;
__device__ __forceinline__ void cmask(f32x16& p0, f32x16& p1, int jb, int qrel, int hi) {
    const float NEG = -INFINITY; const int kb = 64 * jb + 4 * hi;
#pragma unroll
    for (int r = 0; r < 16; ++r) { const int kv = kb + (r & 3) + 8 * (r >> 2); if (kv > qrel) p0[r] = NEG; if (kv + 32 > qrel) p1[r] = NEG; }
}
__device__ __forceinline__ void kload8(bf16x8* kf, lptr kp) {
    kf[0] = *(const LAS bf16x8*)(kp);        kf[1] = *(const LAS bf16x8*)(kp + 512);  kf[2] = *(const LAS bf16x8*)(kp + 2048); kf[3] = *(const LAS bf16x8*)(kp + 2560);
    kf[4] = *(const LAS bf16x8*)(kp + 4096); kf[5] = *(const LAS bf16x8*)(kp + 4608); kf[6] = *(const LAS bf16x8*)(kp + 6144); kf[7] = *(const LAS bf16x8*)(kp + 6656);
}
__device__ __forceinline__ void kload2(bf16x8* kf, lptr kp, int j) { kf[2 * j] = *(const LAS bf16x8*)(kp + j * 2048); kf[2 * j + 1] = *(const LAS bf16x8*)(kp + j * 2048 + 512); }
__device__ __forceinline__ s16x4 vtr(lptr p) { return __builtin_bit_cast(s16x4, __builtin_amdgcn_ds_read_tr16_b64_v4i16((LAS v4i16_t*)p)); }
__device__ __forceinline__ bf16x8 mk_qx(float m, int hi) {
    const unsigned h = cvtpk(m, 0.f) & 0xffffu; const unsigned l = cvtpk(m - __uint_as_float(h << 16), 0.f) & 0xffffu;
    u32x4 w = (u32x4){0x3F803F80u, (h ^ 0x8000u) | ((l ^ 0x8000u) << 16), 0u, 0u}; if (hi) w = (u32x4){0u, 0u, 0u, 0u};
    return __builtin_bit_cast(bf16x8, w);
}
__device__ __forceinline__ void mk_kx(bf16x8& k0, bf16x8& k1, float d0, float d1, int hi) {
    const unsigned u = cvtpk(d0, d1); const unsigned v = cvtpk(d0 - __uint_as_float(u << 16), d1 - __uint_as_float(u & 0xffff0000u));
    u32x4 a = (u32x4){(u & 0xffffu) | (v << 16), 0x3F803F80u, 0u, 0u}, b = (u32x4){(u >> 16) | (v & 0xffff0000u), 0x3F803F80u, 0u, 0u};
    if (hi) { a = (u32x4){0u, 0u, 0u, 0u}; b = a; }
    k0 = __builtin_bit_cast(bf16x8, a); k1 = __builtin_bit_cast(bf16x8, b);
}
#define FX_MX3(a, b, c) __builtin_fmaxf(__builtin_fmaxf((a), (b)), (c))
#define FX_SBAR() __builtin_amdgcn_sched_barrier(0)
#define FX_WAIT_BAR(N) asm volatile("s_waitcnt vmcnt(" #N ") lgkmcnt(0)\n\ts_barrier" ::: "memory")
#define FX_MFMA(a, b, c) __builtin_amdgcn_mfma_f32_32x32x16_bf16(a, b, c, 0, 0, 0)
template <int THRL, int KP, int OP> __device__ __forceinline__ void fox_unit(LAS unsigned char* shm, const bf16* Qh, const bf16* Kh, const bf16* Vh, const float* dl, bf16* Oh, int qb, int lane_, int wid_) {
    int lane = lane_, wid = wid_; asm volatile("" : "+v"(lane), "+s"(wid));
    const int r32 = lane & 31, hi = lane >> 5; const int q0 = qb * 256;
    const bf16* Qw = Qh + (size_t)(q0 + wid * 32) * KP;
    const unsigned lds0 = (unsigned)(size_t)shm;
    LAS float* wsf = (LAS float*)(shm + LDS_WS) + wid * 64;
    int j0;
    { const float dq = ((const GAS float*)dl)[q0], de = ((const GAS float*)dl)[64 * (lane & 31) + 63];
      const unsigned far = (unsigned)__ballot(dq - de > 56.0f);
      j0 = far == 0xffffffffu ? 32 : __builtin_ctz(~far); j0 &= ~1; const int jmax = (q0 + 256) / 64 - 4; j0 = j0 < jmax ? j0 : jmax; j0 = __builtin_amdgcn_readfirstlane(j0); }
    const bf16* ksrc = Kh + (size_t)(64 * j0 + lane) * KP + wid * 8;
    const bf16* vsrc = Vh + (size_t)(64 * j0 + 16 * (wid & 3) + (lane >> 2)) * KP + (wid >> 2) * 32 + (lane & 3) * 8;
    const unsigned kdst = lds0 + LDS_K + wid * 1024, vdst = lds0 + LDS_V + wid * 1024;
#define FX_DMA_K(t, slot) glds16(ksrc + (size_t)(t) * 64 * KP, (unsigned)__builtin_amdgcn_readfirstlane(kdst + (slot)))
#define FX_DMA_V(t, slot) glds16(vsrc + (size_t)(t) * 64 * KP, (unsigned)__builtin_amdgcn_readfirstlane(vdst + (slot)))
    const int vb0 = (int)(lds0 + LDS_V) + ((lane >> 4) & 1) * 32 + (lane & 3) * 8 + (4 * hi + ((lane & 15) >> 2)) * 64;
    bf16x8 kf[8];
    const lptr kp0 = shm + LDS_K + hi * 1024 + r32 * 16; const lptr vp0 = shm + LDS_V + ((lane >> 4) & 1) * 32 + (lane & 3) * 8 + (4 * hi + ((lane & 15) >> 2)) * 64;
    const LAS float* dlt = (const LAS float*)(shm + LDS_DL) + 64 * j0 + r32;
    const int NT = (q0 + 256) / 64 - j0;
    FX_DMA_K(0, 0); FX_DMA_V(0, 0); FX_DMA_K(1, SLOTB);
    { const f32x4 dv = *((const GAS f32x4*)dl + (wid * 64 + lane)); *(LAS f32x4*)(shm + LDS_DL + (wid * 64 + lane) * 16) = dv; }
    bf16x8 qr[4];
#pragma unroll
    for (int d0 = 0; d0 < 4; ++d0) qr[d0] = *(const GAS bf16x8*)(Qw + (size_t)r32 * KP + d0 * 16 + hi * 8);
    float mhat = 0.f, l_reg = 0.f; f32x16 o[2]; o[0] = f32x16{}; o[1] = f32x16{};
    bf16x8 qx = mk_qx(0.f, hi);
    const int qrel = wid * 32 + r32;
#define FX_CMASK(P0, P1, t) do { const int jb_ = (t) - (NT - 4); if (jb_ >= 0) cmask(P0, P1, jb_, qrel, hi); } while (0)
    bool resc = false;
#define FX_RESC() do { if (resc) { asm volatile("s_waitcnt lgkmcnt(0)" ::: "memory"); \
        _Pragma("unroll") for (int d_ = 0; d_ < 2; ++d_) _Pragma("unroll") for (int r = 0; r < 16; ++r) o[d_][r] *= wsf[crow(r, hi)]; } } while (0)
    f32x16 pA0, pA1, pB0, pB1;
    int sl_prev = 0, sl_cur = 0, sl_next = SLOTB;
#define FX_ROT() do { sl_prev = sl_cur; sl_cur = sl_next; sl_next = (sl_next == (NSLOT - 1) * SLOTB) ? 0 : sl_next + SLOTB; } while (0)
    FX_DMA_K(2, 2 * SLOTB);
    FX_WAIT_BAR(3);
    { kload8(kf, kp0); bf16x8 kx0, kx1; mk_kx(kx0, kx1, dlt[0], dlt[32], hi);
      pA0 = FX_MFMA(kf[0], qr[0], f32x16{}); pA1 = FX_MFMA(kf[1], qr[0], f32x16{});
#pragma unroll
      for (int d0 = 1; d0 < 4; ++d0) { pA0 = FX_MFMA(kf[2 * d0], qr[d0], pA0); pA1 = FX_MFMA(kf[2 * d0 + 1], qr[d0], pA1); }
      pA0 = FX_MFMA(kx0, qx, pA0); pA1 = FX_MFMA(kx1, qx, pA1); }
    FX_CMASK(pA0, pA1, 0);
    { float a = FX_MX3(pA0[0], pA0[1], pA1[0]), b = FX_MX3(pA0[2], pA0[3], pA1[1]); a = FX_MX3(a, pA1[2], pA1[3]);
#pragma unroll
      for (int r = 4; r < 16; r += 4) { a = FX_MX3(a, pA0[r], pA0[r + 1]); b = FX_MX3(b, pA0[r + 2], pA0[r + 3]); a = FX_MX3(a, pA1[r], pA1[r + 1]); b = FX_MX3(b, pA1[r + 2], pA1[r + 3]); }
      float rm = __builtin_fmaxf(a, b); { auto rr = __builtin_amdgcn_permlane32_swap(__float_as_uint(rm), __float_as_uint(rm), false, false); rm = __builtin_fmaxf(__uint_as_float(rr[0]), __uint_as_float(rr[1])); }
      mhat = rm; qx = mk_qx(mhat, hi);
#pragma unroll
      for (int r = 0; r < 16; ++r) { pA0[r] = __builtin_amdgcn_exp2f(pA0[r] - rm); pA1[r] = __builtin_amdgcn_exp2f(pA1[r] - rm); } }
    FX_WAIT_BAR(0);
    FX_DMA_K(3, 0); FX_DMA_V(1, SLOTB);
    FX_ROT();
    kload8(kf, kp0 + sl_cur);
    FX_WAIT_BAR(2);
    s16x4 vlo[8], vhi[8]; u32x4 pw0, pw1, pw2, pw3;
#define FX_PKW(P, B) cvtpk(P[B], P[B + 1])
#define FX_PAF(k) __builtin_bit_cast(bf16x8, pw##k)
#define FX_VFR(i) (bf16x8){vlo[i][0], vlo[i][1], vlo[i][2], vlo[i][3], vhi[i][0], vhi[i][1], vhi[i][2], vhi[i][3]}
#define FX_PIN(x) asm volatile("" : "+v"(x))
#define FX_GAPA(MF, A0, A1, A2, A3, W0, W1, PW) do { MF; sacc += A0; sacc += A1; sacc += A2; sacc += A3; FX_PIN(sacc); W0; W1; FX_PIN(PW); FX_SBAR(); } while (0)
#define FX_EX(v) __builtin_amdgcn_exp2f(v)
#define FX_GAPB(MF, X, B) do { MF; X[B] = FX_EX(X[B]); X[B + 1] = FX_EX(X[B + 1]); X[B + 2] = FX_EX(X[B + 2]); X[B + 3] = FX_EX(X[B + 3]); FX_PIN(X); FX_SBAR(); } while (0)
#define FX_VRD(i) do { vlo[i] = vtr(vp_ + (((i) >> 2) * 4096 + ((i) & 3) * 1024)); vhi[i] = vtr(vp_ + (((i) >> 2) * 4096 + ((i) & 3) * 1024 + 512)); } while (0)
#define FX_KRD(G, j) do { if (G) { kload2(kf, kp0 + sl_next, j); FX_SBAR(); } } while (0)
#define FX_STEP(C0, C1, P0, P1, t, GK, GV, GL) do { FX_SBAR(); \
        const lptr vp_ = vp0 + sl_prev; const float d0_ = dlt[64 * (t)], d1_ = dlt[64 * (t) + 32]; \
        FX_VRD(0); FX_SBAR(); float sacc = (P0[0] + P0[1]); \
        FX_GAPA(C0 = FX_MFMA(kf[0], qr[0], f32x16{}), P0[2], P0[3], P0[4], P0[5],     pw0[0] = FX_PKW(P0, 0), pw0[1] = FX_PKW(P0, 2), pw0); \
        FX_VRD(4); FX_SBAR(); FX_GAPA(C1 = FX_MFMA(kf[1], qr[0], f32x16{}), P0[6], P0[7], P0[8], P0[9],     pw0[2] = FX_PKW(P0, 4), pw0[3] = FX_PKW(P0, 6), pw0); \
        FX_VRD(1); FX_SBAR(); FX_GAPA(C0 = FX_MFMA(kf[2], qr[1], C0),   P0[10], P0[11], P0[12], P0[13], pw1[0] = FX_PKW(P0, 8), pw1[1] = FX_PKW(P0, 10), pw1); \
        FX_VRD(5); FX_SBAR(); FX_GAPA(C1 = FX_MFMA(kf[3], qr[1], C1),   P0[14], P0[15], P1[0], P1[1],   pw1[2] = FX_PKW(P0, 12), pw1[3] = FX_PKW(P0, 14), pw1); \
        FX_VRD(2); FX_SBAR(); FX_GAPA(C0 = FX_MFMA(kf[4], qr[2], C0),   P1[2], P1[3], P1[4], P1[5],     pw2[0] = FX_PKW(P1, 0), pw2[1] = FX_PKW(P1, 2), pw2); \
        FX_VRD(6); FX_SBAR(); FX_GAPA(C1 = FX_MFMA(kf[5], qr[2], C1),   P1[6], P1[7], P1[8], P1[9],     pw2[2] = FX_PKW(P1, 4), pw2[3] = FX_PKW(P1, 6), pw2); \
        FX_VRD(3); FX_SBAR(); FX_GAPA(C0 = FX_MFMA(kf[6], qr[3], C0),   P1[10], P1[11], P1[12], P1[13], pw3[0] = FX_PKW(P1, 8), pw3[1] = FX_PKW(P1, 10), pw3); \
        FX_VRD(7); FX_SBAR(); FX_GAPA(C1 = FX_MFMA(kf[7], qr[3], C1),   P1[14], P1[15], 0.f, 0.f,       pw3[2] = FX_PKW(P1, 12), pw3[3] = FX_PKW(P1, 14), pw3); \
        l_reg += sacc; \
        { bf16x8 kx0_, kx1_; mk_kx(kx0_, kx1_, d0_, d1_, hi); FX_PIN(kx0_); FX_PIN(kx1_); FX_SBAR(); C0 = FX_MFMA(kx0_, qx, C0); C1 = FX_MFMA(kx1_, qx, C1); FX_SBAR(); }     \
        if (GK) { FX_DMA_K((t) + 3, sl_cur); } if (GV) { FX_DMA_V((t) + 1, sl_next); } \
        FX_CMASK(C0, C1, t); \
        { float a = FX_MX3(C0[0], C0[1], C1[0]), b = FX_MX3(C0[2], C0[3], C1[1]); a = FX_MX3(a, C1[2], C1[3]); \
          _Pragma("unroll") for (int r = 4; r < 16; r += 4) { a = FX_MX3(a, C0[r], C0[r + 1]); b = FX_MX3(b, C0[r + 2], C0[r + 3]); a = FX_MX3(a, C1[r], C1[r + 1]); b = FX_MX3(b, C1[r + 2], C1[r + 3]); } \
          float rm = __builtin_fmaxf(a, b); { auto rr = __builtin_amdgcn_permlane32_swap(__float_as_uint(rm), __float_as_uint(rm), false, false); rm = __builtin_fmaxf(__uint_as_float(rr[0]), __uint_as_float(rr[1])); } \
          resc = false; \
          if (__builtin_expect(__any(rm > (float)THRL), 0)) { const float dl_ = __builtin_fmaxf(rm, 0.f); mhat += dl_; \
              _Pragma("unroll") for (int r = 0; r < 16; ++r) { C0[r] -= dl_; C1[r] -= dl_; } \
              qx = mk_qx(mhat, hi); \
              const float f = __builtin_amdgcn_exp2f(-dl_); l_reg *= f; if (hi == 0) wsf[r32] = f; resc = true; } } \
        FX_SBAR(); \
        FX_GAPB(o[0] = FX_MFMA(FX_PAF(0), FX_VFR(0), o[0]), C0, 0); \
        FX_GAPB(o[1] = FX_MFMA(FX_PAF(0), FX_VFR(4), o[1]), C0, 4); \
        FX_KRD(GL, 0); FX_GAPB(o[0] = FX_MFMA(FX_PAF(1), FX_VFR(1), o[0]), C0, 8); \
        FX_KRD(GL, 1); FX_GAPB(o[1] = FX_MFMA(FX_PAF(1), FX_VFR(5), o[1]), C0, 12); \
        FX_KRD(GL, 2); FX_GAPB(o[0] = FX_MFMA(FX_PAF(2), FX_VFR(2), o[0]), C1, 0); \
        FX_KRD(GL, 3); FX_GAPB(o[1] = FX_MFMA(FX_PAF(2), FX_VFR(6), o[1]), C1, 4); \
        FX_GAPB(o[0] = FX_MFMA(FX_PAF(3), FX_VFR(3), o[0]), C1, 8); \
        FX_GAPB(o[1] = FX_MFMA(FX_PAF(3), FX_VFR(7), o[1]), C1, 12); \
    } while (0)
    int t = 1;
#undef FX_CMASK
#define FX_CMASK(P0, P1, t) do {} while (0)
    for (; t + 5 < NT; t += 2) {
        FX_STEP(pB0, pB1, pA0, pA1, t, true, true, true);     FX_WAIT_BAR(2); FX_RESC(); FX_ROT();
        FX_STEP(pA0, pA1, pB0, pB1, t + 1, true, true, true); FX_WAIT_BAR(2); FX_RESC(); FX_ROT();
    }
#undef FX_CMASK
#define FX_CMASK(P0, P1, t) do { const int jb_ = (t) - (NT - 4); if (jb_ >= 0) cmask(P0, P1, jb_, qrel, hi); } while (0)
#define FX_ENDW(tt) do { if ((tt) + 3 < NT) { FX_WAIT_BAR(2); } else if ((tt) + 2 < NT) { FX_WAIT_BAR(1); } else { FX_WAIT_BAR(0); } } while (0)
    for (; t + 1 < NT; t += 2) {
        FX_STEP(pB0, pB1, pA0, pA1, t, (t + 3 < NT), (t + 1 < NT), (t + 1 < NT));         FX_ENDW(t);     FX_RESC(); FX_ROT();
        FX_STEP(pA0, pA1, pB0, pB1, t + 1, (t + 4 < NT), (t + 2 < NT), (t + 2 < NT));     FX_ENDW(t + 1); FX_RESC(); FX_ROT();
    }
    FX_STEP(pB0, pB1, pA0, pA1, NT - 1, false, false, false); FX_RESC();
    { float sacc = pB0[0] + pB0[1];
#pragma unroll
      for (int r = 2; r < 16; ++r) sacc += pB0[r];
#pragma unroll
      for (int r = 0; r < 16; ++r) sacc += pB1[r];
      l_reg += sacc;
      pw0 = (u32x4){FX_PKW(pB0, 0), FX_PKW(pB0, 2), FX_PKW(pB0, 4), FX_PKW(pB0, 6)}; pw1 = (u32x4){FX_PKW(pB0, 8), FX_PKW(pB0, 10), FX_PKW(pB0, 12), FX_PKW(pB0, 14)};
      pw2 = (u32x4){FX_PKW(pB1, 0), FX_PKW(pB1, 2), FX_PKW(pB1, 4), FX_PKW(pB1, 6)}; pw3 = (u32x4){FX_PKW(pB1, 8), FX_PKW(pB1, 10), FX_PKW(pB1, 12), FX_PKW(pB1, 14)};
      FX_SBAR();
      at::VFrag vf_; at::vload<0>(vf_, vb0 + sl_cur); at::vwait(vf_); o[0] = at::pvmma(o[0], vf_, FX_PAF(0), FX_PAF(1), FX_PAF(2), FX_PAF(3));
      FX_SBAR(); at::vload<1>(vf_, vb0 + sl_cur); at::vwait(vf_); o[1] = at::pvmma(o[1], vf_, FX_PAF(0), FX_PAF(1), FX_PAF(2), FX_PAF(3)); }
    { auto rr = __builtin_amdgcn_permlane32_swap(__float_as_uint(l_reg), __float_as_uint(l_reg), false, false); l_reg = __uint_as_float(rr[0]) + __uint_as_float(rr[1]); }
    if (hi == 0) wsf[32 + r32] = l_reg; asm volatile("s_waitcnt lgkmcnt(0)" ::: "memory");
    { LAS bf16* stg = (LAS bf16*)(shm + LDS_OST) + wid * 2048;
#pragma unroll
      for (int r = 0; r < 16; ++r) { const float rl = __builtin_amdgcn_rcpf(wsf[32 + crow(r, hi)]); const int orow = crow(r, hi);
          stg[orow * 64 + r32] = (bf16)(cvtpk(o[0][r] * rl, 0.f) & 0xffffu); stg[orow * 64 + 32 + r32] = (bf16)(cvtpk(o[1][r] * rl, 0.f) & 0xffffu); }
      asm volatile("s_waitcnt lgkmcnt(0)" ::: "memory");
      bf16* Ow = Oh + (size_t)(q0 + wid * 32) * OP;
#pragma unroll
      for (int i = 0; i < 4; ++i) { const int row = i * 8 + (lane >> 3), ch = lane & 7; const u32x4 v = *(const LAS u32x4*)(stg + row * 64 + ch * 8); *(GAS u32x4*)(Ow + (size_t)row * OP + ch * 8) = v; } }
    asm volatile("s_waitcnt lgkmcnt(0)\n\ts_barrier" ::: "memory");
#undef FX_DMA_K
#undef FX_DMA_V
#undef FX_CMASK
#undef FX_RESC
#undef FX_ROT
#undef FX_PKW
#undef FX_PAF
#undef FX_VFR
#undef FX_PIN
#undef FX_GAPA
#undef FX_GAPB
#undef FX_EX
#undef FX_VRD
#undef FX_KRD
#undef FX_STEP
#undef FX_ENDW
}
#undef FX_SBAR
#undef FX_MX3
#undef FX_WAIT_BAR
#undef FX_MFMA
}

template <unsigned MASK> __global__ void __launch_bounds__(NTHR, 2) mk_fwd(Args args) {
    extern __shared__ __attribute__((aligned(16))) unsigned char lds_raw[];
    LAS unsigned char* lds = (LAS unsigned char*)lds_raw;
    volatile LAS unsigned* MISC = (volatile LAS unsigned*)(lds + MISC_OFF);
    const int tid0 = threadIdx.x; const int wave0 = __builtin_amdgcn_readfirstlane(tid0 >> 6);
    const int G = gridDim.x, bx0 = blockIdx.x;
    const int NGW = G * NWAVES, NGT = G * NTHR;
    unsigned char* ws0 = args.ws;
    unsigned* ctl = (unsigned*)(ws0 + WS_CTL);
    for (int u = tid0; u < (LDS_BYTES - MISC_OFF) / 4; u += NTHR) ((LAS unsigned*)(lds + MISC_OFF))[u] = 0u;
    __syncthreads();
    XcdBarrier bar; bar.bar = ctl + CW_BAR; bar.x = 0; bar.st = nullptr;
    if (args.fused) bar = xcd_barrier_post(ctl + CW_BAR, MISC + 8);
#define SEAM() do { if (args.fused) { XcdBarrier b_ = bar; asm volatile("" : "+s"(b_.bar)); xcd_barrier(b_, tid == 0); } } while (0)
#define ARRIVE() do { if (args.fused) { XcdBarrier b_ = bar; asm volatile("" : "+s"(b_.bar)); xcd_barrier_arrive(b_, tid == 0); } } while (0)
#define WAIT() do { if (args.fused) { XcdBarrier b_ = bar; asm volatile("" : "+s"(b_.bar)); xcd_barrier_wait(b_, tid == 0); } } while (0)
#define SEAMD(k) do { if (L == 1 && args.fused) { ARRIVE(); { LAS float* scr = (LAS float*)lds + wave * (64 * 33); int jid = 40 + (k); const float* gf2_ = args.in[I_FFNN] + 2 * D; bf16* wgu2_ = (bf16*)(ws + WS_WGU) + (size_t)2 * DFF * D; \
        if ((k) < 2) { CONV(((k) ? args.in[I_FU] : args.in[I_FG]) + (size_t)D * DFF, DFF, D, 0, DFF, wgu2_, D, 0, 1, (k) ? 4 : 0, gf2_, 1.f); } \
        else { CONV(args.in[I_FD] + (size_t)DFF * D, D, DFF, 0, D, (bf16*)(ws + WS_WDN) + (size_t)D * DFF, DFF, 0, 4, 0, nullptr, 1.f); } } WAIT(); } else SEAM(); } while (0)
#define SEAMF(cond, e) do { if ((cond) && args.fused) { ARRIVE(); { LAS float* scr = (LAS float*)lds + wave * (64 * 33); int jid = 3 * (e); const int jm_ = L >> 1; const float* gf3_ = args.in[I_FFNN] + (2 * jm_ + 1) * D; \
        bf16* wgu_ = (bf16*)(ws + WS_WEGU) + (size_t)(e) * 2 * DFE * D; \
        CONV(args.in[I_EG] + (size_t)(jm_ * NEXP + (e)) * D * DFE, DFE, D, 0, DFE, wgu_, D, 0, 1, 0, gf3_, 1.f); \
        CONV(args.in[I_EU] + (size_t)(jm_ * NEXP + (e)) * D * DFE, DFE, D, 0, DFE, wgu_, D, 0, 1, 4, gf3_, 1.f); \
        CONV(args.in[I_ED] + (size_t)(jm_ * NEXP + (e)) * DFE * D, D, DFE, 0, D, (bf16*)(ws + WS_WEDN) + (size_t)(e) * D * DFE, DFE, 0, 0, 0, nullptr, 1.f); } WAIT(); } else SEAM(); } while (0)
    const int lo = args.ph_lo, hi = args.ph_hi;
#define IN(k) (((MASK >> (k)) & 1u) && lo <= (k) && (k) < hi)
#define REPEAT(k) for (int rep_ = 0; rep_ < 1 + (int)((DBL_MASK >> (k)) & 1u); ++rep_)

#define PHASE_BEGIN \
    unsigned char* ws = ws0; asm volatile("" : "+s"(ws)); int bx = bx0; asm volatile("" : "+s"(bx)); float* X = args.out; asm volatile("" : "+s"(X)); \
    ws = (unsigned char*)(GAS unsigned char*)ws; X = (float*)(GAS float*)X;     \
    int lane; asm volatile("v_mbcnt_lo_u32_b32 %0, -1, 0\n\tv_mbcnt_hi_u32_b32 %0, -1, %0" : "=v"(lane)); int wave = wave0; asm volatile("" : "+s"(wave)); const int tid = wave * 64 + lane; (void)tid; \
    const int gw = bx * NWAVES + wave, gtid = bx * NTHR + tid; (void)gw; (void)gtid; \
    bf16* HB = (bf16*)(ws + WS_HB); bf16* PROJ = (bf16*)(ws + WS_PROJ); float* MISCF = (float*)(ws + WS_MISCF); \
    bf16* QC = (bf16*)(ws + WS_QC); bf16* KVC = (bf16*)(ws + WS_KVC); bf16* KR = (bf16*)(ws + WS_KR); float* DL = (float*)(ws + WS_DL); \
    float* RSTD = (float*)(ws + WS_RSTD); bf16* OALL = (bf16*)(ws + WS_OALL); bf16* MERGED = (bf16*)(ws + WS_MERGED); \
    f32x2* CS64 = (f32x2*)(ws + WS_CS64); f32x2* CS32 = (f32x2*)(ws + WS_CS32); \
    bf16* HID = (bf16*)(ws + WS_HID); bf16* XG = (bf16*)(ws + WS_XG); bf16* PB = (bf16*)(ws + WS_PB); bf16* PP = (bf16*)(ws + WS_PP); \
    float* FZ = (float*)(ws + WS_FZ); float* SSC = (float*)(ws + WS_SSC); (void)FZ; (void)SSC; \
    float* SSP_E = (float*)(ws + WS_SSP); float* SSP_G = SSP_E + (size_t)M * 16; float* SSP_H = SSP_G + (size_t)M * 16; float* RSG = (float*)(ws + WS_RSG); bf16* XB = HB; bf16* XBN = (bf16*)(ws + WS_XBN); (void)SSP_E; (void)SSP_G; (void)SSP_H; (void)RSG; (void)XB; (void)XBN; \
    unsigned* ROUTE = (unsigned*)(ws + WS_ROUTE); const int* POS = (const int*)args.in[I_POS]; \
    (void)HB; (void)PROJ; (void)MISCF; (void)QC; (void)KVC; (void)KR; (void)DL; (void)RSTD; (void)OALL; (void)MERGED; (void)CS64; (void)CS32; (void)HID; (void)XG; (void)PB; (void)PP; (void)ROUTE; (void)POS; (void)X;
#define MOE_CUM_ASSIGN { int c_ = 0; _Pragma("unroll") for (int e = 0; e < 8; ++e) { MO.cum[e] = c_; c_ += (int)((__builtin_amdgcn_readfirstlane(__hip_atomic_load(cnt + e, __ATOMIC_RELAXED, __HIP_MEMORY_SCOPE_AGENT)) + 255u) >> 8); } MO.cum[8] = c_; MO.G = G; MO.c = bx; }
#define MOE_CUM \
    pg8::MoeOrder MO; { int c_ = 0; _Pragma("unroll") for (int e = 0; e < 8; ++e) { MO.cum[e] = c_; c_ += (int)((__builtin_amdgcn_readfirstlane(__hip_atomic_load(cnt + e, __ATOMIC_RELAXED, __HIP_MEMORY_SCOPE_AGENT)) + 255u) >> 8); } MO.cum[8] = c_; MO.G = G; MO.c = bx; }

    if (IN(0) && args.l_lo == 0) REPEAT(0) {
        PHASE_BEGIN
        LAS float* scr = (LAS float*)lds + wave * (64 * 33);
        int jid = 0;
#define CONV(src, lds_, K, col0, ncols, dst, ldd, row0, mode, sub, gain, scale) do { conv_items(scr, src, lds_, K, col0, ncols, dst, ldd, row0, mode, sub, gain, scale, (gw + jid * 397) % NGW, NGW, lane); ++jid; } while (0)
        for (int L = 0; L < DEPTH; ++L) {
            const float* win = args.in[I_WIN] + (size_t)L * D * IN_W; const float* gm = args.in[I_MIXN] + L * D;
            bf16* wt = (bf16*)(ws + WS_WIN) + (size_t)L * NPROJ * D;
            CONV(win, IN_W, D, S_FQ, 384, wt, D, C_FQ, 0, 0, gm, QS);
            CONV(win, IN_W, D, S_FK, 768, wt, D, C_FK, 0, 0, gm, 1.f);
            CONV(win, IN_W, D, S_DQ, 384, wt, D, C_DQ, 2, 0, gm, QS);
            CONV(win, IN_W, D, S_DK, 384, wt, D, C_DK, 2, 0, gm, 1.f);
            CONV(win, IN_W, D, S_DV, 384, wt, D, C_DV, 0, 0, gm, 1.f);
            CONV(win, IN_W, D, S_CQ, 512, wt, D, C_CQ, 0, 0, gm, 1.f);
            CONV(win, IN_W, D, S_G, 3072, wt, D, C_G, 4, 0, gm, 1.f);
            CONV(win, IN_W, D, S_KR, 32, wt, D, C_MISC, 3, 0, gm, 1.f);
            CONV(win, IN_W, D, S_FZ, 6, wt, D, C_MISC + 32, 0, 0, gm, 1.f);
            zero_rows(wt, D, C_MISC + 38, NPROJ - (C_MISC + 38), D, gtid, NGT);
            const float* wuq = args.in[I_WUQ] + (size_t)L * 256 * 384; const float* gq = args.in[I_QN] + L * 256;
            const float* wukv = args.in[I_WUKV] + (size_t)L * 256 * 512; const float* gkv = args.in[I_KVN] + L * 256;
            bf16* wup = (bf16*)(ws + WS_WUQ) + (size_t)L * 1024 * 256;
            for (int h = 0; h < 4; ++h) {
                CONV(wuq, 384, 256, h * 96, 64, wup, 256, h * 64, 0, 0, gq, MS);
                CONV(wuq, 384, 256, h * 96 + 64, 32, wup, 256, 256 + h * 32, 3, 0, gq, MS);
                CONV(wukv, 512, 256, h * 128, 64, wup, 256, 512 + h * 64, 0, 0, gkv, 1.f);
                CONV(wukv, 512, 256, h * 128 + 64, 64, wup, 256, 768 + h * 64, 0, 0, gkv, 1.f);
            }
            zero_rows(wup, 256, 384, 128, 256, gtid, NGT);
            bf16* wbr = (bf16*)(ws + WS_WBR) + (size_t)L * D * D;
            CONV(args.in[I_BRF] + (size_t)L * 384 * D, D, 384, 0, D, wbr, D, 0, 0, 0, nullptr, 1.f);
            CONV(args.in[I_BRD] + (size_t)L * 384 * D, D, 384, 0, D, wbr + 384, D, 0, 0, 0, nullptr, 1.f);
            CONV(args.in[I_BRM] + (size_t)L * 256 * D, D, 256, 0, D, wbr + 768, D, 0, 0, 0, nullptr, 1.f);
            CONV(args.in[I_WOUT] + (size_t)L * D * D, D, D, 0, D, (bf16*)(ws + WS_WOUT) + (size_t)L * D * D, D, 0, 4, 0, nullptr, 1.f);
            const float* gf = args.in[I_FFNN] + L * D; const int j = L >> 1;
            if ((L & 1) == 0 && !(L == 2 && args.fused)) {
                bf16* wgu = (bf16*)(ws + WS_WGU) + (size_t)j * 2 * DFF * D;
                CONV(args.in[I_FG] + (size_t)j * D * DFF, DFF, D, 0, DFF, wgu, D, 0, 1, 0, gf, 1.f);
                CONV(args.in[I_FU] + (size_t)j * D * DFF, DFF, D, 0, DFF, wgu, D, 0, 1, 4, gf, 1.f);
                CONV(args.in[I_FD] + (size_t)j * DFF * D, D, DFF, 0, D, (bf16*)(ws + WS_WDN) + (size_t)j * D * DFF, DFF, 0, 4, 0, nullptr, 1.f);
            } else if (L == 1 && !args.fused) {
                for (int e = 0; e < NEXP; ++e) {
                    bf16* wgu = (bf16*)(ws + WS_WEGU) + (size_t)e * 2 * DFE * D;
                    CONV(args.in[I_EG] + (size_t)(j * NEXP + e) * D * DFE, DFE, D, 0, DFE, wgu, D, 0, 1, 0, gf, 1.f);
                    CONV(args.in[I_EU] + (size_t)(j * NEXP + e) * D * DFE, DFE, D, 0, DFE, wgu, D, 0, 1, 4, gf, 1.f);
                    CONV(args.in[I_ED] + (size_t)(j * NEXP + e) * DFE * D, D, DFE, 0, D, (bf16*)(ws + WS_WEDN) + (size_t)e * D * DFE, DFE, 0, 0, 0, nullptr, 1.f);
                }
            }
            CONV(args.in[I_WPG] + (size_t)L * D * D, D, D, 0, D, (bf16*)(ws + WS_WPG) + (size_t)L * D * D, D, 0, 4, 0, args.in[I_PLEN] + L * D, 1.f);
            CONV(args.in[I_WPP] + (size_t)L * 256 * D, D, 256, 0, D, (bf16*)(ws + WS_WPP) + (size_t)L * D * D, D, 0, 0, 0, nullptr, 1.f);
        }
        for (int r = gw; r < M; r += NGW) { const f32x4* xs = (const f32x4*)(args.in[I_X] + (size_t)r * D) + lane; f32x4 v[4]; float s_ = 0.f;
#pragma unroll
            for (int j = 0; j < 4; ++j) { v[j] = xs[64 * j]; s_ += (v[j].x * v[j].x + v[j].y * v[j].y) + (v[j].z * v[j].z + v[j].w * v[j].w); }
            store_row_bf16(XBN + (size_t)r * D, v, 1.0f, lane); const float ss = wave_sum(s_);
            { unsigned* o4 = (unsigned*)((unsigned char*)MERGED + (size_t)r * D) + lane;
#pragma unroll
              for (int j = 0; j < 4; ++j) o4[64 * j] = pk4_fp8(v[j].x, v[j].y, v[j].z, v[j].w); }
            if (lane < 16) SSP_H[(size_t)r * 16 + lane] = (lane == 0) ? ss : 0.f; }
        { const f32x4* ps = (const f32x4*)args.in[I_P]; bf16* PBALL = (bf16*)(ws + WS_PBALL);
          for (int i = gtid; i < DEPTH * M * 64; i += NGT) { const int Lp = i / (M * 64), rem = i - Lp * (M * 64), row = rem >> 6, q = rem & 63; const f32x4 a = ps[i];
              u32x2 w; w.x = cvt_pk_bf16(a.x, a.y); w.y = cvt_pk_bf16(a.z, a.w); *(u32x2*)(PBALL + (size_t)row * D + Lp * 256 + 4 * q) = w; } }
        for (int i = gtid; i < M * 32; i += NGT) { const int row = i >> 5, j = i & 31; const float invf = powf(10000.0f, -(float)j / 32.0f); const float ang = (float)POS[row] * invf; float s, c; sincosf(ang, &s, &c); CS64[i] = (f32x2){c, s}; }
        for (int i = gtid; i < M * 16; i += NGT) { const int row = i >> 4, j = i & 15; const float invf = powf(10000.0f, -(float)j / 16.0f); const float ang = (float)POS[row] * invf; float s, c; sincosf(ang, &s, &c); CS32[i] = (f32x2){c, s}; }
        SEAM();
    }

    for (int L = args.l_lo; L < args.l_hi; ++L) {
        const int jl = L >> 1; const bool moe = (L & 1) != 0;
        unsigned* cnt = ctl + CW_CNT + 64 * jl;
        if (IN(2)) REPEAT(2) {
            PHASE_BEGIN
            { pg8::Gemm g{XBN, (const bf16*)(ws + WS_WIN) + (size_t)L * NPROJ * D, D, D}; pg8::SubsetOrder<false> S; S.init(M, 12 * 256, D, G, bx, D, D); S.first = 0; S.alt = 23;
              pg8::EpiProj3 E{PROJ, KR, FZ, SSC, SSP_H, CS64, CS32}; pg8::gemm_phase(lds, g, S, E, tid); }
            ARRIVE();
            { pg8::Gemm g{MERGED, (const bf16*)(ws + WS_WIN) + (size_t)L * NPROJ * D + (size_t)C_G * D, D / 2, D / 2}; pg8::SubsetOrder<true> S; S.init(M, 12 * 256, D / 2, G, bx, D / 2, D / 2); S.first = 0; S.alt = -1;
              pg8::EpiGate EG{PROJ, SSP_H, 1.0f / 32.0f}; pg8::gemm_phase(lds, g, S, EG, tid); }
            WAIT();
        }
        if (IN(4)) REPEAT(4) {
            PHASE_BEGIN
            { pg8::Gemm g{PROJ + C_CQ, (const bf16*)(ws + WS_WUQ) + (size_t)L * 1024 * 256, NPROJ, 256}; pg8::UpOrder S{G, bx};
              pg8::EpiUp E{QC, KVC, SSC, CS32}; pg8::gemm_phase(lds, g, S, E, tid); }
            if (bx < 48) {
                LAS float* sc = (LAS float*)lds; const int b = bx / 6, h = bx % 6; const float bias = args.in[I_BF][L * 6 + h];
                float v[4], run = 0.f;
#pragma unroll
                for (int j = 0; j < 4; ++j) { const float z = FZ[(size_t)(b * T + tid * 4 + j) * 8 + h] + bias; const float ls = fminf(z, 0.f) - log1pf(expf(-fabsf(z))); run += ls; v[j] = run; }
                sc[tid] = run; __syncthreads();
                for (int o = 1; o < NTHR; o <<= 1) { float add = (tid >= o) ? sc[tid - o] : 0.f; __syncthreads(); sc[tid] += add; __syncthreads(); }
                const float base = (tid > 0) ? sc[tid - 1] : 0.f;
#pragma unroll
                for (int j = 0; j < 4; ++j) DL[(size_t)bx * T + tid * 4 + j] = -LOG2E * (base + v[j]);
                __syncthreads();
            }
            if ((G & 7) == 0) ARRIVE(); else SEAM();
        }
        if (IN(6)) REPEAT(6) {
            PHASE_BEGIN
            bf16* DILO = HB;
            float* LSE = (float*)(ws + WS_HB + 24 * MiB);
            const bool perb = (G & 7) == 0; const int xq = bx & 7;
            unsigned* queue = ctl + CW_Q + 64 * L + (perb ? 8 * xq : 0);
            const int npre = perb ? ((G >> 3) < 48 ? (G >> 3) : 48) : 0; const bool has_pre = (bx >> 3) < npre;
            const int NU = perb ? 80 + 3 * 48 - npre : 640 + 3 * 384;
            for (int it = 0;; ++it) {
                int idx;
                if (it == 0 && has_pre) idx = NU + (bx >> 3);
                else {
                    if (perb && it == (has_pre ? 1 : 0)) WAIT();
                    if (tid == 0) MISC[16] = __hip_atomic_fetch_add(queue, 1u, __ATOMIC_RELAXED, __HIP_MEMORY_SCOPE_AGENT);
                    asm volatile("s_waitcnt vmcnt(0) lgkmcnt(0)\n\ts_barrier" ::: "memory");
                    idx = (int)MISC[16];
                    asm volatile("s_waitcnt lgkmcnt(0)\n\ts_barrier" ::: "memory");
                    if (idx >= NU) break;
                }
                int ln = lane, wv = wave; asm volatile("" : "+v"(ln), "+s"(wv));
                int kind, b, h, qb = 0, br = 0, sub = 0;
                if (perb) { b = xq;
                    if (idx < 80) { qb = 7 - idx / 10; const int jl = idx % 10; kind = (jl < 4) ? 0 : 1; h = (jl < 4) ? jl : jl - 4; }
                    else { const int d = idx - 80; br = d / 48; const int jj = d % 48; kind = 2; h = jj >> 3; sub = jj & 7; }
                } else {
                    if (idx < 640) { qb = 7 - idx / 80; const int j = idx % 80; kind = (j < 32) ? 0 : 1; b = (j < 32) ? (j >> 2) : (j - 32) / 6; h = (j < 32) ? (j & 3) : (j - 32) % 6; }
                    else { const int j = idx - 640; br = j / 384; const int jj = j % 384; kind = 2; b = (jj >> 3) / 6; h = (jj >> 3) % 6; sub = jj & 7; }
                }
                at::Geo g; at::Tens P; g.b = b;
                if (kind == 0) { g.mode = 0; g.r = 1; g.rho = 0; g.u = qb;
                    P.q0 = QC + h * 64; P.q1 = QC + 256 + h * 32; P.qp = 512; P.k0 = KVC + h * 64; P.kp = 512; P.k1 = KR; P.v = KVC + 256 + h * 64; P.vp = 512; P.dl = nullptr;
                    P.o = OALL + 768 + h * 64; P.op = D; P.lse = nullptr;
                    at::attn_unit<true, false>(lds, P, g, ln, wv);
                } else if (kind == 1) {
                    fx::fox_unit<8, NPROJ, D>(lds, PROJ + (size_t)b * T * NPROJ + C_FQ + h * 64, PROJ + (size_t)b * T * NPROJ + C_FK + h * 64, PROJ + (size_t)b * T * NPROJ + C_FV + h * 64,
                                              DL + (size_t)(b * 6 + h) * T, OALL + (size_t)b * T * D + h * 64, qb, ln, wv);
                } else {
                    if (br == 0) { g.mode = 1; g.r = 1; g.rho = 0; g.u = sub; }
                    else if (br == 1) { g.mode = 1; g.r = 4; g.u = sub & 1; g.rho = (sub >> 1) & 3; }
                    else { g.mode = 2; g.r = 16; g.u = 0; g.rho = sub; }
                    P.q0 = PROJ + C_DQ + h * 64; P.q1 = nullptr; P.qp = NPROJ; P.k0 = PROJ + C_DK + h * 64; P.kp = NPROJ; P.k1 = nullptr; P.v = PROJ + C_DV + h * 64; P.vp = NPROJ; P.dl = nullptr;
                    if (br == 0) { P.o = OALL + 384 + h * 64; P.op = D; } else { P.o = DILO + (size_t)(br - 1) * M * 384 + h * 64; P.op = 384; }
                    P.lse = LSE + (size_t)br * M * 8 + h;
                    at::attn_unit<false, false>(lds, P, g, ln, wv);
                }
            }
            SEAMF(true, (L & 1) ? 6 : 0);
        }
        if (IN(7)) REPEAT(7) {
            PHASE_BEGIN
            { const bf16* DILO = HB; const float* LSE = (const float*)(ws + WS_HB + 24 * MiB);
              for (int i = gtid; i < M * 48; i += NGT) { const int row = i / 48, c8 = i - row * 48, h = c8 >> 3;
                  const float l0 = LSE[(size_t)row * 8 + h], l1 = LSE[(size_t)(M + row) * 8 + h], l2 = LSE[(size_t)(2 * M + row) * 8 + h];
                  const float mx = fmaxf(l0, fmaxf(l1, l2)); float w0 = exp2f(l0 - mx), w1 = exp2f(l1 - mx), w2 = exp2f(l2 - mx); const float inv = 1.0f / (w0 + w1 + w2); w0 *= inv; w1 *= inv; w2 *= inv;
                  u32x4* op = (u32x4*)(OALL + (size_t)row * D + 384 + c8 * 8);
                  f32x4 a0, a1, b0, b1, c0, c1; pg8::unpack8(*op, a0, a1); pg8::unpack8(*(const u32x4*)(DILO + (size_t)row * 384 + c8 * 8), b0, b1); pg8::unpack8(*(const u32x4*)(DILO + (size_t)(M + row) * 384 + c8 * 8), c0, c1);
                  *op = pg8::pack8(a0 * w0 + b0 * w1 + c0 * w2, a1 * w0 + b1 * w1 + c1 * w2); }
              SEAMF(true, (L & 1) ? 7 : 1); }
            { pg8::Gemm g{OALL, (const bf16*)(ws + WS_WBR) + (size_t)L * D * D, D, D}; pg8::MergeOrder S{G, bx};
              pg8::EpiMergeChain E{MERGED, PROJ + C_G}; pg8::gemm_phase(lds, g, S, E, tid); }
            if ((L & 1) == 0) SEAMF(true, 2); else SEAMD(0);
        }
        if (IN(8)) REPEAT(8) {
            PHASE_BEGIN
            pg8::Gemm g{MERGED, (const bf16*)(ws + WS_WOUT) + (size_t)L * D * D, D / 2, D / 2}; pg8::SubsetOrder<true> S; S.init(M, D, D / 2, G, bx, D / 2, D / 2); S.first = 0; S.alt = -1;
            pg8::EpiResidX<false> E{XBN, XB, SSP_E, nullptr, 1.0f / 256.0f}; pg8::gemm_phase(lds, g, S, E, tid);
            if ((L & 1) == 0) SEAMF(true, 3); else SEAMD(1);
        }
        if (IN(9) && moe) REPEAT(9) {
            PHASE_BEGIN
            const float* gf = args.in[I_FFNN] + L * D; const float* wr = args.in[I_WR] + (size_t)jl * D * NEXP;
            LAS unsigned* lcnt = (LAS unsigned*)lds;
            LAS unsigned* info = (LAS unsigned*)lds + 16;
            f32x4 wq[4][4][2];
#pragma unroll
            for (int j = 0; j < 4; ++j) { const f32x4 gv = *((const f32x4*)gf + lane + 64 * j);
#pragma unroll
                for (int q = 0; q < 4; ++q) { const int k = 4 * lane + 256 * j + q; wq[j][q][0] = *(const f32x4*)(wr + (size_t)k * 8) * gv[q]; wq[j][q][1] = *(const f32x4*)(wr + (size_t)k * 8 + 4) * gv[q]; } }
            for (int blk = bx; blk < M / 64; blk += G) {
                if (tid < 16) lcnt[tid] = 0u;
                __syncthreads();
                u32x2 raw[8][4];
#pragma unroll
                for (int i = 0; i < 8; ++i) { const u32x2* p = (const u32x2*)(XB + (size_t)(blk * 64 + wave * 8 + i) * D) + lane;
#pragma unroll
                    for (int j = 0; j < 4; ++j) raw[i][j] = p[64 * j]; }
#pragma unroll
                for (int i = 0; i < 8; ++i) { const int lr = wave * 8 + i;
                    f32x4 v[4];
#pragma unroll
                    for (int j = 0; j < 4; ++j) v[j] = (f32x4){bf2f(raw[i][j].x & 0xffffu), bf2f(raw[i][j].x >> 16), bf2f(raw[i][j].y & 0xffffu), bf2f(raw[i][j].y >> 16)};
                    const float rs = row_rstd(v);
                    f32x4 la = (f32x4){0.f, 0.f, 0.f, 0.f}, lb = la;
#pragma unroll
                    for (int j = 0; j < 4; ++j)
#pragma unroll
                        for (int q = 0; q < 4; ++q) { la += wq[j][q][0] * v[j][q]; lb += wq[j][q][1] * v[j][q]; }
                    float lg[8] = {la.x * rs, la.y * rs, la.z * rs, la.w * rs, lb.x * rs, lb.y * rs, lb.z * rs, lb.w * rs};
#pragma unroll
                    for (int e = 0; e < 8; ++e) lg[e] = wave_sum(lg[e]);
                    int e0 = 0; float l0 = lg[0];
#pragma unroll
                    for (int e = 1; e < 8; ++e) if (lg[e] > l0) { l0 = lg[e]; e0 = e; }
                    int e1 = -1; float l1 = -INFINITY;
#pragma unroll
                    for (int e = 0; e < 8; ++e) if (e != e0 && lg[e] > l1) { l1 = lg[e]; e1 = e; }
                    const float w1v = 1.0f / (1.0f + expf(l0 - l1)), w0v = 1.0f - w1v;
                    if (lane == 0) { const unsigned r0 = atomicAdd((unsigned*)(lcnt + e0), 1u), r1 = atomicAdd((unsigned*)(lcnt + e1), 1u);
                        LAS unsigned* io = info + lr * 8; io[0] = e0; io[1] = r0; io[2] = __float_as_uint(w0v); io[3] = e1; io[4] = r1; io[5] = __float_as_uint(w1v); io[6] = __float_as_uint(rs); }
                }
                __syncthreads();
                if (tid < 8) lcnt[8 + tid] = __hip_atomic_fetch_add(cnt + tid, lcnt[tid], __ATOMIC_RELAXED, __HIP_MEMORY_SCOPE_AGENT);
                __syncthreads();
                if (tid < 64) { const LAS unsigned* io = info + tid * 8; unsigned* ro = ROUTE + (size_t)(blk * 64 + tid) * 8;
                    const unsigned e0 = io[0], e1 = io[3]; const unsigned s0 = lcnt[8 + e0] + io[1], s1 = lcnt[8 + e1] + io[4]; ro[0] = e0; ro[1] = s0; ro[2] = io[2]; ro[3] = e1; ro[4] = s1; ro[5] = io[5];
                    int* TOKS = (int*)(ws + WS_TOKS); TOKS[(size_t)e0 * M + s0] = blk * 64 + tid; TOKS[(size_t)e1 * M + s1] = blk * 64 + tid;
                    float* RSL = (float*)(ws + WS_RSL); const float rsv = __uint_as_float(io[6]); RSL[(size_t)e0 * M + s0] = rsv; RSL[(size_t)e1 * M + s1] = rsv; }
                __syncthreads();
            }
            if (L == 3 && !args.fused) { LAS float* scr = (LAS float*)lds + wave * (64 * 33); int jid = 0;
                for (int e = 0; e < NEXP; ++e) { bf16* wgu = (bf16*)(ws + WS_WEGU) + (size_t)e * 2 * DFE * D;
                    CONV(args.in[I_EG] + (size_t)(NEXP + e) * D * DFE, DFE, D, 0, DFE, wgu, D, 0, 1, 0, gf, 1.f);
                    CONV(args.in[I_EU] + (size_t)(NEXP + e) * D * DFE, DFE, D, 0, DFE, wgu, D, 0, 1, 4, gf, 1.f);
                    CONV(args.in[I_ED] + (size_t)(NEXP + e) * DFE * D, D, DFE, 0, D, (bf16*)(ws + WS_WEDN) + (size_t)e * D * DFE, DFE, 0, 0, 0, nullptr, 1.f); } }
            SEAM();
        }
        if (IN(10) && !moe) REPEAT(10) {
            PHASE_BEGIN
            pg8::Gemm g{XB, (const bf16*)(ws + WS_WGU) + (size_t)jl * 2 * DFF * D, D, D}; pg8::StaticOrder S; S.init(M, 2 * DFF, D, G, bx, D, D);
            pg8::EpiSwiGLU2<false, true> E{HID, DFF, SSP_E}; pg8::gemm_phase(lds, g, S, E, tid);
            SEAMF((L & 1) == 0, 4);
        }
        if (IN(11)) REPEAT(11) {
            PHASE_BEGIN
            if (!moe) {
                pg8::Gemm g{HID, (const bf16*)(ws + WS_WDN) + (size_t)jl * D * DFF, DFF / 2, DFF / 2}; pg8::SubsetOrder<true> S; S.init(M, D, DFF / 2, G, bx, DFF / 2, DFF / 2); S.first = 0; S.alt = -1;
                pg8::EpiResidX<true> E{XB, XB, SSP_G, (unsigned char*)OALL, 1.0f / 256.0f}; pg8::gemm_phase(lds, g, S, E, tid);
            } else {
                pg8::MoeGatherOrder MO; MOE_CUM_ASSIGN
                pg8::Gemm g{XB, (const bf16*)(ws + WS_WEGU), D, D};
                MO.nt = (D) / 64; MO.npn = 2 * DFE / 256; MO.ta = 256L * D * 2; MO.tb = 256L * D * 2; MO.eb = 2L * DFE * D * 2;
                { LAS int* tt = (LAS int*)(lds + pg8::TOK_TAB_OFF); const int* TOKS = (const int*)(ws + WS_TOKS); const float* RSL = (const float*)(ws + WS_RSL);
                  for (int i = 0; i < 8; ++i) { int tile, pnu; if (!MO.unit_tile(i, tile, pnu)) break;
                      int e = 0, c0 = 0;
#pragma unroll
                      for (int k = 1; k < 8; ++k) if (tile >= MO.cum[k]) { e = k; c0 = MO.cum[k]; }
                      const int r0 = (tile - c0) * 256, n = (int)__builtin_amdgcn_readfirstlane(__hip_atomic_load(cnt + e, __ATOMIC_RELAXED, __HIP_MEMORY_SCOPE_AGENT)) - r0;
                      if (tid < 256) { const size_t li = (size_t)e * M + r0 + (tid < n ? tid : 0); tt[i * 256 + tid] = TOKS[li]; ((LAS float*)(lds + pg8::RSU_TAB_OFF))[i * 256 + tid] = RSL[li]; } }
                  __syncthreads(); }
                pg8::EpiSwiGLU2<true> E{HID, DFE, nullptr}; pg8::gemm_phase(lds, g, MO, E, tid);
            }
            if (!moe) ARRIVE(); else SEAM();
        }
        if (IN(12) && moe) REPEAT(12) {
            PHASE_BEGIN
            MOE_CUM
            pg8::Gemm g{HID, (const bf16*)(ws + WS_WEDN), DFE, DFE};
            MO.nt = (DFE) / 64; MO.npn = D / 256; MO.ta = 256L * DFE * 2; MO.tb = 256L * DFE * 2; MO.eb = (long)D * DFE * 2;
            pg8::EpiStore E{XG, D}; pg8::gemm_phase(lds, g, MO, E, tid);
            SEAM();
        }
        if (IN(13) && moe) REPEAT(13) {
            PHASE_BEGIN
            { pg8::MoeOrder MO; MOE_CUM_ASSIGN
            for (int r = gw; r < M; r += NGW) { f32x4 v[4]; load_row_bf16(XB + (size_t)r * D, v, lane);
                const unsigned* ro = ROUTE + (size_t)r * 8; int o0 = 0, o1 = 0; const int e0 = (int)ro[0], e1 = (int)ro[3];
#pragma unroll
                for (int e = 0; e < 8; ++e) { if (e == e0) o0 = MO.cum[e]; if (e == e1) o1 = MO.cum[e]; }
                const float w0 = __uint_as_float(ro[2]), w1 = __uint_as_float(ro[5]);
                const u32x2* y0 = (const u32x2*)(XG + ((size_t)o0 * 256 + ro[1]) * D) + lane; const u32x2* y1 = (const u32x2*)(XG + ((size_t)o1 * 256 + ro[4]) * D) + lane; float s_ = 0.f;
#pragma unroll
                for (int j = 0; j < 4; ++j) { const u32x2 a = y0[64 * j], b2 = y1[64 * j];
                    v[j].x += w0 * bf2f(a.x & 0xffffu) + w1 * bf2f(b2.x & 0xffffu); v[j].y += w0 * bf2f(a.x >> 16) + w1 * bf2f(b2.x >> 16);
                    v[j].z += w0 * bf2f(a.y & 0xffffu) + w1 * bf2f(b2.y & 0xffffu); v[j].w += w0 * bf2f(a.y >> 16) + w1 * bf2f(b2.y >> 16);
                    s_ += (v[j].x * v[j].x + v[j].y * v[j].y) + (v[j].z * v[j].z + v[j].w * v[j].w); }
                store_row_bf16(XB + (size_t)r * D, v, 1.0f, lane); const float ss = wave_sum(s_);
                { unsigned* o4 = (unsigned*)((unsigned char*)OALL + (size_t)r * D) + lane;
#pragma unroll
                  for (int j = 0; j < 4; ++j) o4[64 * j] = pk4_fp8(v[j].x, v[j].y, v[j].z, v[j].w); }
                if (lane < 16) SSP_G[(size_t)r * 16 + lane] = (lane == 0) ? ss : 0.f; } }
            ARRIVE();
        }
        if (IN(15)) REPEAT(15) {
            PHASE_BEGIN
            bf16* PPL = PP + (moe ? (size_t)0 : (size_t)48 * MiB);
            { pg8::Gemm g{(const bf16*)ws, (const bf16*)ws, D, D};
              pg8::PleSubOrder<false> S{G, bx, 0, 4, (long)(WS_PBALL + (size_t)L * 512), (long)(WS_WPP + (size_t)L * D * D * 2), 256L * D * 2, 256L * D * 2};
              pg8::EpiStore E{PPL, D}; pg8::gemm_phase(lds, g, S, E, tid); }
            WAIT();
            { pg8::Gemm g{(const bf16*)ws, (const bf16*)ws, D / 2, D / 2};
              pg8::PleSubOrder<true> S{G, bx, 1, 8, (long)WS_OALL, (long)(WS_WPG + (size_t)L * D * D * 2), 256L * D, 256L * D};
              pg8::EpiPle3 E{XB, XBN, PPL, SSP_G, SSP_H, (unsigned char*)MERGED, 1.0f / 32.0f}; pg8::gemm_phase(lds, g, S, E, tid); }
            if ((L & 1) == 0) SEAMF(true, 5); else SEAMD(2);
        }
    }
    if (IN(PH_FINAL) && args.l_hi == DEPTH) {
        PHASE_BEGIN
        const float* gn = args.in[I_FINN];
        for (int r = gw; r < M; r += NGW) { f32x4* xr = (f32x4*)(X + (size_t)r * D) + lane; const float rs = rstd16(SSP_H + (size_t)r * 16); f32x4 v[4]; load_row_bf16(XBN + (size_t)r * D, v, lane);
#pragma unroll
            for (int j = 0; j < 4; ++j) { const f32x4 gv = *((const f32x4*)gn + lane + 64 * j); xr[64 * j] = v[j] * rs * gv; } }
    }
#undef IN
#undef SEAM
}

#ifndef MK_PER_PHASE
#define MK_PER_PHASE 0
#endif
typedef void (*kern_t)(Args);
#if MK_PER_PHASE
template <int K> struct KTab { static void fill(kern_t* t) { t[K] = mk_fwd<(1u << K)>; KTab<K - 1>::fill(t); } };
template <> struct KTab<-1> { static void fill(kern_t*) {} };
#endif
extern "C" void kernel_launch(void* const* d_in, const int* in_sizes, int n_in, void* d_out, int out_size, void* d_ws, size_t ws_size, hipStream_t stream) {
    static int grid = 0; static kern_t tab[PH_FINAL + 1];
    if (grid == 0) {
        if (n_in != 26 || out_size != M * D || ws_size < WS_END) { fprintf(stderr, "kernel_launch: unexpected shapes / workspace (n_in %d out %d ws %zu need %zu)\n", n_in, out_size, ws_size, (size_t)WS_END); grid = -1; return; }
        int dev = 0, cus = 0;
        if (hipGetDevice(&dev) != hipSuccess || hipDeviceGetAttribute(&cus, hipDeviceAttributeMultiprocessorCount, dev) != hipSuccess) { grid = -1; return; }
#if MK_PER_PHASE
        KTab<PH_FINAL>::fill(tab);
#else
        for (int k = 0; k <= PH_FINAL; ++k) tab[k] = mk_fwd<0x1FFFFu>;
#endif
        for (int k = 0; k <= PH_FINAL; ++k)
            if (hipFuncSetAttribute((const void*)tab[k], hipFuncAttributeMaxDynamicSharedMemorySize, LDS_BYTES) != hipSuccess) { grid = -1; return; }
        int per_cu = 0;
        if (hipOccupancyMaxActiveBlocksPerMultiprocessor(&per_cu, (const void*)tab[0], NTHR, LDS_BYTES) != hipSuccess || per_cu < 1) { fprintf(stderr, "kernel_launch: occupancy query reports %d workgroups per CU\n", per_cu); grid = -1; (void)hipGetLastError(); return; }
        (void)hipGetLastError();
        grid = cus;
    }
    if (grid < 0) return;
    (void)hipMemsetAsync((char*)d_ws + WS_CTL, 0, CTL_BYTES, stream);
    Args a{};
    for (int i = 0; i < 26; ++i) a.in[i] = (const float*)d_in[i];
    a.out = (float*)d_out; a.ws = (unsigned char*)d_ws; a.pad = 0;
#if MK_PER_PHASE
    a.fused = 0;
    a.l_lo = 0; a.l_hi = 0; a.ph_lo = 0; a.ph_hi = 1;
    hipLaunchKernelGGL(tab[0], dim3(grid), dim3(NTHR), LDS_BYTES, stream, a);
    for (int L = 0; L < DEPTH; ++L)
        for (int ph = 1; ph <= 15; ++ph) {
            if (ph == 12 && !(L & 1)) continue;
            a.l_lo = L; a.l_hi = L + 1; a.ph_lo = ph; a.ph_hi = ph + 1;
            hipLaunchKernelGGL(tab[ph], dim3(grid), dim3(NTHR), LDS_BYTES, stream, a);
        }
    a.l_lo = DEPTH; a.l_hi = DEPTH; a.ph_lo = PH_FINAL; a.ph_hi = PH_FINAL + 1;
    hipLaunchKernelGGL(tab[PH_FINAL], dim3(grid), dim3(NTHR), LDS_BYTES, stream, a);
#else
    a.fused = 1; a.l_lo = 0; a.l_hi = DEPTH; a.ph_lo = 0; a.ph_hi = PH_FINAL + 1;
    hipLaunchKernelGGL(tab[0], dim3(grid), dim3(NTHR), LDS_BYTES, stream, a);
#endif
}
```
